# Optimizing an MI355X kernel written in HIP

```python
import math
import jax, jax.numpy as jnp
from jax import lax
import numpy as np

D_MODEL = 2048
BATCH = 4
SEQ = 2048
DEPTH = 4
DEC_BATCH = 128
DEC_SEQ = 4
PAST_LEN = 16384
PAGE_SIZE = 128

MIX_WIDTH = D_MODEL
POOL_WIDTH = MIX_WIDTH // 4
POOL_WINDOWS = (2, 4, 8, 16)
POOL_GROUPS = len(POOL_WINDOWS)
POOL_GROUP_DIM = POOL_WIDTH // POOL_GROUPS
POOL_BUF = max(POOL_WINDOWS) - 1
SSD_WIDTH = MIX_WIDTH - POOL_WIDTH
SSD_HEAD_DIM = 64
SSD_HEADS = SSD_WIDTH // SSD_HEAD_DIM
SSD_GROUPS = 4
SSD_HPG = SSD_HEADS // SSD_GROUPS
D_STATE = 128
SSD_CONV = 4
SSD_CHUNK = 128
XBC_WIDTH = SSD_WIDTH + 2 * SSD_GROUPS * D_STATE
IN_WIDTH = POOL_WIDTH + SSD_WIDTH + XBC_WIDTH + SSD_HEADS
D_FF = 128 * ((8 * D_MODEL // 3 + 127) // 128)
FFN_CONV = 3
EPS = 1e-6

kernel_name = 'hybrid_pool_ssd_convffn_adaln_step'


def rmsnorm(x, g):
    xf = x.astype(jnp.float32)
    y = xf * lax.rsqrt(jnp.mean(xf * xf, axis=-1, keepdims=True) + EPS)
    return (y * g.astype(jnp.float32)).astype(x.dtype)


def causal_dwconv(u, prev, w, b):
    k = w.shape[0]
    L = u.shape[1]
    full = jnp.concatenate([prev.astype(u.dtype), u], axis=1)
    out = b.astype(u.dtype)
    for i in range(k):
        out = out + full[:, i:i + L] * w[i].astype(u.dtype)
    return out, full[:, full.shape[1] - (k - 1):]


def pool_mixer(u, prev, pos0, pool_w, pool_scale):
    L = u.shape[1]
    full = jnp.concatenate([prev.astype(u.dtype), u], axis=1)
    cs = jnp.cumsum(full.astype(jnp.float32), axis=1)
    cs = jnp.pad(cs, ((0, 0), (1, 0), (0, 0)))
    pos = pos0 + jnp.arange(L, dtype=jnp.int32)
    outs = []
    for g, w in enumerate(POOL_WINDOWS):
        lo, hi = g * POOL_GROUP_DIM, (g + 1) * POOL_GROUP_DIM
        s = cs[:, POOL_BUF + 1:POOL_BUF + 1 + L, lo:hi] - cs[:, POOL_BUF + 1 - w:POOL_BUF + 1 - w + L, lo:hi]
        cnt = jnp.minimum(pos + 1, w).astype(jnp.float32)[None, :, None]
        d = s / cnt - u[:, :, lo:hi].astype(jnp.float32)
        outs.append(d @ pool_w[g].astype(jnp.float32))
    out = jnp.concatenate(outs, axis=-1) * pool_scale.astype(jnp.float32)
    return out.astype(u.dtype), full[:, full.shape[1] - POOL_BUF:]


def ssd_chunked(xdt, dA, Bm, Cm, h0):
    b, L = xdt.shape[0], xdt.shape[1]
    q = min(SSD_CHUNK, L)
    nc = -(-L // q)
    pad = nc * q - L

    def padc(a):
        a = jnp.pad(a, ((0, 0), (0, pad)) + ((0, 0),) * (a.ndim - 2))
        return a.reshape((b, nc, q) + a.shape[2:])

    xdt, dA, Bm, Cm = padc(xdt), padc(dA), padc(Bm), padc(Cm)
    cs = jnp.cumsum(dA, axis=2)
    seg = cs[:, :, :, None] - cs[:, :, None, :]
    mask = jnp.tril(jnp.ones((q, q), dtype=bool))[:, :, None, None]
    Lm = jnp.exp(jnp.where(mask, seg, -jnp.inf))
    CB = jnp.einsum('bclgn,bcsgn->bclsg', Cm, Bm)
    y_diag = jnp.einsum('bclsg,bclsgr,bcsgrp->bclgrp', CB, Lm, xdt)
    decay_to_end = jnp.exp(cs[:, :, -1:] - cs)
    chunk_states = jnp.einsum('bclgn,bclgr,bclgrp->bcgrpn', Bm, decay_to_end, xdt)
    chunk_decay = jnp.exp(cs[:, :, -1])

    def step(h, inp):
        s, dec = inp
        return h * dec[..., None, None] + s, h

    h_final, h_starts = lax.scan(step, h0, (jnp.moveaxis(chunk_states, 1, 0), jnp.moveaxis(chunk_decay, 1, 0)))
    h_starts = jnp.moveaxis(h_starts, 0, 1)
    y_off = jnp.einsum('bclgn,bcgrpn,bclgr->bclgrp', Cm, h_starts, jnp.exp(cs))
    y = (y_diag + y_off).reshape((b, nc * q) + xdt.shape[3:])[:, :L]
    return y, h_final


def ssd_mixer(z, xbc, dt_raw, conv_prev, h0, conv_w, conv_b, dt_bias, a_log, d_skip, norm_g):
    b, L = z.shape[0], z.shape[1]
    xbc_c, new_conv = causal_dwconv(xbc, conv_prev, conv_w, conv_b)
    xbc_c = jax.nn.silu(xbc_c.astype(jnp.float32))
    xs = xbc_c[..., :SSD_WIDTH].reshape(b, L, SSD_GROUPS, SSD_HPG, SSD_HEAD_DIM)
    Bm = xbc_c[..., SSD_WIDTH:SSD_WIDTH + SSD_GROUPS * D_STATE].reshape(b, L, SSD_GROUPS, D_STATE)
    Cm = xbc_c[..., SSD_WIDTH + SSD_GROUPS * D_STATE:].reshape(b, L, SSD_GROUPS, D_STATE)
    dt = jax.nn.softplus(dt_raw.astype(jnp.float32) + dt_bias.astype(jnp.float32)).reshape(b, L, SSD_GROUPS, SSD_HPG)
    A = -jnp.exp(a_log.astype(jnp.float32)).reshape(SSD_GROUPS, SSD_HPG)
    h0 = h0.astype(jnp.float32).reshape(b, SSD_GROUPS, SSD_HPG, SSD_HEAD_DIM, D_STATE)
    y, h_final = ssd_chunked(xs * dt[..., None], dt * A, Bm, Cm, h0)
    y = y + d_skip.astype(jnp.float32).reshape(SSD_GROUPS, SSD_HPG)[..., None] * xs
    y = y.reshape(b, L, SSD_WIDTH) * jax.nn.silu(z.astype(jnp.float32))
    y = rmsnorm(y, norm_g)
    return y.astype(z.dtype), new_conv, h_final.reshape(b, SSD_HEADS, SSD_HEAD_DIM, D_STATE)


def conv_ffn(h, prev, w_up, conv_w, conv_b, w_down):
    up = h @ w_up
    gate, val = up[..., :D_FF], up[..., D_FF:]
    gate_c, new_buf = causal_dwconv(gate, prev, conv_w, conv_b)
    act = jax.nn.silu(gate_c) * val
    return act @ w_down, new_buf


def block(x, c, st_pool, st_conv, st_ssm, st_ffn, pos0, lp):
    mod = (jax.nn.silu(c.astype(jnp.float32)) @ lp['w_ada'].astype(jnp.float32) + lp['b_ada'].astype(jnp.float32)).astype(x.dtype)
    sh1, sc1, g1, sh2, sc2, g2 = [m[:, None] for m in jnp.split(mod, 6, axis=-1)]
    h = rmsnorm(x, lp['norm1']) * (1 + sc1) + sh1
    proj = h @ lp['w_in']
    u_pool, z, xbc, dt_raw = jnp.split(proj, [POOL_WIDTH, POOL_WIDTH + SSD_WIDTH, POOL_WIDTH + SSD_WIDTH + XBC_WIDTH], axis=-1)
    pool_out, new_pool = pool_mixer(u_pool, st_pool, pos0, lp['pool_w'], lp['pool_scale'])
    ssd_out, new_conv, new_ssm = ssd_mixer(z, xbc, dt_raw, st_conv, st_ssm, lp['conv_w'], lp['conv_b'],
                                           lp['dt_bias'], lp['a_log'], lp['d_skip'], lp['ssd_norm'])
    mix = jnp.concatenate([pool_out, ssd_out], axis=-1) @ lp['w_out']
    x = x + g1 * mix
    h2 = rmsnorm(x, lp['norm2']) * (1 + sc2) + sh2
    ffn_out, new_ffn = conv_ffn(h2, st_ffn, lp['w_up'], lp['ffn_conv_w'], lp['ffn_conv_b'], lp['w_down'])
    x = x + g2 * ffn_out
    return x, new_pool, new_conv, new_ssm, new_ffn


def setup_inputs(seed: int = 0) -> dict:
    key = jax.random.key(seed)
    ks = jax.random.split(key, 32)

    def nrm(k, shape, scale=1.0):
        return scale * jax.random.normal(k, shape, jnp.float32)

    dt0 = jnp.exp(jax.random.uniform(ks[14], (DEPTH, SSD_HEADS), jnp.float32, math.log(1e-3), math.log(1e-1)))
    return {
        'x_prompt': nrm(ks[0], (BATCH, SEQ, D_MODEL)),
        'x_sample': nrm(ks[1], (DEC_BATCH, DEC_SEQ, D_MODEL)),
        'c_prompt': nrm(ks[2], (BATCH, D_MODEL)),
        'c_sample': nrm(ks[3], (DEC_BATCH, D_MODEL)),
        'state_pool': nrm(ks[4], (DEPTH, DEC_BATCH, POOL_BUF, POOL_WIDTH)),
        'state_conv': nrm(ks[5], (DEPTH, DEC_BATCH, SSD_CONV - 1, XBC_WIDTH)),
        'state_ssm': nrm(ks[6], (DEPTH, DEC_BATCH, SSD_HEADS, SSD_HEAD_DIM, D_STATE), 0.1),
        'state_ffn': nrm(ks[7], (DEPTH, DEC_BATCH, FFN_CONV - 1, D_FF)),
        'norm1': 1.0 + nrm(ks[8], (DEPTH, D_MODEL), 0.02),
        'norm2': 1.0 + nrm(ks[9], (DEPTH, D_MODEL), 0.02),
        'w_ada': nrm(ks[10], (DEPTH, D_MODEL, 6 * D_MODEL), 0.5 * D_MODEL ** -0.5),
        'b_ada': nrm(ks[11], (DEPTH, 6 * D_MODEL), 0.02),
        'w_in': nrm(ks[12], (DEPTH, D_MODEL, IN_WIDTH), D_MODEL ** -0.5),
        'pool_w': nrm(ks[13], (DEPTH, POOL_GROUPS, POOL_GROUP_DIM, POOL_GROUP_DIM), POOL_GROUP_DIM ** -0.5),
        'pool_scale': 1.0 + nrm(ks[15], (DEPTH, POOL_WIDTH), 0.1),
        'conv_w': nrm(ks[16], (DEPTH, SSD_CONV, XBC_WIDTH), SSD_CONV ** -0.5),
        'conv_b': nrm(ks[17], (DEPTH, XBC_WIDTH), 0.02),
        'dt_bias': dt0 + jnp.log(-jnp.expm1(-dt0)),
        'a_log': jnp.log(jax.random.uniform(ks[18], (DEPTH, SSD_HEADS), jnp.float32, 1.0, 16.0)),
        'd_skip': 1.0 + nrm(ks[19], (DEPTH, SSD_HEADS), 0.1),
        'ssd_norm': 1.0 + nrm(ks[20], (DEPTH, SSD_WIDTH), 0.02),
        'w_out': nrm(ks[21], (DEPTH, MIX_WIDTH, D_MODEL), MIX_WIDTH ** -0.5),
        'w_up': nrm(ks[22], (DEPTH, D_MODEL, 2 * D_FF), D_MODEL ** -0.5),
        'ffn_conv_w': nrm(ks[23], (DEPTH, FFN_CONV, D_FF), FFN_CONV ** -0.5),
        'ffn_conv_b': nrm(ks[24], (DEPTH, D_FF), 0.02),
        'w_down': nrm(ks[25], (DEPTH, D_FF, D_MODEL), D_FF ** -0.5),
        'norm_f': 1.0 + nrm(ks[26], (D_MODEL,), 0.02),
    }


def reference(x_prompt, x_sample, c_prompt, c_sample, state_pool, state_conv, state_ssm, state_ffn,
              norm1, norm2, w_ada, b_ada, w_in, pool_w, pool_scale, conv_w, conv_b, dt_bias, a_log,
              d_skip, ssd_norm, w_out, w_up, ffn_conv_w, ffn_conv_b, w_down, norm_f):
    bp = x_prompt.shape[0]
    xp, xs = x_prompt, x_sample
    pp_pool, pp_conv, pp_ssm, pp_ffn = [], [], [], []
    ps_pool, ps_conv, ps_ssm, ps_ffn = [], [], [], []
    for l in range(DEPTH):
        lp = {'norm1': norm1[l], 'norm2': norm2[l], 'w_ada': w_ada[l], 'b_ada': b_ada[l], 'w_in': w_in[l],
              'pool_w': pool_w[l], 'pool_scale': pool_scale[l], 'conv_w': conv_w[l], 'conv_b': conv_b[l],
              'dt_bias': dt_bias[l], 'a_log': a_log[l], 'd_skip': d_skip[l], 'ssd_norm': ssd_norm[l],
              'w_out': w_out[l], 'w_up': w_up[l], 'ffn_conv_w': ffn_conv_w[l], 'ffn_conv_b': ffn_conv_b[l],
              'w_down': w_down[l]}
        xp, a, b_, c_, d_ = block(
            xp, c_prompt,
            jnp.zeros((bp, POOL_BUF, POOL_WIDTH), xp.dtype),
            jnp.zeros((bp, SSD_CONV - 1, XBC_WIDTH), xp.dtype),
            jnp.zeros((bp, SSD_HEADS, SSD_HEAD_DIM, D_STATE), jnp.float32),
            jnp.zeros((bp, FFN_CONV - 1, D_FF), xp.dtype),
            0, lp)
        pp_pool.append(a); pp_conv.append(b_); pp_ssm.append(c_); pp_ffn.append(d_)
        xs, a, b_, c_, d_ = block(xs, c_sample, state_pool[l], state_conv[l], state_ssm[l], state_ffn[l], PAST_LEN, lp)
        ps_pool.append(a); ps_conv.append(b_); ps_ssm.append(c_); ps_ffn.append(d_)
    y_prompt = rmsnorm(xp, norm_f)
    y_sample = rmsnorm(xs, norm_f)
    return (y_prompt, y_sample,
            jnp.stack(pp_pool), jnp.stack(pp_conv), jnp.stack(pp_ssm), jnp.stack(pp_ffn),
            jnp.stack(ps_pool), jnp.stack(ps_conv), jnp.stack(ps_ssm), jnp.stack(ps_ffn))
```

```cpp
#include <hip/hip_runtime.h>
#include <cstdio>
#include <cstdint>
namespace pg8 {
#define PG8_LAS __attribute__((address_space(3)))
typedef unsigned short bf16_t;
typedef short bf16x8 __attribute__((ext_vector_type(8)));
typedef float f32x4 __attribute__((ext_vector_type(4)));
typedef unsigned u32x4 __attribute__((ext_vector_type(4)));
constexpr int BM = 256, BK = 64, HALF = 128, HTB = HALF * BK * 2  , STAGE_BYTES = 8 * HTB, NXCD = 8, WGM = 8;

__host__ __device__ __forceinline__ int lds_byte(int r, int c) { const int st = (r >> 4) * 2 + (c >> 5), rr = r & 15, cc = c & 31, ob = rr * 64 + cc * 2; return st * 1024 + (ob ^ (((ob >> 9) & 1) << 5)); }
__host__ __device__ __forceinline__ void stage_rc(int b, int& R, int& C) { const int st = b / 1024, sb = b % 1024, swz = sb ^ (((sb >> 9) & 1) << 5); R = (st >> 1) * 16 + swz / 64; C = (st & 1) * 32 + (swz % 64) / 2; }
__host__ __device__ __forceinline__ int perm32(int rho) { const int n = rho >> 4, i = rho & 15; return 8 * (i >> 2) + 4 * n + (i & 3); }

struct Unit { int pm, pn; };
struct Gemm { const bf16_t* A; const bf16_t* Bt; int M, N, K; };

struct StaticOrder {
    int nM, nN, nwg, G, c;
    __host__ __device__ void init(int M, int N, int G_, int c_) { nM = M / BM; nN = N / BM; nwg = nM * nN; G = G_; c = c_; }
    __host__ __device__ bool next(int i, Unit& u) const {
        const long L = (long)i * G + c; if (L >= nwg) return false;
        int wgid = (int)L; { const int q = nwg / NXCD, r = nwg % NXCD, xcd = wgid % NXCD, off = wgid / NXCD; wgid = (xcd < r ? xcd * (q + 1) : r * (q + 1) + (xcd - r) * q) + off; }
        const int nig = WGM * nN, gid = wgid / nig, fm = gid * WGM, gsz = (nM - fm) < WGM ? (nM - fm) : WGM;
        u.pm = fm + ((wgid % nig) % gsz); u.pn = (wgid % nig) / gsz; return true;
    }
    __device__ __forceinline__ void a_ready(const Unit&) const {}
    __device__ __forceinline__ void done(const Unit&) const {}
};

__device__ __forceinline__ unsigned cvt_pk_bf16(float lo, float hi) { unsigned r; asm volatile("v_cvt_pk_bf16_f32 %0, %1, %2" : "=v"(r) : "v"(lo), "v"(hi)); return r; }
typedef float f32x2 __attribute__((ext_vector_type(2)));
template <class Epi, class Sched, bool ALIGN_EPI = false, bool SP2 = false>
__device__ __forceinline__ void gemm_phase(PG8_LAS unsigned char* lds, const Gemm g, const Sched& S, const Epi& E) {
    int tid_ = threadIdx.x; asm volatile("" : "+v"(tid_)); const int tid = tid_, wid = __builtin_amdgcn_readfirstlane(tid >> 6), lane = tid & 63, wr = wid >> 2, wc = wid & 3, fr = lane & 15, fq = lane >> 4;
    const int K = g.K, nt = K / BK;
    unsigned voffA[2], voffB[2];
#pragma unroll
    for (int i = 0; i < 2; ++i) { int R, C; stage_rc(tid * 16 + i * 8192, R, C); const int Rb = Epi::PERM ? ((R & ~31) + perm32(R & 31)) : R;
        voffA[i] = (unsigned)(R * K + C) * 2u; voffB[i] = (unsigned)(Rb * K + C) * 2u; }
    const size_t kstep = (size_t)(BK * 2);
    const size_t hstep = (size_t)HALF * K * 2;
    const size_t tstep = 2 * hstep;
    const unsigned ldsw = (unsigned)wid * 1024u;
    const int aoff = lds_byte(wr * 64 + fr, fq * 8), boff = lds_byte(wc * 32 + fr, fq * 8);
#define PG8_SA(b, h) (((b) * 2 + (h)) * HTB)
#define PG8_SB(b, h) ((4 + (b) * 2 + (h)) * HTB)
#define PG8_STAGE(bufoff, gbase, voff) do { _Pragma("unroll") for (int _i = 0; _i < 2; ++_i) \
        __builtin_amdgcn_global_load_lds((const unsigned*)((const char*)(gbase) + (voff)[_i]), (PG8_LAS unsigned*)(lds + (bufoff) + ldsw + _i * 8192), 16, 0, 0); } while (0)
#define PG8_LDA(dst, b, h) do { _Pragma("unroll") for (int m = 0; m < 4; ++m) _Pragma("unroll") for (int k = 0; k < 2; ++k) dst[m][k] = *(const PG8_LAS bf16x8*)(lds + PG8_SA(b, h) + aoff + m * 2048 + k * 1024); } while (0)
#define PG8_LDB(dst, b, h) do { _Pragma("unroll") for (int n = 0; n < 2; ++n) _Pragma("unroll") for (int k = 0; k < 2; ++k) dst[n][k] = *(const PG8_LAS bf16x8*)(lds + PG8_SB(b, h) + boff + n * 2048 + k * 1024); } while (0)
#define PG8_MMA(ai, bj, At, Bt) do { __builtin_amdgcn_s_setprio(1); _Pragma("unroll") for (int m = 0; m < 4; ++m) _Pragma("unroll") for (int n = 0; n < 2; ++n) _Pragma("unroll") for (int k = 0; k < 2; ++k) \
        acc[ai][bj][m][n] = __builtin_amdgcn_mfma_f32_16x16x32_bf16(Bt[n][k], At[m][k], acc[ai][bj][m][n], 0, 0, 0); __builtin_amdgcn_s_setprio(0); } while (0)
#define PG8_WAIT_V(n) asm volatile("s_waitcnt vmcnt(" #n ")" ::: "memory")
#define PG8_WAIT_L(n) asm volatile("s_waitcnt lgkmcnt(" #n ")" ::: "memory")
#define PG8_BAR __builtin_amdgcn_s_barrier()
#define PG8_SCHED __builtin_amdgcn_sched_barrier(0)
    Unit cur, nxt; int ui = 0;
    if (!S.next(0, cur)) return;
    f32x4 acc[2][2][4][2];
#pragma unroll
    for (int a = 0; a < 2; ++a)
#pragma unroll
        for (int b = 0; b < 2; ++b)
#pragma unroll
            for (int m = 0; m < 4; ++m)
#pragma unroll
                for (int n = 0; n < 2; ++n) acc[a][b][m][n] = (f32x4){0.f, 0.f, 0.f, 0.f};
    bf16x8 At[4][2], B0[2][2], B1[2][2];
    const char* cA = (const char*)g.A + (size_t)cur.pm * tstep; const char* cB = (const char*)g.Bt + (size_t)cur.pn * tstep;
    S.a_ready(cur);
    if constexpr (SP2) {
        PG8_STAGE(PG8_SB(0, 0), cB, voffB); PG8_STAGE(PG8_SB(0, 1), cB + hstep, voffB); PG8_STAGE(PG8_SA(0, 0), cA, voffA); PG8_STAGE(PG8_SA(0, 1), cA + hstep, voffA);
        if (wr == 1) PG8_BAR;
        PG8_WAIT_V(2); PG8_BAR;
        PG8_STAGE(PG8_SB(1, 0), cB + kstep, voffB); PG8_STAGE(PG8_SA(1, 0), cA + kstep, voffA); PG8_STAGE(PG8_SB(1, 1), cB + hstep + kstep, voffB);
        PG8_WAIT_V(6); PG8_BAR;
    } else {
        PG8_STAGE(PG8_SB(0, 0), cB, voffB); PG8_STAGE(PG8_SA(0, 0), cA, voffA); PG8_STAGE(PG8_SB(0, 1), cB + hstep, voffB); PG8_STAGE(PG8_SA(0, 1), cA + hstep, voffA);
        if (wr == 1) PG8_BAR;
        PG8_WAIT_V(4); PG8_BAR;
        PG8_STAGE(PG8_SB(1, 0), cB + kstep, voffB); PG8_STAGE(PG8_SA(1, 0), cA + kstep, voffA); PG8_STAGE(PG8_SB(1, 1), cB + hstep + kstep, voffB);
        PG8_WAIT_V(6); PG8_BAR;
    }
    for (;;) {
        const bool has_next = S.next(ui + 1, nxt);
        const char* nA = has_next ? (const char*)g.A + (size_t)nxt.pm * tstep : cA; const char* nB = has_next ? (const char*)g.Bt + (size_t)nxt.pn * tstep : cB;
        for (int t = 0; t < nt; t += 2) {
            const bool last = (t == nt - 2);
            const char* a1 = cA + (size_t)(t + 1) * kstep;
            const char* a2 = last ? nA : cA + (size_t)(t + 2) * kstep; const char* b2 = last ? nB : cB + (size_t)(t + 2) * kstep;
            const char* a3 = a2 + kstep; const char* b3 = b2 + kstep;
            if (last && has_next) S.a_ready(nxt);
            if constexpr (SP2) {
            PG8_LDB(B0, 0, 0); PG8_LDB(B1, 0, 1); PG8_SCHED; PG8_LDA(At, 0, 0); PG8_STAGE(PG8_SA(1, 1), a1 + hstep, voffA);
            PG8_WAIT_V(8); PG8_WAIT_L(0); PG8_BAR; PG8_MMA(0, 0, At, B0); PG8_MMA(0, 1, At, B1); PG8_BAR; PG8_SCHED;
            PG8_LDA(At, 0, 1); PG8_STAGE(PG8_SB(0, 0), b2, voffB); PG8_STAGE(PG8_SB(0, 1), b2 + hstep, voffB); PG8_STAGE(PG8_SA(0, 0), a2, voffA);
            PG8_WAIT_V(8); PG8_WAIT_L(0); PG8_BAR; PG8_MMA(1, 0, At, B0); PG8_MMA(1, 1, At, B1); PG8_BAR; PG8_SCHED;
            PG8_LDB(B0, 1, 0); PG8_LDB(B1, 1, 1); PG8_SCHED; PG8_LDA(At, 1, 0); PG8_STAGE(PG8_SA(0, 1), a2 + hstep, voffA);
            PG8_WAIT_V(8); PG8_WAIT_L(0); PG8_BAR; PG8_MMA(0, 0, At, B0); PG8_MMA(0, 1, At, B1); PG8_BAR; PG8_SCHED;
            PG8_LDA(At, 1, 1); PG8_STAGE(PG8_SB(1, 0), b3, voffB); PG8_STAGE(PG8_SB(1, 1), b3 + hstep, voffB); PG8_STAGE(PG8_SA(1, 0), a3, voffA);
            PG8_WAIT_V(8); PG8_WAIT_L(0); PG8_BAR; PG8_MMA(1, 0, At, B0); PG8_MMA(1, 1, At, B1); PG8_BAR; PG8_SCHED;
            } else {
            PG8_LDB(B0, 0, 0); PG8_SCHED; PG8_LDA(At, 0, 0); PG8_STAGE(PG8_SA(1, 1), a1 + hstep, voffA);
            PG8_WAIT_L(8); PG8_BAR; PG8_WAIT_L(0); PG8_MMA(0, 0, At, B0); PG8_BAR; PG8_SCHED;
            PG8_LDB(B1, 0, 1); PG8_STAGE(PG8_SB(0, 0), b2, voffB);
            PG8_BAR; PG8_WAIT_L(0); PG8_MMA(0, 1, At, B1); PG8_BAR;
            PG8_LDA(At, 0, 1); PG8_STAGE(PG8_SA(0, 0), a2, voffA);
            PG8_BAR; PG8_WAIT_L(0); PG8_MMA(1, 0, At, B0); PG8_BAR; PG8_SCHED;
            PG8_STAGE(PG8_SB(0, 1), b2 + hstep, voffB);
            PG8_WAIT_V(6); PG8_BAR; PG8_MMA(1, 1, At, B1); PG8_BAR;
            PG8_LDB(B0, 1, 0); PG8_SCHED; PG8_LDA(At, 1, 0); PG8_STAGE(PG8_SA(0, 1), a2 + hstep, voffA);
            PG8_WAIT_L(8); PG8_BAR; PG8_WAIT_L(0); PG8_MMA(0, 0, At, B0); PG8_BAR; PG8_SCHED;
            PG8_LDB(B1, 1, 1); PG8_STAGE(PG8_SB(1, 0), b3, voffB);
            PG8_BAR; PG8_WAIT_L(0); PG8_MMA(0, 1, At, B1); PG8_BAR;
            PG8_LDA(At, 1, 1); PG8_STAGE(PG8_SA(1, 0), a3, voffA);
            PG8_BAR; PG8_WAIT_L(0); PG8_MMA(1, 0, At, B0); PG8_BAR; PG8_SCHED;
            PG8_STAGE(PG8_SB(1, 1), b3 + hstep, voffB);
            PG8_WAIT_V(6); PG8_BAR; PG8_MMA(1, 1, At, B1); PG8_BAR;
            }
        }
        if constexpr (ALIGN_EPI) { if (wr == 0) PG8_BAR; }
        if constexpr (!Epi::AFTER_DRAIN) { E(acc, cur, wr, wc, fr, fq); S.done(cur); }
        if (!has_next) break;
#pragma unroll
        for (int a = 0; a < 2; ++a)
#pragma unroll
            for (int b = 0; b < 2; ++b)
#pragma unroll
                for (int m = 0; m < 4; ++m)
#pragma unroll
                    for (int n = 0; n < 2; ++n) acc[a][b][m][n] = (f32x4){0.f, 0.f, 0.f, 0.f};
        cur = nxt; cA = nA; cB = nB; ++ui;
        if constexpr (ALIGN_EPI) { if (wr == 1) PG8_BAR; }
    }
    PG8_WAIT_V(0);
    if constexpr (!ALIGN_EPI) { if (wr == 0) PG8_BAR; }
    PG8_BAR;
    if constexpr (Epi::AFTER_DRAIN) { E.fused(acc, cur, wr, wc, fr, fq, lds, wid, lane); S.done(cur); }
#undef PG8_SA
#undef PG8_SB
#undef PG8_STAGE
#undef PG8_LDA
#undef PG8_LDB
#undef PG8_MMA
#undef PG8_WAIT_V
#undef PG8_WAIT_L
#undef PG8_BAR
#undef PG8_SCHED
}
}

#define LAS __attribute__((address_space(3)))
#define GAS __attribute__((address_space(1)))
typedef unsigned short bf16;
typedef short bf16x8 __attribute__((ext_vector_type(8)));
typedef float f32x4 __attribute__((ext_vector_type(4)));
typedef float f32x16 __attribute__((ext_vector_type(16)));
typedef unsigned u32x4 __attribute__((ext_vector_type(4)));
typedef unsigned u32x2 __attribute__((ext_vector_type(2)));
#define RLX_AGENT __ATOMIC_RELAXED, __HIP_MEMORY_SCOPE_AGENT
#define LDS_WAIT() asm volatile("s_waitcnt lgkmcnt(0)" ::: "memory")
#define VM_WAIT() asm volatile("s_waitcnt vmcnt(0)" ::: "memory")

constexpr int NWAVES = 8, NTHR = 512;
constexpr int DM = 2048, NPR = 8192, NSR = 512, MROWS = 8704, SEQ = 2048, NBP = 4, NBS = 128, NB = 132, DEPTH = 4;
constexpr int NIN = 4632, NINP = 4864, PW = 4608;
constexpr int DFF = 5504, NUP = 11008;
constexpr int XBCW = 2560, SSDW = 1536, NH = 24, HD = 64, NG = 4, HPG = 6, DS = 128, POOLW = 512;
constexpr int NCH = 16;
constexpr int ADA = 12288;
constexpr float EPS = 1e-6f;

constexpr size_t O_YP = 0, O_YS = O_YP + (size_t)NPR * DM, O_PP = O_YS + (size_t)NSR * DM, O_CP = O_PP + (size_t)DEPTH * NBP * 15 * 512,
                 O_SP = O_CP + (size_t)DEPTH * NBP * 3 * XBCW, O_FP = O_SP + (size_t)DEPTH * NBP * NH * HD * DS, O_PS = O_FP + (size_t)DEPTH * NBP * 2 * DFF,
                 O_CS = O_PS + (size_t)DEPTH * NBS * 15 * 512, O_SS = O_CS + (size_t)DEPTH * NBS * 3 * XBCW, O_FS = O_SS + (size_t)DEPTH * NBS * NH * HD * DS,
                 O_END = O_FS + (size_t)DEPTH * NBS * 2 * DFF;
static_assert(O_END == 135557120ull, "output size");

constexpr size_t al256(size_t x) { return (x + 255) & ~(size_t)255; }
constexpr size_t WS_CTL = 0, CTL_BYTES = 1u << 20;
constexpr size_t WS_WIN = CTL_BYTES,                         SZ_WIN = (size_t)NINP * DM * 2;
constexpr size_t WS_WOUT = WS_WIN + DEPTH * SZ_WIN,          SZ_WOUT = (size_t)DM * DM * 2;
constexpr size_t WS_WUP = WS_WOUT + DEPTH * SZ_WOUT,         SZ_WUP = (size_t)NUP * DM * 2;
constexpr size_t WS_WDN = WS_WUP + DEPTH * SZ_WUP,           SZ_WDN = (size_t)DM * DFF * 2;
constexpr size_t WS_PWT = WS_WDN + DEPTH * SZ_WDN,           SZ_PWT = (size_t)4 * 128 * 128 * 2;
constexpr size_t WS_SC = WS_PWT + DEPTH * SZ_PWT;
constexpr size_t WS_MOD = al256(WS_SC + (size_t)160 * DM * 2);
constexpr size_t WS_H = al256(WS_MOD + (size_t)DEPTH * NB * ADA * 4);
constexpr size_t WS_P = al256(WS_H + (size_t)MROWS * DM * 2);
constexpr size_t WS_DT = al256(WS_P + (size_t)MROWS * PW * 2);
constexpr size_t WS_XC = al256(WS_DT + (size_t)MROWS * 32 * 4);
constexpr size_t WS_DTB = al256(WS_XC + (size_t)MROWS * XBCW * 2);
constexpr size_t WS_CSB = al256(WS_DTB + (size_t)MROWS * NH * 4);
constexpr size_t WS_S = al256(WS_CSB + (size_t)MROWS * NH * 4);
constexpr size_t WS_DEC = al256(WS_S + (size_t)NBP * NCH * NH * HD * DS * 4);
constexpr size_t WS_HS = al256(WS_DEC + (size_t)NBP * NCH * NH * 4);
constexpr size_t WS_MIX = al256(WS_HS + (size_t)NBP * NCH * NH * HD * DS * 2);
constexpr size_t WS_SSQ = al256(WS_MIX + (size_t)MROWS * DM * 2);
constexpr size_t WS_R = al256(WS_SSQ + (size_t)MROWS * NH * 4);
constexpr size_t WS_XA = al256(WS_R + (size_t)MROWS * 4);
constexpr size_t WS_XB = al256(WS_XA + (size_t)MROWS * DM * 4);
constexpr size_t WS_UP = al256(WS_XB + (size_t)MROWS * DM * 4);
constexpr size_t WS_ACT = al256(WS_UP + (size_t)MROWS * NUP * 2);
constexpr size_t WS_END = al256(WS_ACT + (size_t)MROWS * DFF * 2);

constexpr int CW_BAR = 4096;
constexpr int LDS_BYTES = 155648;
constexpr int LDS_MISC = 151552;

__device__ __forceinline__ float bflo(unsigned w) { return __uint_as_float(w << 16); }
__device__ __forceinline__ float bfhi(unsigned w) { return __uint_as_float(w & 0xffff0000u); }
__device__ __forceinline__ float bf1(bf16 b) { return __uint_as_float((unsigned)b << 16); }
__device__ __forceinline__ unsigned pk2(float lo, float hi) { return pg8::cvt_pk_bf16(lo, hi); }
__device__ __forceinline__ bf16 f2bf(float f) { return (bf16)(pk2(f, 0.f) & 0xffffu); }
__device__ __forceinline__ void unpack8(const u32x4 w, float (&v)[8]) { v[0] = bflo(w.x); v[1] = bfhi(w.x); v[2] = bflo(w.y); v[3] = bfhi(w.y); v[4] = bflo(w.z); v[5] = bfhi(w.z); v[6] = bflo(w.w); v[7] = bfhi(w.w); }
__device__ __forceinline__ u32x4 pack8(const float (&v)[8]) { u32x4 o; o.x = pk2(v[0], v[1]); o.y = pk2(v[2], v[3]); o.z = pk2(v[4], v[5]); o.w = pk2(v[6], v[7]); return o; }
__device__ __forceinline__ float silu_f(float x) { return x / (1.f + __expf(-x)); }
__device__ __forceinline__ float softplus_f(float x) { return x > 20.f ? x : log1pf(__expf(x)); }
__device__ __forceinline__ float wave_sum(float v) {
#pragma unroll
    for (int o = 1; o < 64; o <<= 1) v += __shfl_xor(v, o);
    return v;
}
#define MFMA16(a, b, c) __builtin_amdgcn_mfma_f32_16x16x32_bf16((a), (b), (c), 0, 0, 0)
__device__ __forceinline__ bf16x8 as_frag(u32x4 w) { return __builtin_bit_cast(bf16x8, w); }

struct Args {
    const float* in[27]; float* out; unsigned char* ws; int ph_lo, ph_hi;
};

__device__ __forceinline__ int row_bidx(int r) { return r < NPR ? (r >> 11) : 4 + ((r - NPR) >> 2); }

struct EpiProj {
    static constexpr bool PERM = true, AFTER_DRAIN = false;
    bf16* P; float* DT;
    __device__ __forceinline__ void operator()(const pg8::f32x4 (&acc)[2][2][4][2], const pg8::Unit& u, int wr, int wc, int fr, int fq) const {
        const int row0 = u.pm * 256 + wr * 64 + fr;
        if (u.pn < 18) {
            const int col0 = u.pn * 256 + wc * 32 + 8 * fq;
#pragma unroll
            for (int ai = 0; ai < 2; ++ai)
#pragma unroll
                for (int m = 0; m < 4; ++m) { bf16* rowp = P + (size_t)(row0 + ai * 128 + m * 16) * PW + col0;
#pragma unroll
                    for (int bj = 0; bj < 2; ++bj) { const pg8::f32x4 v0 = acc[ai][bj][m][0], v1 = acc[ai][bj][m][1];
                        u32x4 w; w.x = pk2(v0[0], v0[1]); w.y = pk2(v0[2], v0[3]); w.z = pk2(v1[0], v1[1]); w.w = pk2(v1[2], v1[3]);
                        *(u32x4*)(rowp + bj * 128) = w; } }
        } else if (wc == 0) {
#pragma unroll
            for (int ai = 0; ai < 2; ++ai)
#pragma unroll
                for (int m = 0; m < 4; ++m) { float* rowp = DT + (size_t)(row0 + ai * 128 + m * 16) * 32 + 8 * fq;
                    *(f32x4*)(rowp) = acc[ai][0][m][0]; *(f32x4*)(rowp + 4) = acc[ai][0][m][1]; }
        }
    }
};
struct EpiBf {
    static constexpr bool PERM = true, AFTER_DRAIN = false;
    bf16* O; int ldc;
    __device__ __forceinline__ void operator()(const pg8::f32x4 (&acc)[2][2][4][2], const pg8::Unit& u, int wr, int wc, int fr, int fq) const {
        const int row0 = u.pm * 256 + wr * 64 + fr, col0 = u.pn * 256 + wc * 32 + 8 * fq;
#pragma unroll
        for (int ai = 0; ai < 2; ++ai)
#pragma unroll
            for (int m = 0; m < 4; ++m) { bf16* rowp = O + (size_t)(row0 + ai * 128 + m * 16) * ldc + col0;
#pragma unroll
                for (int bj = 0; bj < 2; ++bj) { const pg8::f32x4 v0 = acc[ai][bj][m][0], v1 = acc[ai][bj][m][1];
                    u32x4 w; w.x = pk2(v0[0], v0[1]); w.y = pk2(v0[2], v0[3]); w.z = pk2(v1[0], v1[1]); w.w = pk2(v1[2], v1[3]);
                    *(u32x4*)(rowp + bj * 128) = w; } }
    }
};
struct EpiRes {
    static constexpr bool PERM = false, AFTER_DRAIN = false;
    const float* bp; const float* bs; float* out; const float* gate; const float* rs;
    __device__ __forceinline__ void operator()(const pg8::f32x4 (&acc)[2][2][4][2], const pg8::Unit& u, int wr, int wc, int fr, int fq) const {
        const int row0 = u.pm * 256 + wr * 64 + fr, col0 = u.pn * 256 + wc * 32 + 4 * fq;
#pragma unroll
        for (int ai = 0; ai < 2; ++ai)
#pragma unroll
            for (int m = 0; m < 4; ++m) {
                const int r = row0 + ai * 128 + m * 16;
                const float* brow = (r < NPR ? bp + (size_t)r * DM : bs + (size_t)(r - NPR) * DM) + col0;
                const float* grow = gate + (size_t)row_bidx(r) * ADA + col0;
                const float s = rs ? rs[r] : 1.f;
                float* orow = out + (size_t)r * DM + col0;
#pragma unroll
                for (int bj = 0; bj < 2; ++bj)
#pragma unroll
                    for (int n = 0; n < 2; ++n) { const int o = bj * 128 + n * 16;
                        const pg8::f32x4 b = *(const pg8::f32x4*)(brow + o), g = *(const pg8::f32x4*)(grow + o);
                        *(pg8::f32x4*)(orow + o) = b + g * (acc[ai][bj][m][n] * s); }
            }
    }
};

__device__ __forceinline__ void tr_item(const float* W, int K, int N, int nblk, bf16* WT, int mode, const float* ks0, const float* ks1, LAS float* scr, int item, int lane) {
    const int kb = item / nblk, nb = item % nblk, k0 = 64 * kb, n0 = 32 * nb;
    const int n = n0 + (lane & 31);
#pragma unroll 8
    for (int i = 0; i < 32; ++i) { const int kk = 2 * i + (lane >> 5); float v = (n < N) ? W[(size_t)(k0 + kk) * N + n] : 0.f;
        if (mode == 1) { const int k = k0 + kk; v *= (k < 512) ? ks0[k] : ks1[k - 512]; }
        scr[kk * 33 + (lane & 31)] = v; }
    LDS_WAIT(); asm volatile("" ::: "memory");
    const int c = lane & 7;
#pragma unroll
    for (int j = 0; j < 4; ++j) { const int nl = (lane >> 3) + 8 * j; const LAS float* s = scr + (8 * c) * 33 + nl;
        u32x4 o; o.x = pk2(s[0 * 33], s[1 * 33]); o.y = pk2(s[2 * 33], s[3 * 33]); o.z = pk2(s[4 * 33], s[5 * 33]); o.w = pk2(s[6 * 33], s[7 * 33]);
        const int nn = n0 + nl; int row = nn;
        if (mode == 2) row = nn < DFF ? ((nn >> 7) * 256 + (nn & 127)) : (((nn - DFF) >> 7) * 256 + 128 + ((nn - DFF) & 127));
        *(u32x4*)(WT + (size_t)row * K + k0 + 8 * c) = o; }
    LDS_WAIT(); asm volatile("" ::: "memory");
}
__device__ __forceinline__ void p0a_phase(const Args& a, LAS unsigned char* lds, int G) {
    int tid_ = threadIdx.x; asm volatile("" : "+v"(tid_)); const int tid = tid_, lane = tid & 63, wave = tid >> 6;
    LAS float* scr = (LAS float*)(lds + wave * 8448);
    const int gw = blockIdx.x * NWAVES + wave, NGW = G * NWAVES;
    constexpr int I_IN = 32 * (NINP / 32), I_OUT = 32 * (DM / 32), I_UP = 32 * (NUP / 32), I_DN = (DFF / 64) * (DM / 32), I_PW = 4 * 2 * 4, I_L = I_IN + I_OUT + I_UP + I_DN + I_PW;
    for (int it = gw; it < DEPTH * I_L; it += NGW) {
        const int l = it / I_L; int r = it % I_L;
        if (r < I_IN) { tr_item(a.in[12] + (size_t)l * DM * NIN, DM, NIN, NINP / 32, (bf16*)(a.ws + WS_WIN + l * SZ_WIN), 0, nullptr, nullptr, scr, r, lane); continue; } r -= I_IN;
        if (r < I_OUT) { tr_item(a.in[21] + (size_t)l * DM * DM, DM, DM, DM / 32, (bf16*)(a.ws + WS_WOUT + l * SZ_WOUT), 1, a.in[14] + l * POOLW, a.in[20] + l * SSDW, scr, r, lane); continue; } r -= I_OUT;
        if (r < I_UP) { tr_item(a.in[22] + (size_t)l * DM * NUP, DM, NUP, NUP / 32, (bf16*)(a.ws + WS_WUP + l * SZ_WUP), 2, nullptr, nullptr, scr, r, lane); continue; } r -= I_UP;
        if (r < I_DN) { tr_item(a.in[25] + (size_t)l * DFF * DM, DFF, DM, DM / 32, (bf16*)(a.ws + WS_WDN + l * SZ_WDN), 0, nullptr, nullptr, scr, r, lane); continue; } r -= I_DN;
        { const int g = r / 8, q = r % 8; tr_item(a.in[13] + ((size_t)l * 4 + g) * 128 * 128, 128, 128, 4, (bf16*)(a.ws + WS_PWT + l * SZ_PWT) + (size_t)g * 128 * 128, 0, nullptr, nullptr, scr, q, lane); }
    }
    bf16* SC = (bf16*)(a.ws + WS_SC);
    for (int i = blockIdx.x * NTHR + tid; i < 160 * (DM / 4); i += G * NTHR) {
        const int row = i / (DM / 4), c4 = (i % (DM / 4)) * 4; f32x4 v = (f32x4){0.f, 0.f, 0.f, 0.f};
        if (row < NBP) v = *(const f32x4*)(a.in[2] + (size_t)row * DM + c4); else if (row < NB) v = *(const f32x4*)(a.in[3] + (size_t)(row - NBP) * DM + c4);
        u32x2 o; o.x = pk2(silu_f(v[0]), silu_f(v[1])); o.y = pk2(silu_f(v[2]), silu_f(v[3]));
        *(u32x2*)(SC + (size_t)row * DM + c4) = o;
    }
}
__device__ __forceinline__ void p0b_phase(const Args& a, int G) {
    int tid_ = threadIdx.x; asm volatile("" : "+v"(tid_)); const int tid = tid_, lane = tid & 63, wave = tid >> 6, r = lane & 31, h = lane >> 5;
    const bf16* SC = (const bf16*)(a.ws + WS_SC); float* MOD = (float*)(a.ws + WS_MOD);
    for (int u = blockIdx.x; u < 256; u += G) {
        if (wave >= 6) continue;
        const int l = u >> 6, c0 = (u & 63) * 192 + wave * 32;
        const float* W = a.in[10] + (size_t)l * DM * ADA + c0 + r;
        f32x16 acc[5];
#pragma unroll
        for (int m = 0; m < 5; ++m)
#pragma unroll
            for (int e = 0; e < 16; ++e) acc[m][e] = 0.f;
#pragma unroll 1
        for (int kk = 0; kk < DM / 16; ++kk) {
            const int k0 = kk * 16 + 8 * h;
            float bv[8];
#pragma unroll
            for (int j = 0; j < 8; ++j) bv[j] = W[(size_t)(k0 + j) * ADA];
            const bf16x8 bfr = as_frag(pack8(bv));
#pragma unroll
            for (int m = 0; m < 5; ++m) { const bf16x8 afr = as_frag(*(const u32x4*)(SC + (size_t)(32 * m + r) * DM + k0));
                acc[m] = __builtin_amdgcn_mfma_f32_32x32x16_bf16(afr, bfr, acc[m], 0, 0, 0); }
        }
        const float bias = a.in[11][(size_t)l * ADA + c0 + r];
#pragma unroll
        for (int m = 0; m < 5; ++m)
#pragma unroll
            for (int e4 = 0; e4 < 4; ++e4) {
                const int rowb = 32 * m + 8 * e4 + 4 * h;
                float* p = MOD + ((size_t)l * NB + rowb) * ADA + c0 + r; asm volatile("" : "+v"(p));
#pragma unroll
                for (int e = 0; e < 4; ++e) if (rowb + e < NB) p[(size_t)e * ADA] = acc[m][4 * e4 + e] + bias;
            }
    }
}
__device__ __forceinline__ void norm_phase(const float* xp, const float* xs, const float* gamma, const float* modl, int shc, bf16* H, int G) {
    int tid_ = threadIdx.x; asm volatile("" : "+v"(tid_)); const int tid = tid_, lane = tid & 63, wave = tid >> 6;
    for (int row = blockIdx.x * NWAVES + wave; row < MROWS; row += G * NWAVES) {
        const float* xr = (row < NPR ? xp + (size_t)row * DM : xs + (size_t)(row - NPR) * DM) + 4 * lane;
        f32x4 v[8]; float ss = 0.f;
#pragma unroll
        for (int j = 0; j < 8; ++j) { v[j] = *(const f32x4*)(xr + 256 * j); ss += (v[j][0] * v[j][0] + v[j][1] * v[j][1]) + (v[j][2] * v[j][2] + v[j][3] * v[j][3]); }
        const float rstd = 1.f / sqrtf(wave_sum(ss) * (1.f / DM) + EPS);
        const float* mrow = modl + (size_t)row_bidx(row) * ADA + 4 * lane;
        bf16* hr = H + (size_t)row * DM + 4 * lane;
#pragma unroll
        for (int j = 0; j < 8; ++j) { const f32x4 g = *(const f32x4*)(gamma + 256 * j + 4 * lane), sh = *(const f32x4*)(mrow + shc * DM + 256 * j), sc = *(const f32x4*)(mrow + (shc + 1) * DM + 256 * j);
            const f32x4 y = (v[j] * rstd) * g * (sc + 1.f) + sh;
            u32x2 o; o.x = pk2(y[0], y[1]); o.y = pk2(y[2], y[3]); *(u32x2*)(hr + 256 * j) = o; }
    }
}
__device__ __forceinline__ void final_phase(const float* X, const float* gamma, float* out, int G) {
    int tid_ = threadIdx.x; asm volatile("" : "+v"(tid_)); const int tid = tid_, lane = tid & 63, wave = tid >> 6;
    for (int row = blockIdx.x * NWAVES + wave; row < MROWS; row += G * NWAVES) {
        const float* xr = X + (size_t)row * DM + 4 * lane;
        f32x4 v[8]; float ss = 0.f;
#pragma unroll
        for (int j = 0; j < 8; ++j) { v[j] = *(const f32x4*)(xr + 256 * j); ss += (v[j][0] * v[j][0] + v[j][1] * v[j][1]) + (v[j][2] * v[j][2] + v[j][3] * v[j][3]); }
        const float rstd = 1.f / sqrtf(wave_sum(ss) * (1.f / DM) + EPS);
        float* orow = out + (size_t)row * DM + 4 * lane;
#pragma unroll
        for (int j = 0; j < 8; ++j) { const f32x4 g = *(const f32x4*)(gamma + 256 * j + 4 * lane); *(f32x4*)(orow + 256 * j) = (v[j] * rstd) * g; }
    }
}
#define XB_TMO      128
#define XB_XCNT(j)  (256  + 64 * (j))
#define XB_XSUB(j)  (1280 + 64 * (j))
#define XB_XGEN(j)  (2304 + 64 * (j))
#define XB_TOP      3328
#define XB_TOPGEN   3392
#define XCD_BAR_WORDS 3456
#define XB_SPIN_CAP (1u << 18)

__device__ __forceinline__ unsigned xb_ld(unsigned* p)              { return __hip_atomic_load(p, __ATOMIC_RELAXED, __HIP_MEMORY_SCOPE_AGENT); }
__device__ __forceinline__ unsigned xb_add(unsigned* p, unsigned v) { return __hip_atomic_fetch_add(p, v, __ATOMIC_RELAXED, __HIP_MEMORY_SCOPE_AGENT); }
__device__ __forceinline__ unsigned xb_xcc_id() { return (unsigned)__builtin_amdgcn_s_getreg((3 << 11) | 20) & 0xFu; }
#define XB_SPIN(cond, bar) do { unsigned _sp = 0; while (cond) { __builtin_amdgcn_s_sleep(1); \
    if ((++_sp & 255u) == 0u) { if (xb_ld(&(bar)[XB_TMO])) break; if (_sp > XB_SPIN_CAP) { atomicAdd(&(bar)[XB_TMO], 1u); break; } } } } while (0)

struct XcdBarrier {
    unsigned* bar; unsigned x;
    volatile LAS unsigned* st;
};

__device__ __forceinline__ XcdBarrier xcd_barrier_post(unsigned* bar, volatile LAS unsigned* st) {
    XcdBarrier b; b.bar = bar; b.x = xb_xcc_id(); b.st = st;
    if (threadIdx.x == 0) (void)xb_add(&bar[XB_XCNT(b.x)], 1u);
    return b;
}
__device__ __forceinline__ void xcd_barrier_complete(unsigned* bar, unsigned x, unsigned& nloc, unsigned& nx) {
    const unsigned G = gridDim.x * gridDim.y * gridDim.z;
    unsigned sum, cnt, mine, sp = 0u;
    for (;;) {
        sum = 0u; cnt = 0u; mine = 0u;
#pragma unroll
        for (unsigned j = 0; j < 16; ++j) { const unsigned c = xb_ld(&bar[XB_XCNT(j)]); sum += c; cnt += (c > 0u) ? 1u : 0u; mine = (j == x) ? c : mine; }
        if (sum == G) break;
        __builtin_amdgcn_s_sleep(1);
        if ((++sp & 255u) == 0u) { if (xb_ld(&bar[XB_TMO])) break; if (sp > XB_SPIN_CAP) { atomicAdd(&bar[XB_TMO], 1u); break; } }
    }
    nloc = mine > 0u ? mine : 1u; nx = cnt > 0u ? cnt : 1u;
}

__device__ __forceinline__ void xcd_barrier(const XcdBarrier& b) {
    asm volatile("s_waitcnt vmcnt(0)" ::: "memory");
    __syncthreads();
    if (threadIdx.x == 0) {
        unsigned* bar = b.bar;
        __builtin_amdgcn_s_waitcnt(0);
        unsigned nloc = b.st[0], nx = b.st[1];
        if (nloc == 0u) { xcd_barrier_complete(bar, b.x, nloc, nx); b.st[0] = nloc; b.st[1] = nx; }
        const unsigned old = xb_add(&bar[XB_XSUB(b.x)], 1u);
        const unsigned gen = old / nloc;
        if (old + 1u == (gen + 1u) * nloc) {
            __builtin_amdgcn_fence(__ATOMIC_RELEASE, "agent");
            asm volatile("s_waitcnt vmcnt(0)" ::: "memory");
            const unsigned og = xb_add(&bar[XB_TOP], 1u);
            const unsigned tg = og / nx;
            if (og + 1u == (tg + 1u) * nx) xb_add(&bar[XB_TOPGEN], 1u);
            else XB_SPIN(xb_ld(&bar[XB_TOPGEN]) == tg, bar);
            __builtin_amdgcn_fence(__ATOMIC_ACQUIRE, "agent");
            xb_add(&bar[XB_XGEN(b.x)], 1u);
            asm volatile("s_waitcnt vmcnt(0)" ::: "memory");
        } else {
            XB_SPIN(xb_ld(&bar[XB_XGEN(b.x)]) == gen, bar);
            __builtin_amdgcn_fence(__ATOMIC_ACQUIRE, "agent");
            asm volatile("s_waitcnt vmcnt(0)" ::: "memory");
        }
    }
    __syncthreads();
}

constexpr int LSTR = 136;
__device__ __forceinline__ int k1_chan(int g, int ch8) { return ch8 < 48 ? 384 * g + 8 * ch8 : (ch8 < 64 ? SSDW + 128 * g + 8 * (ch8 - 48) : SSDW + 512 + 128 * g + 8 * (ch8 - 64)); }

__device__ __forceinline__ void k1_phase(const Args& a, int l, LAS unsigned char* lds, int G) {
    int tid_ = threadIdx.x; asm volatile("" : "+v"(tid_)); const int tid = tid_, lane = tid & 63, wave = __builtin_amdgcn_readfirstlane(tid >> 6), q = lane >> 4, fr = lane & 15;
    const bf16* P = (const bf16*)(a.ws + WS_P); const float* DT = (const float*)(a.ws + WS_DT);
    bf16* XC = (bf16*)(a.ws + WS_XC); float* DTB = (float*)(a.ws + WS_DTB); float* CSB = (float*)(a.ws + WS_CSB);
    float* S = (float*)(a.ws + WS_S); float* DEC = (float*)(a.ws + WS_DEC);
    const float* cw = a.in[15] + (size_t)l * 4 * XBCW; const float* cb = a.in[16] + (size_t)l * XBCW;
    const float* dtb = a.in[17] + l * NH; const float* alog = a.in[18] + l * NH;
    LAS bf16* xdT = (LAS bf16*)lds;
    LAS bf16* BT = (LAS bf16*)(lds + 6 * 64 * LSTR * 2);
    LAS float* csL = (LAS float*)(lds + 6 * 64 * LSTR * 2 + 128 * LSTR * 2);
    LAS float* scL = csL + 6 * 128;
    for (int u = blockIdx.x; u < NBP * NCH * NG; u += G) {
        const int b = u >> 6, c = (u >> 2) & 15, g = u & 3, r0 = b * SEQ + c * 128;
        if (wave < HPG) {
            const int h = HPG * g + wave; const float A = -__expf(alog[h]), bias = dtb[h];
            const int t0 = 2 * lane;
            const float d0 = softplus_f(DT[(size_t)(r0 + t0) * 32 + h] + bias), d1 = softplus_f(DT[(size_t)(r0 + t0 + 1) * 32 + h] + bias);
            const float a0 = d0 * A, a1 = d1 * A; float s = a0 + a1;
#pragma unroll
            for (int o = 1; o < 64; o <<= 1) { const float t = __shfl_up(s, o); if (lane >= o) s += t; }
            const float cs1 = s, cs0 = s - a1, tot = __shfl(s, 63);
            csL[wave * 128 + t0] = cs0; csL[wave * 128 + t0 + 1] = cs1;
            scL[wave * 128 + t0] = d0 * __expf(tot - cs0); scL[wave * 128 + t0 + 1] = d1 * __expf(tot - cs1);
            DTB[(size_t)(r0 + t0) * NH + h] = d0; DTB[(size_t)(r0 + t0 + 1) * NH + h] = d1;
            CSB[(size_t)(r0 + t0) * NH + h] = cs0; CSB[(size_t)(r0 + t0 + 1) * NH + h] = cs1;
            if (lane == 0) DEC[(b * NCH + c) * NH + h] = __expf(tot);
        }
        __syncthreads();
        for (int it = tid; it < 80 * 16; it += NTHR) {
            const int ch8 = it % 80, tt0 = (it / 80) * 8, j0 = k1_chan(g, ch8);
            float w[4][8], bb[8];
#pragma unroll
            for (int i = 0; i < 4; ++i) { const f32x4 w0 = *(const f32x4*)(cw + i * XBCW + j0), w1 = *(const f32x4*)(cw + i * XBCW + j0 + 4);
#pragma unroll
                for (int j = 0; j < 4; ++j) { w[i][j] = w0[j]; w[i][4 + j] = w1[j]; } }
            { const f32x4 b0 = *(const f32x4*)(cb + j0), b1 = *(const f32x4*)(cb + j0 + 4);
#pragma unroll
              for (int j = 0; j < 4; ++j) { bb[j] = b0[j]; bb[4 + j] = b1[j]; } }
            float xm3[8], xm2[8], xm1[8];
            const bf16* src = P + (size_t)(r0 + tt0) * PW + 2048 + j0;
            const bool has_prev = (c * 128 + tt0) > 0;
            if (has_prev) { unpack8(*(const u32x4*)(src - 3 * PW), xm3); unpack8(*(const u32x4*)(src - 2 * PW), xm2); unpack8(*(const u32x4*)(src - PW), xm1); }
            else {
#pragma unroll
                for (int j = 0; j < 8; ++j) { xm3[j] = 0.f; xm2[j] = 0.f; xm1[j] = 0.f; } }
#pragma unroll
            for (int t = 0; t < 8; ++t) {
                float cur[8], o[8]; unpack8(*(const u32x4*)(src + (size_t)t * PW), cur);
#pragma unroll
                for (int j = 0; j < 8; ++j) o[j] = silu_f(bb[j] + w[0][j] * xm3[j] + w[1][j] * xm2[j] + w[2][j] * xm1[j] + w[3][j] * cur[j]);
                *(u32x4*)(XC + (size_t)(r0 + tt0 + t) * XBCW + j0) = pack8(o);
                const int tt = tt0 + t;
                if (ch8 < 48) { const int hh = ch8 >> 3, p0 = 8 * (ch8 & 7); const float sc = scL[hh * 128 + tt];
#pragma unroll
                    for (int j = 0; j < 8; ++j) xdT[(hh * 64 + p0 + j) * LSTR + tt] = f2bf(o[j] * sc);
                } else if (ch8 < 64) { const int n0 = 8 * (ch8 - 48);
#pragma unroll
                    for (int j = 0; j < 8; ++j) BT[(n0 + j) * LSTR + tt] = f2bf(o[j]); }
#pragma unroll
                for (int j = 0; j < 8; ++j) { xm3[j] = xm2[j]; xm2[j] = xm1[j]; xm1[j] = cur[j]; }
            }
        }
        if (c == NCH - 1) {
            float* o = a.out + O_CP + ((size_t)l * NBP + b) * 3 * XBCW;
            for (int it = tid; it < 3 * 640; it += NTHR) { const int i = it / 640, cc = it % 640, j = k1_chan(g, cc >> 3) + (cc & 7);
                o[i * XBCW + j] = bf1(P[(size_t)(r0 + 125 + i) * PW + 2048 + j]); }
        }
        __syncthreads();
#pragma unroll 1
        for (int hh = 0; hh < HPG; ++hh) {
            f32x4 acc[4];
#pragma unroll
            for (int pt = 0; pt < 4; ++pt) acc[pt] = (f32x4){0.f, 0.f, 0.f, 0.f};
#pragma unroll
            for (int ks = 0; ks < 4; ++ks) {
                const bf16x8 bfr = *(const LAS bf16x8*)(BT + (16 * wave + fr) * LSTR + 32 * ks + 8 * q);
#pragma unroll
                for (int pt = 0; pt < 4; ++pt) { const bf16x8 afr = *(const LAS bf16x8*)(xdT + (hh * 64 + 16 * pt + fr) * LSTR + 32 * ks + 8 * q);
                    acc[pt] = MFMA16(bfr, afr, acc[pt]); }
            }
            float* so = S + ((size_t)(b * NCH + c) * NH + HPG * g + hh) * (HD * DS) + 16 * wave + 4 * q;
#pragma unroll
            for (int pt = 0; pt < 4; ++pt) *(f32x4*)(so + (size_t)(16 * pt + fr) * DS) = acc[pt];
        }
        __syncthreads();
    }
    {
        const float* st = a.in[5] + (size_t)l * NBS * 3 * XBCW;
        float* oc = a.out + O_CS + (size_t)l * NBS * 3 * XBCW;
        for (int it = blockIdx.x * NTHR + tid; it < NBS * (XBCW / 8); it += G * NTHR) {
            const int bs = it / (XBCW / 8), j0 = (it % (XBCW / 8)) * 8, rs0 = NPR + 4 * bs;
            float full[7][8];
#pragma unroll
            for (int i = 0; i < 3; ++i) { const f32x4 p0 = *(const f32x4*)(st + ((size_t)bs * 3 + i) * XBCW + j0), p1 = *(const f32x4*)(st + ((size_t)bs * 3 + i) * XBCW + j0 + 4);
#pragma unroll
                for (int j = 0; j < 4; ++j) { full[i][j] = p0[j]; full[i][4 + j] = p1[j]; } }
#pragma unroll
            for (int t = 0; t < 4; ++t) unpack8(*(const u32x4*)(P + (size_t)(rs0 + t) * PW + 2048 + j0), full[3 + t]);
            float w[4][8], bb[8];
#pragma unroll
            for (int i = 0; i < 4; ++i) { const f32x4 w0 = *(const f32x4*)(cw + i * XBCW + j0), w1 = *(const f32x4*)(cw + i * XBCW + j0 + 4);
#pragma unroll
                for (int j = 0; j < 4; ++j) { w[i][j] = w0[j]; w[i][4 + j] = w1[j]; } }
            { const f32x4 b0 = *(const f32x4*)(cb + j0), b1 = *(const f32x4*)(cb + j0 + 4);
#pragma unroll
              for (int j = 0; j < 4; ++j) { bb[j] = b0[j]; bb[4 + j] = b1[j]; } }
#pragma unroll
            for (int t = 0; t < 4; ++t) { float o[8];
#pragma unroll
                for (int j = 0; j < 8; ++j) o[j] = silu_f(bb[j] + w[0][j] * full[t][j] + w[1][j] * full[t + 1][j] + w[2][j] * full[t + 2][j] + w[3][j] * full[t + 3][j]);
                *(u32x4*)(XC + (size_t)(rs0 + t) * XBCW + j0) = pack8(o); }
#pragma unroll
            for (int i = 0; i < 3; ++i) { float* o = oc + ((size_t)bs * 3 + i) * XBCW + j0;
                *(f32x4*)o = (f32x4){full[4 + i][0], full[4 + i][1], full[4 + i][2], full[4 + i][3]}; *(f32x4*)(o + 4) = (f32x4){full[4 + i][4], full[4 + i][5], full[4 + i][6], full[4 + i][7]}; }
        }
        for (int it = blockIdx.x * NTHR + tid; it < NSR * NH; it += G * NTHR) { const int r = NPR + it / NH, h = it % NH;
            DTB[(size_t)r * NH + h] = softplus_f(DT[(size_t)r * 32 + h] + dtb[h]); }
    }
}

__device__ __forceinline__ void k2_phase(const Args& a, int l, int G) {
    int tid_ = threadIdx.x; asm volatile("" : "+v"(tid_)); const int tid = tid_, lane = tid & 63, wave = tid >> 6, q = lane >> 4, fr = lane & 15;
    const float* S = (const float*)(a.ws + WS_S); const float* DEC = (const float*)(a.ws + WS_DEC); bf16* HS = (bf16*)(a.ws + WS_HS);
    for (int it = blockIdx.x * NTHR + tid; it < NBP * NH * (HD * DS / 4); it += G * NTHR) {
        const int bh = it / (HD * DS / 4), e = (it % (HD * DS / 4)) * 4, b = bh / NH, h = bh % NH;
        f32x4 H = (f32x4){0.f, 0.f, 0.f, 0.f};
#pragma unroll 4
        for (int c = 0; c < NCH; ++c) {
            const size_t o = ((size_t)(b * NCH + c) * NH + h) * (HD * DS) + e;
            u32x2 w; w.x = pk2(H[0], H[1]); w.y = pk2(H[2], H[3]); *(u32x2*)(HS + o) = w;
            const float d = DEC[(b * NCH + c) * NH + h]; const f32x4 s = *(const f32x4*)(S + o);
            H = H * d + s;
        }
        *(f32x4*)(a.out + O_SP + (((size_t)l * NBP + b) * NH + h) * (HD * DS) + e) = H;
    }
    const bf16* XC = (const bf16*)(a.ws + WS_XC); const bf16* P = (const bf16*)(a.ws + WS_P); const float* DTB = (const float*)(a.ws + WS_DTB);
    bf16* MIX = (bf16*)(a.ws + WS_MIX); float* SSQ = (float*)(a.ws + WS_SSQ);
    const float* alog = a.in[18] + l * NH; const float* dsk = a.in[19] + l * NH;
    for (int u = blockIdx.x * NWAVES + wave; u < NBS * NH; u += G * NWAVES) {
        const int bs = u / NH, h = u % NH, g = h / HPG, rs0 = NPR + 4 * bs;
        const float A = -__expf(alog[h]), Dh = dsk[h];
        float dt[4], cs[4]; { float s = 0.f;
#pragma unroll
            for (int t = 0; t < 4; ++t) { dt[t] = DTB[(size_t)(rs0 + t) * NH + h]; s += dt[t] * A; cs[t] = s; } }
        bf16x8 cfr[4]; u32x4 brow[4];
#pragma unroll
        for (int ks = 0; ks < 4; ++ks) { u32x4 z = (u32x4){0u, 0u, 0u, 0u}, zb = z;
            if (fr < 4) { z = *(const u32x4*)(XC + (size_t)(rs0 + fr) * XBCW + SSDW + 512 + 128 * g + 32 * ks + 8 * q); zb = *(const u32x4*)(XC + (size_t)(rs0 + fr) * XBCW + SSDW + 128 * g + 32 * ks + 8 * q); }
            cfr[ks] = as_frag(z); brow[ks] = zb; }
        f32x4 cb4 = (f32x4){0.f, 0.f, 0.f, 0.f};
#pragma unroll
        for (int ks = 0; ks < 4; ++ks) cb4 = MFMA16(cfr[ks], as_frag(brow[ks]), cb4);
        float Wm[4][4];
#pragma unroll
        for (int t = 0; t < 4; ++t)
#pragma unroll
            for (int s = 0; s < 4; ++s) Wm[t][s] = 0.f;
#pragma unroll
        for (int t = 0; t < 4; ++t)
#pragma unroll
            for (int s = 0; s < 4; ++s) if (s <= t) Wm[t][s] = __int_as_float(__builtin_amdgcn_readlane(__float_as_int(cb4[t]), s)) * __expf(cs[t] - cs[s]) * dt[s];
        float coef[4];
#pragma unroll
        for (int s = 0; s < 4; ++s) coef[s] = dt[s] * __expf(cs[3] - cs[s]);
        const float e3 = __expf(cs[3]);
        const float* h0 = a.in[6] + (((size_t)l * NBS + bs) * NH + h) * (HD * DS);
        float* hn = a.out + O_SS + (((size_t)l * NBS + bs) * NH + h) * (HD * DS);
        float ysum[4] = {0.f, 0.f, 0.f, 0.f};
#pragma unroll 1
        for (int pt = 0; pt < 4; ++pt) {
            const int p = 16 * pt + fr;
            float xs[4];
#pragma unroll
            for (int s = 0; s < 4; ++s) xs[s] = bf1(XC[(size_t)(rs0 + s) * XBCW + h * HD + p]);
            f32x4 yo = (f32x4){0.f, 0.f, 0.f, 0.f};
#pragma unroll
            for (int ks = 0; ks < 4; ++ks) {
                const float* hp = h0 + (size_t)p * DS + 32 * ks + 8 * q;
                const f32x4 v0 = *(const f32x4*)hp, v1 = *(const f32x4*)(hp + 4);
                float hv[8] = {v0[0], v0[1], v0[2], v0[3], v1[0], v1[1], v1[2], v1[3]}, nv[8];
#pragma unroll
                for (int j = 0; j < 8; ++j) nv[j] = e3 * hv[j];
#pragma unroll
                for (int s = 0; s < 4; ++s) { u32x4 bw; bw.x = __shfl(brow[ks].x, 16 * q + s); bw.y = __shfl(brow[ks].y, 16 * q + s); bw.z = __shfl(brow[ks].z, 16 * q + s); bw.w = __shfl(brow[ks].w, 16 * q + s);
                    float bvv[8]; unpack8(bw, bvv); const float cx = coef[s] * xs[s];
#pragma unroll
                    for (int j = 0; j < 8; ++j) nv[j] += cx * bvv[j]; }
                float* np = hn + (size_t)p * DS + 32 * ks + 8 * q;
                *(f32x4*)np = (f32x4){nv[0], nv[1], nv[2], nv[3]}; *(f32x4*)(np + 4) = (f32x4){nv[4], nv[5], nv[6], nv[7]};
                yo = MFMA16(cfr[ks], as_frag(pack8(hv)), yo);
            }
            if (lane < 16) {
#pragma unroll
                for (int t = 0; t < 4; ++t) {
                    float y = __expf(cs[t]) * yo[t] + Dh * xs[t];
#pragma unroll
                    for (int s = 0; s < 4; ++s) if (s <= t) y += Wm[t][s] * xs[s];
                    const float z = bf1(P[(size_t)(rs0 + t) * PW + POOLW + h * HD + p]);
                    const float yg = y * silu_f(z);
                    MIX[(size_t)(rs0 + t) * DM + POOLW + h * HD + p] = f2bf(yg);
                    ysum[t] += yg * yg;
                }
            }
        }
#pragma unroll
        for (int t = 0; t < 4; ++t) { float s = ysum[t]; s += __shfl_xor(s, 1); s += __shfl_xor(s, 2); s += __shfl_xor(s, 4); s += __shfl_xor(s, 8);
            if (lane == 0) SSQ[(size_t)(rs0 + t) * NH + h] = s; }
    }
}

__device__ __forceinline__ void k3_phase(const Args& a, int l, LAS unsigned char* lds, int G) {
    int tid_ = threadIdx.x; asm volatile("" : "+v"(tid_)); const int tid = tid_, lane = tid & 63, wave = __builtin_amdgcn_readfirstlane(tid >> 6), q = lane >> 4, fr = lane & 15;
    const bf16* XC = (const bf16*)(a.ws + WS_XC); const bf16* P = (const bf16*)(a.ws + WS_P);
    const float* DTB = (const float*)(a.ws + WS_DTB); const float* CSB = (const float*)(a.ws + WS_CSB); const bf16* HS = (const bf16*)(a.ws + WS_HS);
    bf16* MIX = (bf16*)(a.ws + WS_MIX); float* SSQ = (float*)(a.ws + WS_SSQ);
    const float* dsk = a.in[19] + l * NH;
    LAS bf16* Cs = (LAS bf16*)lds;
    LAS bf16* Bs = Cs + 128 * LSTR;
    LAS bf16* xT = Bs + 128 * LSTR;
    LAS bf16* Ms = xT + 64 * LSTR;
    LAS float* csL = (LAS float*)(Ms + 8 * 16 * LSTR);
    LAS float* dtL = csL + 6 * 128;
    for (int u = blockIdx.x; u < NBP * NCH * NG; u += G) {
        const int b = u >> 6, c = (u >> 2) & 15, g = u & 3, r0 = b * SEQ + c * 128;
        for (int it = tid; it < 2 * 128 * 16; it += NTHR) { const int m = it >> 11, row = (it >> 4) & 127, k8 = (it & 15) * 8;
            const u32x4 v = *(const u32x4*)(XC + (size_t)(r0 + row) * XBCW + SSDW + (m ? 0 : 512) + 128 * g + k8);
            *(LAS u32x4*)((m ? Bs : Cs) + row * LSTR + k8) = v; }
        for (int it = tid; it < 6 * 128; it += NTHR) { const int hh = it >> 7, t = it & 127;
            csL[it] = CSB[(size_t)(r0 + t) * NH + HPG * g + hh]; dtL[it] = DTB[(size_t)(r0 + t) * NH + HPG * g + hh]; }
        __syncthreads();
        bf16x8 cf[4];
#pragma unroll
        for (int ks = 0; ks < 4; ++ks) cf[ks] = *(const LAS bf16x8*)(Cs + (16 * wave + fr) * LSTR + 32 * ks + 8 * q);
        f32x4 gacc[8];
#pragma unroll
        for (int st = 0; st < 8; ++st) { gacc[st] = (f32x4){0.f, 0.f, 0.f, 0.f};
            if (st <= wave) {
#pragma unroll
                for (int ks = 0; ks < 4; ++ks) { const bf16x8 bfr = *(const LAS bf16x8*)(Bs + (16 * st + fr) * LSTR + 32 * ks + 8 * q); gacc[st] = MFMA16(bfr, cf[ks], gacc[st]); } } }
        const int lrow = 16 * wave + fr;
#pragma unroll 1
        for (int hh = 0; hh < HPG; ++hh) {
            const int h = HPG * g + hh;
            for (int it = tid; it < 128 * 8; it += NTHR) { const int s = it >> 3, p8 = (it & 7) * 8; float xv[8];
                unpack8(*(const u32x4*)(XC + (size_t)(r0 + s) * XBCW + h * HD + p8), xv);
#pragma unroll
                for (int j = 0; j < 8; ++j) xT[(p8 + j) * LSTR + s] = f2bf(xv[j]); }
            const float csl = csL[hh * 128 + lrow];
#pragma unroll
            for (int st = 0; st < 8; ++st) {
                if (st <= (wave | 1)) { float mv[4];
#pragma unroll
                    for (int r = 0; r < 4; ++r) { const int s = 16 * st + 4 * q + r;
                        mv[r] = (st <= wave && s <= lrow) ? gacc[st][r] * __expf(csl - csL[hh * 128 + s]) * dtL[hh * 128 + s] : 0.f; }
                    u32x2 w; w.x = pk2(mv[0], mv[1]); w.y = pk2(mv[2], mv[3]);
                    *(LAS u32x2*)(Ms + (wave * 16 + fr) * LSTR + 16 * st + 4 * q) = w; } }
            __syncthreads();
            f32x4 y1[4], y2[4];
#pragma unroll
            for (int pt = 0; pt < 4; ++pt) { y1[pt] = (f32x4){0.f, 0.f, 0.f, 0.f}; y2[pt] = (f32x4){0.f, 0.f, 0.f, 0.f}; }
            const bf16* hs = HS + ((size_t)(b * NCH + c) * NH + h) * (HD * DS);
#pragma unroll
            for (int ks = 0; ks < 4; ++ks) {
                if (2 * ks <= wave) { const bf16x8 mfr = *(const LAS bf16x8*)(Ms + (wave * 16 + fr) * LSTR + 32 * ks + 8 * q);
#pragma unroll
                    for (int pt = 0; pt < 4; ++pt) { const bf16x8 xfr = *(const LAS bf16x8*)(xT + (16 * pt + fr) * LSTR + 32 * ks + 8 * q); y1[pt] = MFMA16(xfr, mfr, y1[pt]); } }
#pragma unroll
                for (int pt = 0; pt < 4; ++pt) { const bf16x8 hfr = as_frag(*(const u32x4*)(hs + (size_t)(16 * pt + fr) * DS + 32 * ks + 8 * q)); y2[pt] = MFMA16(hfr, cf[ks], y2[pt]); }
            }
            const float ecs = __expf(csl), Dh = dsk[h]; const int row = r0 + lrow; float ss = 0.f;
#pragma unroll
            for (int pt = 0; pt < 4; ++pt) { const int p0 = 16 * pt + 4 * q;
                const u32x2 xw = *(const u32x2*)(XC + (size_t)row * XBCW + h * HD + p0), zw = *(const u32x2*)(P + (size_t)row * PW + POOLW + h * HD + p0);
                const float xv[4] = {bflo(xw.x), bfhi(xw.x), bflo(xw.y), bfhi(xw.y)}, zv[4] = {bflo(zw.x), bfhi(zw.x), bflo(zw.y), bfhi(zw.y)}; float yg[4];
#pragma unroll
                for (int r = 0; r < 4; ++r) { const float y = y1[pt][r] + ecs * y2[pt][r] + Dh * xv[r]; yg[r] = y * silu_f(zv[r]); ss += yg[r] * yg[r]; }
                u32x2 w; w.x = pk2(yg[0], yg[1]); w.y = pk2(yg[2], yg[3]);
                *(u32x2*)(MIX + (size_t)row * DM + POOLW + h * HD + p0) = w; }
            ss += __shfl_xor(ss, 16); ss += __shfl_xor(ss, 32);
            if (q == 0) SSQ[(size_t)row * NH + h] = ss;
            __syncthreads();
        }
    }
}

__device__ __forceinline__ void pool_phase(const Args& a, int l, int G) {
    int tid_ = threadIdx.x; asm volatile("" : "+v"(tid_)); const int tid = tid_, lane = tid & 63, wave = tid >> 6, q = lane >> 4, fr = lane & 15;
    const bf16* P = (const bf16*)(a.ws + WS_P); const bf16* PWT = (const bf16*)(a.ws + WS_PWT + l * SZ_PWT);
    bf16* MIX = (bf16*)(a.ws + WS_MIX); const float* SSQ = (const float*)(a.ws + WS_SSQ); float* R = (float*)(a.ws + WS_R);
    const float* stp = a.in[4] + (size_t)l * NBS * 15 * POOLW;
    for (int u = blockIdx.x * NWAVES + wave; u < (MROWS / 16) * 4; u += G * NWAVES) {
        const int rb = u >> 2, g = u & 3, row = 16 * rb + fr, w = 2 << g;
        float ssum = 0.f;
#pragma unroll
        for (int i = 0; i < 6; ++i) { const f32x4 v = *(const f32x4*)(SSQ + (size_t)row * NH + 4 * i); ssum += (v[0] + v[1]) + (v[2] + v[3]); }
        const float rr = sqrtf(ssum * (1.f / SSDW) + EPS);
        if (g == 0 && q == 0) R[row] = 1.f / rr;
        f32x4 acc[8];
#pragma unroll
        for (int nt = 0; nt < 8; ++nt) acc[nt] = (f32x4){0.f, 0.f, 0.f, 0.f};
#pragma unroll 1
        for (int ks = 0; ks < 4; ++ks) {
            const int ch = 128 * g + 32 * ks + 8 * q; float sum[8], cur[8];
            unpack8(*(const u32x4*)(P + (size_t)row * PW + ch), cur);
#pragma unroll
            for (int j = 0; j < 8; ++j) sum[j] = cur[j];
            float cnt;
            if (row < NPR) { const int pos = row & (SEQ - 1), nw = (pos + 1 < w) ? pos + 1 : w; cnt = (float)nw;
                for (int i = 1; i < nw; ++i) { float v[8]; unpack8(*(const u32x4*)(P + (size_t)(row - i) * PW + ch), v);
#pragma unroll
                    for (int j = 0; j < 8; ++j) sum[j] += v[j]; }
            } else { const int seq = (row - NPR) >> 2, t4 = (row - NPR) & 3; cnt = (float)w;
                for (int i = 1; i < w; ++i) { float v[8];
                    if (t4 - i >= 0) unpack8(*(const u32x4*)(P + (size_t)(row - i) * PW + ch), v);
                    else { const float* sp = stp + ((size_t)seq * 15 + (15 + t4 - i)) * POOLW + ch; const f32x4 v0 = *(const f32x4*)sp, v1 = *(const f32x4*)(sp + 4);
                        v[0] = v0[0]; v[1] = v0[1]; v[2] = v0[2]; v[3] = v0[3]; v[4] = v1[0]; v[5] = v1[1]; v[6] = v1[2]; v[7] = v1[3]; }
#pragma unroll
                    for (int j = 0; j < 8; ++j) sum[j] += v[j]; }
            }
            const float ic = 1.f / cnt; float d[8];
#pragma unroll
            for (int j = 0; j < 8; ++j) d[j] = sum[j] * ic - cur[j];
            const bf16x8 dfr = as_frag(pack8(d));
#pragma unroll
            for (int nt = 0; nt < 8; ++nt) { const bf16x8 wfr = as_frag(*(const u32x4*)(PWT + ((size_t)g * 128 + 16 * nt + fr) * 128 + 32 * ks + 8 * q)); acc[nt] = MFMA16(wfr, dfr, acc[nt]); }
        }
#pragma unroll
        for (int nt = 0; nt < 8; ++nt) { u32x2 o; o.x = pk2(acc[nt][0] * rr, acc[nt][1] * rr); o.y = pk2(acc[nt][2] * rr, acc[nt][3] * rr);
            *(u32x2*)(MIX + (size_t)row * DM + 128 * g + 16 * nt + 4 * q) = o; }
    }
    { float* o = a.out + O_PP + (size_t)l * NBP * 15 * POOLW;
      for (int it = blockIdx.x * NTHR + tid; it < NBP * 15 * POOLW; it += G * NTHR) { const int b = it / (15 * POOLW), i = (it / POOLW) % 15, cc = it % POOLW;
          o[it] = bf1(P[(size_t)(b * SEQ + SEQ - 15 + i) * PW + cc]); }
      float* os = a.out + O_PS + (size_t)l * NBS * 15 * POOLW;
      for (int it = blockIdx.x * NTHR + tid; it < NBS * 15 * POOLW; it += G * NTHR) { const int bs = it / (15 * POOLW), i = (it / POOLW) % 15, cc = it % POOLW;
          os[it] = i < 11 ? stp[((size_t)bs * 15 + i + 4) * POOLW + cc] : bf1(P[(size_t)(NPR + 4 * bs + i - 11) * PW + cc]); } }
}

__device__ __forceinline__ void act_phase(const Args& a, int l, int G) {
    int tid_ = threadIdx.x; asm volatile("" : "+v"(tid_)); const int tid = tid_;
    const bf16* UP = (const bf16*)(a.ws + WS_UP); bf16* ACT = (bf16*)(a.ws + WS_ACT);
    const float* fw = a.in[23] + (size_t)l * 3 * DFF; const float* fb = a.in[24] + (size_t)l * DFF;
    const float* stf = a.in[7] + (size_t)l * NBS * 2 * DFF;
    for (int it = blockIdx.x * NTHR + tid; it < (MROWS / 4) * (DFF / 8); it += G * NTHR) {
        const int run = it / (DFF / 8), j0 = (it % (DFF / 8)) * 8, row0 = 4 * run;
        const int ucol = (j0 >> 7) * 256 + (j0 & 127);
        float w[3][8], bb[8];
#pragma unroll
        for (int i = 0; i < 3; ++i) { const f32x4 w0 = *(const f32x4*)(fw + i * DFF + j0), w1 = *(const f32x4*)(fw + i * DFF + j0 + 4);
#pragma unroll
            for (int j = 0; j < 4; ++j) { w[i][j] = w0[j]; w[i][4 + j] = w1[j]; } }
        { const f32x4 b0 = *(const f32x4*)(fb + j0), b1 = *(const f32x4*)(fb + j0 + 4);
#pragma unroll
          for (int j = 0; j < 4; ++j) { bb[j] = b0[j]; bb[4 + j] = b1[j]; } }
        float g2[8], g1[8];
        if (row0 < NPR) {
            if ((row0 & (SEQ - 1)) == 0) {
#pragma unroll
                for (int j = 0; j < 8; ++j) { g2[j] = 0.f; g1[j] = 0.f; }
            } else { unpack8(*(const u32x4*)(UP + (size_t)(row0 - 2) * NUP + ucol), g2); unpack8(*(const u32x4*)(UP + (size_t)(row0 - 1) * NUP + ucol), g1); }
        } else { const int bs = (row0 - NPR) >> 2; const float* s0 = stf + ((size_t)bs * 2) * DFF + j0;
            const f32x4 a0 = *(const f32x4*)s0, a1 = *(const f32x4*)(s0 + 4), c0 = *(const f32x4*)(s0 + DFF), c1 = *(const f32x4*)(s0 + DFF + 4);
#pragma unroll
            for (int j = 0; j < 4; ++j) { g2[j] = a0[j]; g2[4 + j] = a1[j]; g1[j] = c0[j]; g1[4 + j] = c1[j]; } }
#pragma unroll
        for (int t = 0; t < 4; ++t) {
            float gc[8], vv[8], o[8];
            unpack8(*(const u32x4*)(UP + (size_t)(row0 + t) * NUP + ucol), gc); unpack8(*(const u32x4*)(UP + (size_t)(row0 + t) * NUP + ucol + 128), vv);
#pragma unroll
            for (int j = 0; j < 8; ++j) o[j] = silu_f(bb[j] + w[0][j] * g2[j] + w[1][j] * g1[j] + w[2][j] * gc[j]) * vv[j];
            *(u32x4*)(ACT + (size_t)(row0 + t) * DFF + j0) = pack8(o);
#pragma unroll
            for (int j = 0; j < 8; ++j) { g2[j] = g1[j]; g1[j] = gc[j]; }
        }
        if (row0 < NPR) { if ((row0 & (SEQ - 1)) == SEQ - 4) { float* o = a.out + O_FP + (((size_t)l * NBP + (row0 >> 11)) * 2) * DFF + j0;
                *(f32x4*)o = (f32x4){g2[0], g2[1], g2[2], g2[3]}; *(f32x4*)(o + 4) = (f32x4){g2[4], g2[5], g2[6], g2[7]};
                *(f32x4*)(o + DFF) = (f32x4){g1[0], g1[1], g1[2], g1[3]}; *(f32x4*)(o + DFF + 4) = (f32x4){g1[4], g1[5], g1[6], g1[7]}; } }
        else { float* o = a.out + O_FS + (((size_t)l * NBS + ((row0 - NPR) >> 2)) * 2) * DFF + j0;
            *(f32x4*)o = (f32x4){g2[0], g2[1], g2[2], g2[3]}; *(f32x4*)(o + 4) = (f32x4){g2[4], g2[5], g2[6], g2[7]};
            *(f32x4*)(o + DFF) = (f32x4){g1[0], g1[1], g1[2], g1[3]}; *(f32x4*)(o + DFF + 4) = (f32x4){g1[4], g1[5], g1[6], g1[7]}; }
    }
}

constexpr int PH_P0A = 0, PH_P0B = 1, PH_L0 = 2, PH_PER_LAYER = 11, PH_FINAL = PH_L0 + DEPTH * PH_PER_LAYER, N_PHASES = PH_FINAL + 1;
#ifndef N_LAUNCH_MODE
#define N_LAUNCH_MODE 0
#endif

__device__ __forceinline__ int grid_size() { int g = gridDim.x; asm volatile("" : "+s"(g)); return g; }
__global__ void __launch_bounds__(NTHR, 2) fwd_kernel(Args a) {
    extern __shared__ __attribute__((aligned(16))) unsigned char lds_raw[];
    LAS unsigned char* lds = (LAS unsigned char*)lds_raw;
    const int tid = threadIdx.x;
#define G grid_size()
    volatile LAS unsigned* misc = (volatile LAS unsigned*)(lds + LDS_MISC);
    if (tid < 64) misc[tid] = 0u;
    __syncthreads();
    XcdBarrier bar; bar.bar = (unsigned*)(a.ws + WS_CTL) + CW_BAR; bar.x = 0; bar.st = misc + 8;
    const int lo = a.ph_lo, hi = a.ph_hi;
    if (hi - lo > 1) bar = xcd_barrier_post((unsigned*)(a.ws + WS_CTL) + CW_BAR, misc + 8);
#ifndef PH_MASK
#define PH_MASK 0xFFFFFFFFu
#endif
#define EN(b) (((PH_MASK) >> (b)) & 1u)
#define IN(k) (lo <= (k) && (k) < hi)
#define SEAM(k) do { if ((k) + 1 < hi) xcd_barrier(bar); } while (0)

    if (EN(0) && IN(PH_P0A)) { p0a_phase(a, lds, G); SEAM(PH_P0A); }
    if (EN(1) && IN(PH_P0B)) { p0b_phase(a, G); SEAM(PH_P0B); }

#define WSP(T, off) ((T*)(a.ws + (off)))
#pragma unroll 1
    for (int l = 0; l < DEPTH; ++l) {
        const int pb = PH_L0 + l * PH_PER_LAYER;
#define MODL (WSP(const float, WS_MOD) + (size_t)l * NB * ADA)
#define XIN_P (l == 0 ? a.in[0] : WSP(const float, WS_XA))
#define XIN_S (l == 0 ? a.in[1] : WSP(const float, WS_XA) + (size_t)NPR * DM)
        if (EN(2) && IN(pb + 0)) { norm_phase(XIN_P, XIN_S, a.in[8] + l * DM, MODL, 0, WSP(bf16, WS_H), G); SEAM(pb + 0); }
        if (EN(3) && IN(pb + 1)) {
            pg8::Gemm g{WSP(const bf16, WS_H), (const bf16*)(a.ws + WS_WIN + l * SZ_WIN), MROWS, NINP, DM}; pg8::StaticOrder S; S.init(MROWS, NINP, G, (int)blockIdx.x);
            EpiProj E{WSP(bf16, WS_P), WSP(float, WS_DT)};
            pg8::gemm_phase<EpiProj, pg8::StaticOrder, true, true>(lds, g, S, E);
            SEAM(pb + 1);
        }
        if (EN(4) && IN(pb + 2)) { k1_phase(a, l, lds, G); SEAM(pb + 2); }
        if (EN(5) && IN(pb + 3)) { k2_phase(a, l, G); SEAM(pb + 3); }
        if (EN(6) && IN(pb + 4)) { k3_phase(a, l, lds, G); SEAM(pb + 4); }
        if (EN(7) && IN(pb + 5)) { pool_phase(a, l, G); SEAM(pb + 5); }
        if (EN(8) && IN(pb + 6)) {
            pg8::Gemm g{WSP(const bf16, WS_MIX), (const bf16*)(a.ws + WS_WOUT + l * SZ_WOUT), MROWS, DM, DM}; pg8::StaticOrder S; S.init(MROWS, DM, G, (int)blockIdx.x);
            EpiRes E{XIN_P, XIN_S, WSP(float, WS_XB), MODL + 2 * DM, WSP(const float, WS_R)};
            pg8::gemm_phase<EpiRes, pg8::StaticOrder, true, true>(lds, g, S, E);
            SEAM(pb + 6);
        }
        if (EN(9) && IN(pb + 7)) { norm_phase(WSP(const float, WS_XB), WSP(const float, WS_XB) + (size_t)NPR * DM, a.in[9] + l * DM, MODL, 3, WSP(bf16, WS_H), G); SEAM(pb + 7); }
        if (EN(10) && IN(pb + 8)) {
            pg8::Gemm g{WSP(const bf16, WS_H), (const bf16*)(a.ws + WS_WUP + l * SZ_WUP), MROWS, NUP, DM}; pg8::StaticOrder S; S.init(MROWS, NUP, G, (int)blockIdx.x);
            EpiBf E{WSP(bf16, WS_UP), NUP};
            pg8::gemm_phase<EpiBf, pg8::StaticOrder, true, true>(lds, g, S, E);
            SEAM(pb + 8);
        }
        if (EN(11) && IN(pb + 9)) { act_phase(a, l, G); SEAM(pb + 9); }
        if (EN(12) && IN(pb + 10)) {
            pg8::Gemm g{WSP(const bf16, WS_ACT), (const bf16*)(a.ws + WS_WDN + l * SZ_WDN), MROWS, DM, DFF}; pg8::StaticOrder S; S.init(MROWS, DM, G, (int)blockIdx.x);
            EpiRes E{WSP(const float, WS_XB), WSP(const float, WS_XB) + (size_t)NPR * DM, WSP(float, WS_XA), MODL + 5 * DM, nullptr};
            pg8::gemm_phase<EpiRes, pg8::StaticOrder, true, true>(lds, g, S, E);
            SEAM(pb + 10);
        }
    }
    if (EN(13) && IN(PH_FINAL)) final_phase(WSP(const float, WS_XA), a.in[26], a.out + O_YP, G);
#undef IN
#undef SEAM
#undef G
}

extern "C" void kernel_launch(void* const* d_in, const int* in_sizes, int n_in, void* d_out, int out_size, void* d_ws, size_t ws_size, hipStream_t stream) {
    static int grid = 0;
    if (grid == 0) {
        if (n_in != 27 || (size_t)out_size != O_END || ws_size < WS_END) { fprintf(stderr, "kernel_launch: unexpected problem shape (n_in %d, out %d, ws %zu; need ws >= %zu)\n", n_in, out_size, ws_size, (size_t)WS_END); grid = -1; return; }
        int dev = 0, cus = 0, per_cu = 0;
        if (hipGetDevice(&dev) != hipSuccess || hipDeviceGetAttribute(&cus, hipDeviceAttributeMultiprocessorCount, dev) != hipSuccess) { grid = -1; return; }
        if (hipFuncSetAttribute((const void*)fwd_kernel, hipFuncAttributeMaxDynamicSharedMemorySize, LDS_BYTES) != hipSuccess) { fprintf(stderr, "kernel_launch: hipFuncSetAttribute failed\n"); grid = -1; return; }
        if (hipOccupancyMaxActiveBlocksPerMultiprocessor(&per_cu, (const void*)fwd_kernel, NTHR, LDS_BYTES) != hipSuccess || per_cu < 1) { fprintf(stderr, "kernel_launch: occupancy query says %d blocks per CU\n", per_cu); (void)hipGetLastError(); grid = -1; return; }
        grid = cus;
    }
    if (grid < 0) return;
    (void)hipMemsetAsync((char*)d_ws + WS_CTL, 0, CTL_BYTES, stream);
    Args a{};
    for (int i = 0; i < 27; ++i) a.in[i] = (const float*)d_in[i];
    a.out = (float*)d_out; a.ws = (unsigned char*)d_ws;
#if N_LAUNCH_MODE == 1
    a.ph_lo = 0; a.ph_hi = N_PHASES;
    hipLaunchKernelGGL(fwd_kernel, dim3(grid), dim3(NTHR), LDS_BYTES, stream, a);
#else
    for (int p = 0; p < N_PHASES; ++p) { a.ph_lo = p; a.ph_hi = p + 1; hipLaunchKernelGGL(fwd_kernel, dim3(grid), dim3(NTHR), LDS_BYTES, stream, a); }
#endif
}
```

```cpp
#include <hip/hip_runtime.h>
#include <cstdio>
#include <cstdint>
namespace pg8 {
#define PG8_LAS __attribute__((address_space(3)))
typedef unsigned short bf16_t;
typedef short bf16x8 __attribute__((ext_vector_type(8)));
typedef float f32x4 __attribute__((ext_vector_type(4)));
typedef unsigned u32x4 __attribute__((ext_vector_type(4)));
constexpr int BM = 256, BK = 64, HALF = 128, HTB = HALF * BK * 2  , STAGE_BYTES = 8 * HTB, NXCD = 8, WGM = 8;

__host__ __device__ __forceinline__ int lds_byte(int r, int c) { const int st = (r >> 4) * 2 + (c >> 5), rr = r & 15, cc = c & 31, ob = rr * 64 + cc * 2; return st * 1024 + (ob ^ (((ob >> 9) & 1) << 5)); }
__host__ __device__ __forceinline__ void stage_rc(int b, int& R, int& C) { const int st = b / 1024, sb = b % 1024, swz = sb ^ (((sb >> 9) & 1) << 5); R = (st >> 1) * 16 + swz / 64; C = (st & 1) * 32 + (swz % 64) / 2; }
__host__ __device__ __forceinline__ int perm32(int rho) { const int n = rho >> 4, i = rho & 15; return 8 * (i >> 2) + 4 * n + (i & 3); }

struct Unit { int pm, pn; };
struct Gemm { const bf16_t* A; const bf16_t* Bt; int M, N, K; };

struct StaticOrder {
    int nM, nN, nwg, G, c;
    __host__ __device__ void init(int M, int N, int G_, int c_) { nM = M / BM; nN = N / BM; nwg = nM * nN; G = G_; c = c_; }
    __host__ __device__ bool next(int i, Unit& u) const {
        const long L = (long)i * G + c; if (L >= nwg) return false;
        int wgid = (int)L; { const int q = nwg / NXCD, r = nwg % NXCD, xcd = wgid % NXCD, off = wgid / NXCD; wgid = (xcd < r ? xcd * (q + 1) : r * (q + 1) + (xcd - r) * q) + off; }
        const int nig = WGM * nN, gid = wgid / nig, fm = gid * WGM, gsz = (nM - fm) < WGM ? (nM - fm) : WGM;
        u.pm = fm + ((wgid % nig) % gsz); u.pn = (wgid % nig) / gsz; return true;
    }
    __device__ __forceinline__ void a_ready(const Unit&) const {}
    __device__ __forceinline__ void done(const Unit&) const {}
};

__device__ __forceinline__ unsigned cvt_pk_bf16(float lo, float hi) { unsigned r; asm volatile("v_cvt_pk_bf16_f32 %0, %1, %2" : "=v"(r) : "v"(lo), "v"(hi)); return r; }
typedef float f32x2 __attribute__((ext_vector_type(2)));
template <class Epi, class Sched, bool ALIGN_EPI = false, bool SP2 = false>
__device__ __forceinline__ void gemm_phase(PG8_LAS unsigned char* lds, const Gemm g, const Sched& S, const Epi& E) {
    int tid_ = threadIdx.x; asm volatile("" : "+v"(tid_)); const int tid = tid_, wid = __builtin_amdgcn_readfirstlane(tid >> 6), lane = tid & 63, wr = wid >> 2, wc = wid & 3, fr = lane & 15, fq = lane >> 4;
    const int K = g.K, nt = K / BK;
    unsigned voffA[2], voffB[2];
#pragma unroll
    for (int i = 0; i < 2; ++i) { int R, C; stage_rc(tid * 16 + i * 8192, R, C); const int Rb = Epi::PERM ? ((R & ~31) + perm32(R & 31)) : R;
        voffA[i] = (unsigned)(R * K + C) * 2u; voffB[i] = (unsigned)(Rb * K + C) * 2u; }
    const size_t kstep = (size_t)(BK * 2);
    const size_t hstep = (size_t)HALF * K * 2;
    const size_t tstep = 2 * hstep;
    const unsigned ldsw = (unsigned)wid * 1024u;
    const int aoff = lds_byte(wr * 64 + fr, fq * 8), boff = lds_byte(wc * 32 + fr, fq * 8);
#define PG8_SA(b, h) (((b) * 2 + (h)) * HTB)
#define PG8_SB(b, h) ((4 + (b) * 2 + (h)) * HTB)
#define PG8_STAGE(bufoff, gbase, voff) do { _Pragma("unroll") for (int _i = 0; _i < 2; ++_i) \
        __builtin_amdgcn_global_load_lds((const unsigned*)((const char*)(gbase) + (voff)[_i]), (PG8_LAS unsigned*)(lds + (bufoff) + ldsw + _i * 8192), 16, 0, 0); } while (0)
#define PG8_LDA(dst, b, h) do { _Pragma("unroll") for (int m = 0; m < 4; ++m) _Pragma("unroll") for (int k = 0; k < 2; ++k) dst[m][k] = *(const PG8_LAS bf16x8*)(lds + PG8_SA(b, h) + aoff + m * 2048 + k * 1024); } while (0)
#define PG8_LDB(dst, b, h) do { _Pragma("unroll") for (int n = 0; n < 2; ++n) _Pragma("unroll") for (int k = 0; k < 2; ++k) dst[n][k] = *(const PG8_LAS bf16x8*)(lds + PG8_SB(b, h) + boff + n * 2048 + k * 1024); } while (0)
#define PG8_MMA(ai, bj, At, Bt) do { __builtin_amdgcn_s_setprio(1); _Pragma("unroll") for (int m = 0; m < 4; ++m) _Pragma("unroll") for (int n = 0; n < 2; ++n) _Pragma("unroll") for (int k = 0; k < 2; ++k) \
        acc[ai][bj][m][n] = __builtin_amdgcn_mfma_f32_16x16x32_bf16(Bt[n][k], At[m][k], acc[ai][bj][m][n], 0, 0, 0); __builtin_amdgcn_s_setprio(0); } while (0)
#define PG8_WAIT_V(n) asm volatile("s_waitcnt vmcnt(" #n ")" ::: "memory")
#define PG8_WAIT_L(n) asm volatile("s_waitcnt lgkmcnt(" #n ")" ::: "memory")
#define PG8_BAR __builtin_amdgcn_s_barrier()
#define PG8_SCHED __builtin_amdgcn_sched_barrier(0)
    Unit cur, nxt; int ui = 0;
    if (!S.next(0, cur)) return;
    f32x4 acc[2][2][4][2];
#pragma unroll
    for (int a = 0; a < 2; ++a)
#pragma unroll
        for (int b = 0; b < 2; ++b)
#pragma unroll
            for (int m = 0; m < 4; ++m)
#pragma unroll
                for (int n = 0; n < 2; ++n) acc[a][b][m][n] = (f32x4){0.f, 0.f, 0.f, 0.f};
    bf16x8 At[4][2], B0[2][2], B1[2][2];
    const char* cA = (const char*)g.A + (size_t)cur.pm * tstep; const char* cB = (const char*)g.Bt + (size_t)cur.pn * tstep;
    S.a_ready(cur);
    if constexpr (SP2) {
        PG8_STAGE(PG8_SB(0, 0), cB, voffB); PG8_STAGE(PG8_SB(0, 1), cB + hstep, voffB); PG8_STAGE(PG8_SA(0, 0), cA, voffA); PG8_STAGE(PG8_SA(0, 1), cA + hstep, voffA);
        if (wr == 1) PG8_BAR;
        PG8_WAIT_V(2); PG8_BAR;
        PG8_STAGE(PG8_SB(1, 0), cB + kstep, voffB); PG8_STAGE(PG8_SA(1, 0), cA + kstep, voffA); PG8_STAGE(PG8_SB(1, 1), cB + hstep + kstep, voffB);
        PG8_WAIT_V(6); PG8_BAR;
    } else {
        PG8_STAGE(PG8_SB(0, 0), cB, voffB); PG8_STAGE(PG8_SA(0, 0), cA, voffA); PG8_STAGE(PG8_SB(0, 1), cB + hstep, voffB); PG8_STAGE(PG8_SA(0, 1), cA + hstep, voffA);
        if (wr == 1) PG8_BAR;
        PG8_WAIT_V(4); PG8_BAR;
        PG8_STAGE(PG8_SB(1, 0), cB + kstep, voffB); PG8_STAGE(PG8_SA(1, 0), cA + kstep, voffA); PG8_STAGE(PG8_SB(1, 1), cB + hstep + kstep, voffB);
        PG8_WAIT_V(6); PG8_BAR;
    }
    for (;;) {
        const bool has_next = S.next(ui + 1, nxt);
        const char* nA = has_next ? (const char*)g.A + (size_t)nxt.pm * tstep : cA; const char* nB = has_next ? (const char*)g.Bt + (size_t)nxt.pn * tstep : cB;
        for (int t = 0; t < nt; t += 2) {
            const bool last = (t == nt - 2);
            const char* a1 = cA + (size_t)(t + 1) * kstep;
            const char* a2 = last ? nA : cA + (size_t)(t + 2) * kstep; const char* b2 = last ? nB : cB + (size_t)(t + 2) * kstep;
            const char* a3 = a2 + kstep; const char* b3 = b2 + kstep;
            if (last && has_next) S.a_ready(nxt);
            if constexpr (SP2) {
            PG8_LDB(B0, 0, 0); PG8_LDB(B1, 0, 1); PG8_SCHED; PG8_LDA(At, 0, 0); PG8_STAGE(PG8_SA(1, 1), a1 + hstep, voffA);
            PG8_WAIT_V(8); PG8_WAIT_L(0); PG8_BAR; PG8_MMA(0, 0, At, B0); PG8_MMA(0, 1, At, B1); PG8_BAR; PG8_SCHED;
            PG8_LDA(At, 0, 1); PG8_STAGE(PG8_SB(0, 0), b2, voffB); PG8_STAGE(PG8_SB(0, 1), b2 + hstep, voffB); PG8_STAGE(PG8_SA(0, 0), a2, voffA);
            PG8_WAIT_V(8); PG8_WAIT_L(0); PG8_BAR; PG8_MMA(1, 0, At, B0); PG8_MMA(1, 1, At, B1); PG8_BAR; PG8_SCHED;
            PG8_LDB(B0, 1, 0); PG8_LDB(B1, 1, 1); PG8_SCHED; PG8_LDA(At, 1, 0); PG8_STAGE(PG8_SA(0, 1), a2 + hstep, voffA);
            PG8_WAIT_V(8); PG8_WAIT_L(0); PG8_BAR; PG8_MMA(0, 0, At, B0); PG8_MMA(0, 1, At, B1); PG8_BAR; PG8_SCHED;
            PG8_LDA(At, 1, 1); PG8_STAGE(PG8_SB(1, 0), b3, voffB); PG8_STAGE(PG8_SB(1, 1), b3 + hstep, voffB); PG8_STAGE(PG8_SA(1, 0), a3, voffA);
            PG8_WAIT_V(8); PG8_WAIT_L(0); PG8_BAR; PG8_MMA(1, 0, At, B0); PG8_MMA(1, 1, At, B1); PG8_BAR; PG8_SCHED;
            } else {
            PG8_LDB(B0, 0, 0); PG8_SCHED; PG8_LDA(At, 0, 0); PG8_STAGE(PG8_SA(1, 1), a1 + hstep, voffA);
            PG8_WAIT_L(8); PG8_BAR; PG8_WAIT_L(0); PG8_MMA(0, 0, At, B0); PG8_BAR; PG8_SCHED;
            PG8_LDB(B1, 0, 1); PG8_STAGE(PG8_SB(0, 0), b2, voffB);
            PG8_BAR; PG8_WAIT_L(0); PG8_MMA(0, 1, At, B1); PG8_BAR;
            PG8_LDA(At, 0, 1); PG8_STAGE(PG8_SA(0, 0), a2, voffA);
            PG8_BAR; PG8_WAIT_L(0); PG8_MMA(1, 0, At, B0); PG8_BAR; PG8_SCHED;
            PG8_STAGE(PG8_SB(0, 1), b2 + hstep, voffB);
            PG8_WAIT_V(6); PG8_BAR; PG8_MMA(1, 1, At, B1); PG8_BAR;
            PG8_LDB(B0, 1, 0); PG8_SCHED; PG8_LDA(At, 1, 0); PG8_STAGE(PG8_SA(0, 1), a2 + hstep, voffA);
            PG8_WAIT_L(8); PG8_BAR; PG8_WAIT_L(0); PG8_MMA(0, 0, At, B0); PG8_BAR; PG8_SCHED;
            PG8_LDB(B1, 1, 1); PG8_STAGE(PG8_SB(1, 0), b3, voffB);
            PG8_BAR; PG8_WAIT_L(0); PG8_MMA(0, 1, At, B1); PG8_BAR;
            PG8_LDA(At, 1, 1); PG8_STAGE(PG8_SA(1, 0), a3, voffA);
            PG8_BAR; PG8_WAIT_L(0); PG8_MMA(1, 0, At, B0); PG8_BAR; PG8_SCHED;
            PG8_STAGE(PG8_SB(1, 1), b3 + hstep, voffB);
            PG8_WAIT_V(6); PG8_BAR; PG8_MMA(1, 1, At, B1); PG8_BAR;
            }
        }
        if constexpr (ALIGN_EPI) { if (wr == 0) PG8_BAR; }
        if constexpr (!Epi::AFTER_DRAIN) { E(acc, cur, wr, wc, fr, fq); S.done(cur); }
        if (!has_next) break;
#pragma unroll
        for (int a = 0; a < 2; ++a)
#pragma unroll
            for (int b = 0; b < 2; ++b)
#pragma unroll
                for (int m = 0; m < 4; ++m)
#pragma unroll
                    for (int n = 0; n < 2; ++n) acc[a][b][m][n] = (f32x4){0.f, 0.f, 0.f, 0.f};
        cur = nxt; cA = nA; cB = nB; ++ui;
        if constexpr (ALIGN_EPI) { if (wr == 1) PG8_BAR; }
    }
    PG8_WAIT_V(0);
    if constexpr (!ALIGN_EPI) { if (wr == 0) PG8_BAR; }
    PG8_BAR;
    if constexpr (Epi::AFTER_DRAIN) { E.fused(acc, cur, wr, wc, fr, fq, lds, wid, lane); S.done(cur); }
#undef PG8_SA
#undef PG8_SB
#undef PG8_STAGE
#undef PG8_LDA
#undef PG8_LDB
#undef PG8_MMA
#undef PG8_WAIT_V
#undef PG8_WAIT_L
#undef PG8_BAR
#undef PG8_SCHED
}
}

#define LAS __attribute__((address_space(3)))
#define GAS __attribute__((address_space(1)))
typedef unsigned short bf16;
typedef short bf16x8 __attribute__((ext_vector_type(8)));
typedef float f32x4 __attribute__((ext_vector_type(4)));
typedef float f32x16 __attribute__((ext_vector_type(16)));
typedef unsigned u32x4 __attribute__((ext_vector_type(4)));
typedef unsigned u32x2 __attribute__((ext_vector_type(2)));
#define RLX_AGENT __ATOMIC_RELAXED, __HIP_MEMORY_SCOPE_AGENT
#define LDS_WAIT() asm volatile("s_waitcnt lgkmcnt(0)" ::: "memory")
#define VM_WAIT() asm volatile("s_waitcnt vmcnt(0)" ::: "memory")

constexpr int NWAVES = 8, NTHR = 512;
constexpr int DM = 2048, NPR = 8192, NSR = 512, MROWS = 8704, SEQ = 2048, NBP = 4, NBS = 128, NB = 132, DEPTH = 4;
constexpr int NIN = 4632, NINP = 4864, PW = 4608;
constexpr int DFF = 5504, NUP = 11008;
constexpr int XBCW = 2560, SSDW = 1536, NH = 24, HD = 64, NG = 4, HPG = 6, DS = 128, POOLW = 512;
constexpr int NCH = 16;
constexpr int ADA = 12288;
constexpr float EPS = 1e-6f;

constexpr size_t O_YP = 0, O_YS = O_YP + (size_t)NPR * DM, O_PP = O_YS + (size_t)NSR * DM, O_CP = O_PP + (size_t)DEPTH * NBP * 15 * 512,
                 O_SP = O_CP + (size_t)DEPTH * NBP * 3 * XBCW, O_FP = O_SP + (size_t)DEPTH * NBP * NH * HD * DS, O_PS = O_FP + (size_t)DEPTH * NBP * 2 * DFF,
                 O_CS = O_PS + (size_t)DEPTH * NBS * 15 * 512, O_SS = O_CS + (size_t)DEPTH * NBS * 3 * XBCW, O_FS = O_SS + (size_t)DEPTH * NBS * NH * HD * DS,
                 O_END = O_FS + (size_t)DEPTH * NBS * 2 * DFF;
static_assert(O_END == 135557120ull, "output size");

constexpr size_t al256(size_t x) { return (x + 255) & ~(size_t)255; }
constexpr size_t WS_CTL = 0, CTL_BYTES = 1u << 20;
constexpr size_t WS_WIN = CTL_BYTES,                         SZ_WIN = (size_t)NINP * DM * 2;
constexpr size_t WS_WOUT = WS_WIN + DEPTH * SZ_WIN,          SZ_WOUT = (size_t)DM * DM * 2;
constexpr size_t WS_WUP = WS_WOUT + DEPTH * SZ_WOUT,         SZ_WUP = (size_t)NUP * DM * 2;
constexpr size_t WS_WDN = WS_WUP + DEPTH * SZ_WUP,           SZ_WDN = (size_t)DM * DFF * 2;
constexpr size_t WS_PWT = WS_WDN + DEPTH * SZ_WDN,           SZ_PWT = (size_t)4 * 128 * 128 * 2;
constexpr size_t WS_SC = WS_PWT + DEPTH * SZ_PWT;
constexpr size_t WS_MOD = al256(WS_SC + (size_t)160 * DM * 2);
constexpr size_t WS_H = al256(WS_MOD + (size_t)DEPTH * NB * ADA * 4);
constexpr size_t WS_P = al256(WS_H + (size_t)MROWS * DM * 2);
constexpr size_t WS_DT = al256(WS_P + (size_t)MROWS * PW * 2);
constexpr size_t WS_XC = al256(WS_DT + (size_t)MROWS * 32 * 4);
constexpr size_t WS_DTB = al256(WS_XC + (size_t)MROWS * XBCW * 2);
constexpr size_t WS_CSB = al256(WS_DTB + (size_t)MROWS * NH * 4);
constexpr size_t WS_S = al256(WS_CSB + (size_t)MROWS * NH * 4);
constexpr size_t WS_DEC = al256(WS_S + (size_t)NBP * NCH * NH * HD * DS * 4);
constexpr size_t WS_HS = al256(WS_DEC + (size_t)NBP * NCH * NH * 4);
constexpr size_t WS_MIX = al256(WS_HS + (size_t)NBP * NCH * NH * HD * DS * 2);
constexpr size_t WS_SSQ = al256(WS_MIX + (size_t)MROWS * DM * 2);
constexpr size_t WS_R = al256(WS_SSQ + (size_t)MROWS * NH * 4);
constexpr size_t WS_XA = al256(WS_R + (size_t)MROWS * 4);
constexpr size_t WS_XB = al256(WS_XA + (size_t)MROWS * DM * 4);
constexpr size_t WS_UP = al256(WS_XB + (size_t)MROWS * DM * 4);
constexpr size_t WS_ACT = al256(WS_UP + (size_t)MROWS * NUP * 2);
constexpr size_t WS_END = al256(WS_ACT + (size_t)MROWS * DFF * 2);

constexpr int CW_BAR = 4096;
constexpr int LDS_BYTES = 155648;
constexpr int LDS_MISC = 151552;

__device__ __forceinline__ float bflo(unsigned w) { return __uint_as_float(w << 16); }
__device__ __forceinline__ float bfhi(unsigned w) { return __uint_as_float(w & 0xffff0000u); }
__device__ __forceinline__ float bf1(bf16 b) { return __uint_as_float((unsigned)b << 16); }
__device__ __forceinline__ unsigned pk2(float lo, float hi) { return pg8::cvt_pk_bf16(lo, hi); }
__device__ __forceinline__ bf16 f2bf(float f) { return (bf16)(pk2(f, 0.f) & 0xffffu); }
__device__ __forceinline__ void unpack8(const u32x4 w, float (&v)[8]) { v[0] = bflo(w.x); v[1] = bfhi(w.x); v[2] = bflo(w.y); v[3] = bfhi(w.y); v[4] = bflo(w.z); v[5] = bfhi(w.z); v[6] = bflo(w.w); v[7] = bfhi(w.w); }
__device__ __forceinline__ u32x4 pack8(const float (&v)[8]) { u32x4 o; o.x = pk2(v[0], v[1]); o.y = pk2(v[2], v[3]); o.z = pk2(v[4], v[5]); o.w = pk2(v[6], v[7]); return o; }
__device__ __forceinline__ float silu_f(float x) { return x / (1.f + __expf(-x)); }
__device__ __forceinline__ float softplus_f(float x) { return x > 20.f ? x : log1pf(__expf(x)); }
__device__ __forceinline__ float wave_sum(float v) {
#pragma unroll
    for (int o = 1; o < 64; o <<= 1) v += __shfl_xor(v, o);
    return v;
}
#define MFMA16(a, b, c) __builtin_amdgcn_mfma_f32_16x16x32_bf16((a), (b), (c), 0, 0, 0)
__device__ __forceinline__ bf16x8 as_frag(u32x4 w) { return __builtin_bit_cast(bf16x8, w); }

struct Args {
    const float* in[27]; float* out; unsigned char* ws; int ph_lo, ph_hi;
};

__device__ __forceinline__ int row_bidx(int r) { return r < NPR ? (r >> 11) : 4 + ((r - NPR) >> 2); }

struct EpiProj {
    static constexpr bool PERM = true, AFTER_DRAIN = false;
    bf16* P; float* DT;
    __device__ __forceinline__ void operator()(const pg8::f32x4 (&acc)[2][2][4][2], const pg8::Unit& u, int wr, int wc, int fr, int fq) const {
        const int row0 = u.pm * 256 + wr * 64 + fr;
        if (u.pn < 18) {
            const int col0 = u.pn * 256 + wc * 32 + 8 * fq;
#pragma unroll
            for (int ai = 0; ai < 2; ++ai)
#pragma unroll
                for (int m = 0; m < 4; ++m) { bf16* rowp = P + (size_t)(row0 + ai * 128 + m * 16) * PW + col0;
#pragma unroll
                    for (int bj = 0; bj < 2; ++bj) { const pg8::f32x4 v0 = acc[ai][bj][m][0], v1 = acc[ai][bj][m][1];
                        u32x4 w; w.x = pk2(v0[0], v0[1]); w.y = pk2(v0[2], v0[3]); w.z = pk2(v1[0], v1[1]); w.w = pk2(v1[2], v1[3]);
                        *(u32x4*)(rowp + bj * 128) = w; } }
        } else if (wc == 0) {
#pragma unroll
            for (int ai = 0; ai < 2; ++ai)
#pragma unroll
                for (int m = 0; m < 4; ++m) { float* rowp = DT + (size_t)(row0 + ai * 128 + m * 16) * 32 + 8 * fq;
                    *(f32x4*)(rowp) = acc[ai][0][m][0]; *(f32x4*)(rowp + 4) = acc[ai][0][m][1]; }
        }
    }
};
struct EpiBf {
    static constexpr bool PERM = true, AFTER_DRAIN = false;
    bf16* O; int ldc;
    __device__ __forceinline__ void operator()(const pg8::f32x4 (&acc)[2][2][4][2], const pg8::Unit& u, int wr, int wc, int fr, int fq) const {
        const int row0 = u.pm * 256 + wr * 64 + fr, col0 = u.pn * 256 + wc * 32 + 8 * fq;
#pragma unroll
        for (int ai = 0; ai < 2; ++ai)
#pragma unroll
            for (int m = 0; m < 4; ++m) { bf16* rowp = O + (size_t)(row0 + ai * 128 + m * 16) * ldc + col0;
#pragma unroll
                for (int bj = 0; bj < 2; ++bj) { const pg8::f32x4 v0 = acc[ai][bj][m][0], v1 = acc[ai][bj][m][1];
                    u32x4 w; w.x = pk2(v0[0], v0[1]); w.y = pk2(v0[2], v0[3]); w.z = pk2(v1[0], v1[1]); w.w = pk2(v1[2], v1[3]);
                    *(u32x4*)(rowp + bj * 128) = w; } }
    }
};
struct EpiRes {
    static constexpr bool PERM = false, AFTER_DRAIN = false;
    const float* bp; const float* bs; float* out; const float* gate; const float* rs;
    __device__ __forceinline__ void operator()(const pg8::f32x4 (&acc)[2][2][4][2], const pg8::Unit& u, int wr, int wc, int fr, int fq) const {
        const int row0 = u.pm * 256 + wr * 64 + fr, col0 = u.pn * 256 + wc * 32 + 4 * fq;
#pragma unroll
        for (int ai = 0; ai < 2; ++ai)
#pragma unroll
            for (int m = 0; m < 4; ++m) {
                const int r = row0 + ai * 128 + m * 16;
                const float* brow = (r < NPR ? bp + (size_t)r * DM : bs + (size_t)(r - NPR) * DM) + col0;
                const float* grow = gate + (size_t)row_bidx(r) * ADA + col0;
                const float s = rs ? rs[r] : 1.f;
                float* orow = out + (size_t)r * DM + col0;
#pragma unroll
                for (int bj = 0; bj < 2; ++bj)
#pragma unroll
                    for (int n = 0; n < 2; ++n) { const int o = bj * 128 + n * 16;
                        const pg8::f32x4 b = *(const pg8::f32x4*)(brow + o), g = *(const pg8::f32x4*)(grow + o);
                        *(pg8::f32x4*)(orow + o) = b + g * (acc[ai][bj][m][n] * s); }
            }
    }
};

__device__ __forceinline__ void tr_item(const float* W, int K, int N, int nblk, bf16* WT, int mode, const float* ks0, const float* ks1, LAS float* scr, int item, int lane) {
    const int kb = item / nblk, nb = item % nblk, k0 = 64 * kb, n0 = 32 * nb;
    const int n = n0 + (lane & 31);
#pragma unroll 8
    for (int i = 0; i < 32; ++i) { const int kk = 2 * i + (lane >> 5); float v = (n < N) ? W[(size_t)(k0 + kk) * N + n] : 0.f;
        if (mode == 1) { const int k = k0 + kk; v *= (k < 512) ? ks0[k] : ks1[k - 512]; }
        scr[kk * 33 + (lane & 31)] = v; }
    LDS_WAIT(); asm volatile("" ::: "memory");
    const int c = lane & 7;
#pragma unroll
    for (int j = 0; j < 4; ++j) { const int nl = (lane >> 3) + 8 * j; const LAS float* s = scr + (8 * c) * 33 + nl;
        u32x4 o; o.x = pk2(s[0 * 33], s[1 * 33]); o.y = pk2(s[2 * 33], s[3 * 33]); o.z = pk2(s[4 * 33], s[5 * 33]); o.w = pk2(s[6 * 33], s[7 * 33]);
        const int nn = n0 + nl; int row = nn;
        if (mode == 2) row = nn < DFF ? ((nn >> 7) * 256 + (nn & 127)) : (((nn - DFF) >> 7) * 256 + 128 + ((nn - DFF) & 127));
        *(u32x4*)(WT + (size_t)row * K + k0 + 8 * c) = o; }
    LDS_WAIT(); asm volatile("" ::: "memory");
}
__device__ __forceinline__ void p0a_phase(const Args& a, LAS unsigned char* lds, int G) {
    int tid_ = threadIdx.x; asm volatile("" : "+v"(tid_)); const int tid = tid_, lane = tid & 63, wave = tid >> 6;
    LAS float* scr = (LAS float*)(lds + wave * 8448);
    const int gw = blockIdx.x * NWAVES + wave, NGW = G * NWAVES;
    constexpr int I_IN = 32 * (NINP / 32), I_OUT = 32 * (DM / 32), I_UP = 32 * (NUP / 32), I_DN = (DFF / 64) * (DM / 32), I_PW = 4 * 2 * 4, I_L = I_IN + I_OUT + I_UP + I_DN + I_PW;
    for (int it = gw; it < DEPTH * I_L; it += NGW) {
        const int l = it / I_L; int r = it % I_L;
        if (r < I_IN) { tr_item(a.in[12] + (size_t)l * DM * NIN, DM, NIN, NINP / 32, (bf16*)(a.ws + WS_WIN + l * SZ_WIN), 0, nullptr, nullptr, scr, r, lane); continue; } r -= I_IN;
        if (r < I_OUT) { tr_item(a.in[21] + (size_t)l * DM * DM, DM, DM, DM / 32, (bf16*)(a.ws + WS_WOUT + l * SZ_WOUT), 1, a.in[14] + l * POOLW, a.in[20] + l * SSDW, scr, r, lane); continue; } r -= I_OUT;
        if (r < I_UP) { tr_item(a.in[22] + (size_t)l * DM * NUP, DM, NUP, NUP / 32, (bf16*)(a.ws + WS_WUP + l * SZ_WUP), 2, nullptr, nullptr, scr, r, lane); continue; } r -= I_UP;
        if (r < I_DN) { tr_item(a.in[25] + (size_t)l * DFF * DM, DFF, DM, DM / 32, (bf16*)(a.ws + WS_WDN + l * SZ_WDN), 0, nullptr, nullptr, scr, r, lane); continue; } r -= I_DN;
        { const int g = r / 8, q = r % 8; tr_item(a.in[13] + ((size_t)l * 4 + g) * 128 * 128, 128, 128, 4, (bf16*)(a.ws + WS_PWT + l * SZ_PWT) + (size_t)g * 128 * 128, 0, nullptr, nullptr, scr, q, lane); }
    }
    bf16* SC = (bf16*)(a.ws + WS_SC);
    for (int i = blockIdx.x * NTHR + tid; i < 160 * (DM / 4); i += G * NTHR) {
        const int row = i / (DM / 4), c4 = (i % (DM / 4)) * 4; f32x4 v = (f32x4){0.f, 0.f, 0.f, 0.f};
        if (row < NBP) v = *(const f32x4*)(a.in[2] + (size_t)row * DM + c4); else if (row < NB) v = *(const f32x4*)(a.in[3] + (size_t)(row - NBP) * DM + c4);
        u32x2 o; o.x = pk2(silu_f(v[0]), silu_f(v[1])); o.y = pk2(silu_f(v[2]), silu_f(v[3]));
        *(u32x2*)(SC + (size_t)row * DM + c4) = o;
    }
}
__device__ __forceinline__ void p0b_phase(const Args& a, int G) {
    int tid_ = threadIdx.x; asm volatile("" : "+v"(tid_)); const int tid = tid_, lane = tid & 63, wave = tid >> 6, r = lane & 31, h = lane >> 5;
    const bf16* SC = (const bf16*)(a.ws + WS_SC); float* MOD = (float*)(a.ws + WS_MOD);
    for (int u = blockIdx.x; u < 256; u += G) {
        if (wave >= 6) continue;
        const int l = u >> 6, c0 = (u & 63) * 192 + wave * 32;
        const float* W = a.in[10] + (size_t)l * DM * ADA + c0 + r;
        f32x16 acc[5];
#pragma unroll
        for (int m = 0; m < 5; ++m)
#pragma unroll
            for (int e = 0; e < 16; ++e) acc[m][e] = 0.f;
#pragma unroll 1
        for (int kk = 0; kk < DM / 16; ++kk) {
            const int k0 = kk * 16 + 8 * h;
            float bv[8];
#pragma unroll
            for (int j = 0; j < 8; ++j) bv[j] = W[(size_t)(k0 + j) * ADA];
            const bf16x8 bfr = as_frag(pack8(bv));
#pragma unroll
            for (int m = 0; m < 5; ++m) { const bf16x8 afr = as_frag(*(const u32x4*)(SC + (size_t)(32 * m + r) * DM + k0));
                acc[m] = __builtin_amdgcn_mfma_f32_32x32x16_bf16(afr, bfr, acc[m], 0, 0, 0); }
        }
        const float bias = a.in[11][(size_t)l * ADA + c0 + r];
#pragma unroll
        for (int m = 0; m < 5; ++m)
#pragma unroll
            for (int e4 = 0; e4 < 4; ++e4) {
                const int rowb = 32 * m + 8 * e4 + 4 * h;
                float* p = MOD + ((size_t)l * NB + rowb) * ADA + c0 + r; asm volatile("" : "+v"(p));
#pragma unroll
                for (int e = 0; e < 4; ++e) if (rowb + e < NB) p[(size_t)e * ADA] = acc[m][4 * e4 + e] + bias;
            }
    }
}
__device__ __forceinline__ void norm_phase(const float* xp, const float* xs, const float* gamma, const float* modl, int shc, bf16* H, int G) {
    int tid_ = threadIdx.x; asm volatile("" : "+v"(tid_)); const int tid = tid_, lane = tid & 63, wave = tid >> 6;
    for (int row = blockIdx.x * NWAVES + wave; row < MROWS; row += G * NWAVES) {
        const float* xr = (row < NPR ? xp + (size_t)row * DM : xs + (size_t)(row - NPR) * DM) + 4 * lane;
        f32x4 v[8]; float ss = 0.f;
#pragma unroll
        for (int j = 0; j < 8; ++j) { v[j] = *(const f32x4*)(xr + 256 * j); ss += (v[j][0] * v[j][0] + v[j][1] * v[j][1]) + (v[j][2] * v[j][2] + v[j][3] * v[j][3]); }
        const float rstd = 1.f / sqrtf(wave_sum(ss) * (1.f / DM) + EPS);
        const float* mrow = modl + (size_t)row_bidx(row) * ADA + 4 * lane;
        bf16* hr = H + (size_t)row * DM + 4 * lane;
#pragma unroll
        for (int j = 0; j < 8; ++j) { const f32x4 g = *(const f32x4*)(gamma + 256 * j + 4 * lane), sh = *(const f32x4*)(mrow + shc * DM + 256 * j), sc = *(const f32x4*)(mrow + (shc + 1) * DM + 256 * j);
            const f32x4 y = (v[j] * rstd) * g * (sc + 1.f) + sh;
            u32x2 o; o.x = pk2(y[0], y[1]); o.y = pk2(y[2], y[3]); *(u32x2*)(hr + 256 * j) = o; }
    }
}
__device__ __forceinline__ void final_phase(const float* X, const float* gamma, float* out, int G) {
    int tid_ = threadIdx.x; asm volatile("" : "+v"(tid_)); const int tid = tid_, lane = tid & 63, wave = tid >> 6;
    for (int row = blockIdx.x * NWAVES + wave; row < MROWS; row += G * NWAVES) {
        const float* xr = X + (size_t)row * DM + 4 * lane;
        f32x4 v[8]; float ss = 0.f;
#pragma unroll
        for (int j = 0; j < 8; ++j) { v[j] = *(const f32x4*)(xr + 256 * j); ss += (v[j][0] * v[j][0] + v[j][1] * v[j][1]) + (v[j][2] * v[j][2] + v[j][3] * v[j][3]); }
        const float rstd = 1.f / sqrtf(wave_sum(ss) * (1.f / DM) + EPS);
        float* orow = out + (size_t)row * DM + 4 * lane;
#pragma unroll
        for (int j = 0; j < 8; ++j) { const f32x4 g = *(const f32x4*)(gamma + 256 * j + 4 * lane); *(f32x4*)(orow + 256 * j) = (v[j] * rstd) * g; }
    }
}
#define XB_TMO      128
#define XB_XCNT(j)  (256  + 64 * (j))
#define XB_XSUB(j)  (1280 + 64 * (j))
#define XB_XGEN(j)  (2304 + 64 * (j))
#define XB_TOP      3328
#define XB_TOPGEN   3392
#define XCD_BAR_WORDS 3456
#define XB_SPIN_CAP (1u << 18)

__device__ __forceinline__ unsigned xb_ld(unsigned* p)              { return __hip_atomic_load(p, __ATOMIC_RELAXED, __HIP_MEMORY_SCOPE_AGENT); }
__device__ __forceinline__ unsigned xb_add(unsigned* p, unsigned v) { return __hip_atomic_fetch_add(p, v, __ATOMIC_RELAXED, __HIP_MEMORY_SCOPE_AGENT); }
__device__ __forceinline__ unsigned xb_xcc_id() { return (unsigned)__builtin_amdgcn_s_getreg((3 << 11) | 20) & 0xFu; }
#define XB_SPIN(cond, bar) do { unsigned _sp = 0; while (cond) { __builtin_amdgcn_s_sleep(1); \
    if ((++_sp & 255u) == 0u) { if (xb_ld(&(bar)[XB_TMO])) break; if (_sp > XB_SPIN_CAP) { atomicAdd(&(bar)[XB_TMO], 1u); break; } } } } while (0)

struct XcdBarrier {
    unsigned* bar; unsigned x;
    volatile LAS unsigned* st;
};

__device__ __forceinline__ XcdBarrier xcd_barrier_post(unsigned* bar, volatile LAS unsigned* st) {
    XcdBarrier b; b.bar = bar; b.x = xb_xcc_id(); b.st = st;
    if (threadIdx.x == 0) (void)xb_add(&bar[XB_XCNT(b.x)], 1u);
    return b;
}
__device__ __forceinline__ void xcd_barrier_complete(unsigned* bar, unsigned x, unsigned& nloc, unsigned& nx) {
    const unsigned G = gridDim.x * gridDim.y * gridDim.z;
    unsigned sum, cnt, mine, sp = 0u;
    for (;;) {
        sum = 0u; cnt = 0u; mine = 0u;
#pragma unroll
        for (unsigned j = 0; j < 16; ++j) { const unsigned c = xb_ld(&bar[XB_XCNT(j)]); sum += c; cnt += (c > 0u) ? 1u : 0u; mine = (j == x) ? c : mine; }
        if (sum == G) break;
        __builtin_amdgcn_s_sleep(1);
        if ((++sp & 255u) == 0u) { if (xb_ld(&bar[XB_TMO])) break; if (sp > XB_SPIN_CAP) { atomicAdd(&bar[XB_TMO], 1u); break; } }
    }
    nloc = mine > 0u ? mine : 1u; nx = cnt > 0u ? cnt : 1u;
}

__device__ __forceinline__ void xcd_barrier(const XcdBarrier& b) {
    asm volatile("s_waitcnt vmcnt(0)" ::: "memory");
    __syncthreads();
    if (threadIdx.x == 0) {
        unsigned* bar = b.bar;
        __builtin_amdgcn_s_waitcnt(0);
        unsigned nloc = b.st[0], nx = b.st[1];
        if (nloc == 0u) { xcd_barrier_complete(bar, b.x, nloc, nx); b.st[0] = nloc; b.st[1] = nx; }
        const unsigned old = xb_add(&bar[XB_XSUB(b.x)], 1u);
        const unsigned gen = old / nloc;
        if (old + 1u == (gen + 1u) * nloc) {
            __builtin_amdgcn_fence(__ATOMIC_RELEASE, "agent");
            asm volatile("s_waitcnt vmcnt(0)" ::: "memory");
            const unsigned og = xb_add(&bar[XB_TOP], 1u);
            const unsigned tg = og / nx;
            if (og + 1u == (tg + 1u) * nx) xb_add(&bar[XB_TOPGEN], 1u);
            else XB_SPIN(xb_ld(&bar[XB_TOPGEN]) == tg, bar);
            __builtin_amdgcn_fence(__ATOMIC_ACQUIRE, "agent");
            xb_add(&bar[XB_XGEN(b.x)], 1u);
            asm volatile("s_waitcnt vmcnt(0)" ::: "memory");
        } else {
            XB_SPIN(xb_ld(&bar[XB_XGEN(b.x)]) == gen, bar);
            __builtin_amdgcn_fence(__ATOMIC_ACQUIRE, "agent");
            asm volatile("s_waitcnt vmcnt(0)" ::: "memory");
        }
    }
    __syncthreads();
}

constexpr int LSTR = 136;
__device__ __forceinline__ int k1_chan(int g, int ch8) { return ch8 < 48 ? 384 * g + 8 * ch8 : (ch8 < 64 ? SSDW + 128 * g + 8 * (ch8 - 48) : SSDW + 512 + 128 * g + 8 * (ch8 - 64)); }

__device__ __forceinline__ void k1_phase(const Args& a, int l, LAS unsigned char* lds, int G) {
    int tid_ = threadIdx.x; asm volatile("" : "+v"(tid_)); const int tid = tid_, lane = tid & 63, wave = __builtin_amdgcn_readfirstlane(tid >> 6), q = lane >> 4, fr = lane & 15;
    const bf16* P = (const bf16*)(a.ws + WS_P); const float* DT = (const float*)(a.ws + WS_DT);
    bf16* XC = (bf16*)(a.ws + WS_XC); float* DTB = (float*)(a.ws + WS_DTB); float* CSB = (float*)(a.ws + WS_CSB);
    float* S = (float*)(a.ws + WS_S); float* DEC = (float*)(a.ws + WS_DEC);
    const float* cw = a.in[15] + (size_t)l * 4 * XBCW; const float* cb = a.in[16] + (size_t)l * XBCW;
    const float* dtb = a.in[17] + l * NH; const float* alog = a.in[18] + l * NH;
    LAS bf16* xdT = (LAS bf16*)lds;
    LAS bf16* BT = (LAS bf16*)(lds + 6 * 64 * LSTR * 2);
    LAS float* csL = (LAS float*)(lds + 6 * 64 * LSTR * 2 + 128 * LSTR * 2);
    LAS float* scL = csL + 6 * 128;
    for (int u = blockIdx.x; u < NBP * NCH * NG; u += G) {
        const int b = u >> 6, c = (u >> 2) & 15, g = u & 3, r0 = b * SEQ + c * 128;
        if (wave < HPG) {
            const int h = HPG * g + wave; const float A = -__expf(alog[h]), bias = dtb[h];
            const int t0 = 2 * lane;
            const float d0 = softplus_f(DT[(size_t)(r0 + t0) * 32 + h] + bias), d1 = softplus_f(DT[(size_t)(r0 + t0 + 1) * 32 + h] + bias);
            const float a0 = d0 * A, a1 = d1 * A; float s = a0 + a1;
#pragma unroll
            for (int o = 1; o < 64; o <<= 1) { const float t = __shfl_up(s, o); if (lane >= o) s += t; }
            const float cs1 = s, cs0 = s - a1, tot = __shfl(s, 63);
            csL[wave * 128 + t0] = cs0; csL[wave * 128 + t0 + 1] = cs1;
            scL[wave * 128 + t0] = d0 * __expf(tot - cs0); scL[wave * 128 + t0 + 1] = d1 * __expf(tot - cs1);
            DTB[(size_t)(r0 + t0) * NH + h] = d0; DTB[(size_t)(r0 + t0 + 1) * NH + h] = d1;
            CSB[(size_t)(r0 + t0) * NH + h] = cs0; CSB[(size_t)(r0 + t0 + 1) * NH + h] = cs1;
            if (lane == 0) DEC[(b * NCH + c) * NH + h] = __expf(tot);
        }
        __syncthreads();
        for (int it = tid; it < 80 * 16; it += NTHR) {
            const int ch8 = it % 80, tt0 = (it / 80) * 8, j0 = k1_chan(g, ch8);
            float w[4][8], bb[8];
#pragma unroll
            for (int i = 0; i < 4; ++i) { const f32x4 w0 = *(const f32x4*)(cw + i * XBCW + j0), w1 = *(const f32x4*)(cw + i * XBCW + j0 + 4);
#pragma unroll
                for (int j = 0; j < 4; ++j) { w[i][j] = w0[j]; w[i][4 + j] = w1[j]; } }
            { const f32x4 b0 = *(const f32x4*)(cb + j0), b1 = *(const f32x4*)(cb + j0 + 4);
#pragma unroll
              for (int j = 0; j < 4; ++j) { bb[j] = b0[j]; bb[4 + j] = b1[j]; } }
            float xm3[8], xm2[8], xm1[8];
            const bf16* src = P + (size_t)(r0 + tt0) * PW + 2048 + j0;
            const bool has_prev = (c * 128 + tt0) > 0;
            if (has_prev) { unpack8(*(const u32x4*)(src - 3 * PW), xm3); unpack8(*(const u32x4*)(src - 2 * PW), xm2); unpack8(*(const u32x4*)(src - PW), xm1); }
            else {
#pragma unroll
                for (int j = 0; j < 8; ++j) { xm3[j] = 0.f; xm2[j] = 0.f; xm1[j] = 0.f; } }
#pragma unroll
            for (int t = 0; t < 8; ++t) {
                float cur[8], o[8]; unpack8(*(const u32x4*)(src + (size_t)t * PW), cur);
#pragma unroll
                for (int j = 0; j < 8; ++j) o[j] = silu_f(bb[j] + w[0][j] * xm3[j] + w[1][j] * xm2[j] + w[2][j] * xm1[j] + w[3][j] * cur[j]);
                *(u32x4*)(XC + (size_t)(r0 + tt0 + t) * XBCW + j0) = pack8(o);
                const int tt = tt0 + t;
                if (ch8 < 48) { const int hh = ch8 >> 3, p0 = 8 * (ch8 & 7); const float sc = scL[hh * 128 + tt];
#pragma unroll
                    for (int j = 0; j < 8; ++j) xdT[(hh * 64 + p0 + j) * LSTR + tt] = f2bf(o[j] * sc);
                } else if (ch8 < 64) { const int n0 = 8 * (ch8 - 48);
#pragma unroll
                    for (int j = 0; j < 8; ++j) BT[(n0 + j) * LSTR + tt] = f2bf(o[j]); }
#pragma unroll
                for (int j = 0; j < 8; ++j) { xm3[j] = xm2[j]; xm2[j] = xm1[j]; xm1[j] = cur[j]; }
            }
        }
        if (c == NCH - 1) {
            float* o = a.out + O_CP + ((size_t)l * NBP + b) * 3 * XBCW;
            for (int it = tid; it < 3 * 640; it += NTHR) { const int i = it / 640, cc = it % 640, j = k1_chan(g, cc >> 3) + (cc & 7);
                o[i * XBCW + j] = bf1(P[(size_t)(r0 + 125 + i) * PW + 2048 + j]); }
        }
        __syncthreads();
#pragma unroll 1
        for (int hh = 0; hh < HPG; ++hh) {
            f32x4 acc[4];
#pragma unroll
            for (int pt = 0; pt < 4; ++pt) acc[pt] = (f32x4){0.f, 0.f, 0.f, 0.f};
#pragma unroll
            for (int ks = 0; ks < 4; ++ks) {
                const bf16x8 bfr = *(const LAS bf16x8*)(BT + (16 * wave + fr) * LSTR + 32 * ks + 8 * q);
#pragma unroll
                for (int pt = 0; pt < 4; ++pt) { const bf16x8 afr = *(const LAS bf16x8*)(xdT + (hh * 64 + 16 * pt + fr) * LSTR + 32 * ks + 8 * q);
                    acc[pt] = MFMA16(bfr, afr, acc[pt]); }
            }
            float* so = S + ((size_t)(b * NCH + c) * NH + HPG * g + hh) * (HD * DS) + 16 * wave + 4 * q;
#pragma unroll
            for (int pt = 0; pt < 4; ++pt) *(f32x4*)(so + (size_t)(16 * pt + fr) * DS) = acc[pt];
        }
        __syncthreads();
    }
    {
        const float* st = a.in[5] + (size_t)l * NBS * 3 * XBCW;
        float* oc = a.out + O_CS + (size_t)l * NBS * 3 * XBCW;
        for (int it = blockIdx.x * NTHR + tid; it < NBS * (XBCW / 8); it += G * NTHR) {
            const int bs = it / (XBCW / 8), j0 = (it % (XBCW / 8)) * 8, rs0 = NPR + 4 * bs;
            float full[7][8];
#pragma unroll
            for (int i = 0; i < 3; ++i) { const f32x4 p0 = *(const f32x4*)(st + ((size_t)bs * 3 + i) * XBCW + j0), p1 = *(const f32x4*)(st + ((size_t)bs * 3 + i) * XBCW + j0 + 4);
#pragma unroll
                for (int j = 0; j < 4; ++j) { full[i][j] = p0[j]; full[i][4 + j] = p1[j]; } }
#pragma unroll
            for (int t = 0; t < 4; ++t) unpack8(*(const u32x4*)(P + (size_t)(rs0 + t) * PW + 2048 + j0), full[3 + t]);
            float w[4][8], bb[8];
#pragma unroll
            for (int i = 0; i < 4; ++i) { const f32x4 w0 = *(const f32x4*)(cw + i * XBCW + j0), w1 = *(const f32x4*)(cw + i * XBCW + j0 + 4);
#pragma unroll
                for (int j = 0; j < 4; ++j) { w[i][j] = w0[j]; w[i][4 + j] = w1[j]; } }
            { const f32x4 b0 = *(const f32x4*)(cb + j0), b1 = *(const f32x4*)(cb + j0 + 4);
#pragma unroll
              for (int j = 0; j < 4; ++j) { bb[j] = b0[j]; bb[4 + j] = b1[j]; } }
#pragma unroll
            for (int t = 0; t < 4; ++t) { float o[8];
#pragma unroll
                for (int j = 0; j < 8; ++j) o[j] = silu_f(bb[j] + w[0][j] * full[t][j] + w[1][j] * full[t + 1][j] + w[2][j] * full[t + 2][j] + w[3][j] * full[t + 3][j]);
                *(u32x4*)(XC + (size_t)(rs0 + t) * XBCW + j0) = pack8(o); }
#pragma unroll
            for (int i = 0; i < 3; ++i) { float* o = oc + ((size_t)bs * 3 + i) * XBCW + j0;
                *(f32x4*)o = (f32x4){full[4 + i][0], full[4 + i][1], full[4 + i][2], full[4 + i][3]}; *(f32x4*)(o + 4) = (f32x4){full[4 + i][4], full[4 + i][5], full[4 + i][6], full[4 + i][7]}; }
        }
        for (int it = blockIdx.x * NTHR + tid; it < NSR * NH; it += G * NTHR) { const int r = NPR + it / NH, h = it % NH;
            DTB[(size_t)r * NH + h] = softplus_f(DT[(size_t)r * 32 + h] + dtb[h]); }
    }
}

__device__ __forceinline__ void k2_phase(const Args& a, int l, int G) {
    int tid_ = threadIdx.x; asm volatile("" : "+v"(tid_)); const int tid = tid_, lane = tid & 63, wave = tid >> 6, q = lane >> 4, fr = lane & 15;
    const float* S = (const float*)(a.ws + WS_S); const float* DEC = (const float*)(a.ws + WS_DEC); bf16* HS = (bf16*)(a.ws + WS_HS);
    for (int it = blockIdx.x * NTHR + tid; it < NBP * NH * (HD * DS / 4); it += G * NTHR) {
        const int bh = it / (HD * DS / 4), e = (it % (HD * DS / 4)) * 4, b = bh / NH, h = bh % NH;
        f32x4 H = (f32x4){0.f, 0.f, 0.f, 0.f};
#pragma unroll 4
        for (int c = 0; c < NCH; ++c) {
            const size_t o = ((size_t)(b * NCH + c) * NH + h) * (HD * DS) + e;
            u32x2 w; w.x = pk2(H[0], H[1]); w.y = pk2(H[2], H[3]); *(u32x2*)(HS + o) = w;
            const float d = DEC[(b * NCH + c) * NH + h]; const f32x4 s = *(const f32x4*)(S + o);
            H = H * d + s;
        }
        *(f32x4*)(a.out + O_SP + (((size_t)l * NBP + b) * NH + h) * (HD * DS) + e) = H;
    }
    const bf16* XC = (const bf16*)(a.ws + WS_XC); const bf16* P = (const bf16*)(a.ws + WS_P); const float* DTB = (const float*)(a.ws + WS_DTB);
    bf16* MIX = (bf16*)(a.ws + WS_MIX); float* SSQ = (float*)(a.ws + WS_SSQ);
    const float* alog = a.in[18] + l * NH; const float* dsk = a.in[19] + l * NH;
    for (int u = blockIdx.x * NWAVES + wave; u < NBS * NH; u += G * NWAVES) {
        const int bs = u / NH, h = u % NH, g = h / HPG, rs0 = NPR + 4 * bs;
        const float A = -__expf(alog[h]), Dh = dsk[h];
        float dt[4], cs[4]; { float s = 0.f;
#pragma unroll
            for (int t = 0; t < 4; ++t) { dt[t] = DTB[(size_t)(rs0 + t) * NH + h]; s += dt[t] * A; cs[t] = s; } }
        bf16x8 cfr[4]; u32x4 brow[4];
#pragma unroll
        for (int ks = 0; ks < 4; ++ks) { u32x4 z = (u32x4){0u, 0u, 0u, 0u}, zb = z;
            if (fr < 4) { z = *(const u32x4*)(XC + (size_t)(rs0 + fr) * XBCW + SSDW + 512 + 128 * g + 32 * ks + 8 * q); zb = *(const u32x4*)(XC + (size_t)(rs0 + fr) * XBCW + SSDW + 128 * g + 32 * ks + 8 * q); }
            cfr[ks] = as_frag(z); brow[ks] = zb; }
        f32x4 cb4 = (f32x4){0.f, 0.f, 0.f, 0.f};
#pragma unroll
        for (int ks = 0; ks < 4; ++ks) cb4 = MFMA16(cfr[ks], as_frag(brow[ks]), cb4);
        float Wm[4][4];
#pragma unroll
        for (int t = 0; t < 4; ++t)
#pragma unroll
            for (int s = 0; s < 4; ++s) Wm[t][s] = 0.f;
#pragma unroll
        for (int t = 0; t < 4; ++t)
#pragma unroll
            for (int s = 0; s < 4; ++s) if (s <= t) Wm[t][s] = __int_as_float(__builtin_amdgcn_readlane(__float_as_int(cb4[t]), s)) * __expf(cs[t] - cs[s]) * dt[s];
        float coef[4];
#pragma unroll
        for (int s = 0; s < 4; ++s) coef[s] = dt[s] * __expf(cs[3] - cs[s]);
        const float e3 = __expf(cs[3]);
        const float* h0 = a.in[6] + (((size_t)l * NBS + bs) * NH + h) * (HD * DS);
        float* hn = a.out + O_SS + (((size_t)l * NBS + bs) * NH + h) * (HD * DS);
        float ysum[4] = {0.f, 0.f, 0.f, 0.f};
#pragma unroll 1
        for (int pt = 0; pt < 4; ++pt) {
            const int p = 16 * pt + fr;
            float xs[4];
#pragma unroll
            for (int s = 0; s < 4; ++s) xs[s] = bf1(XC[(size_t)(rs0 + s) * XBCW + h * HD + p]);
            f32x4 yo = (f32x4){0.f, 0.f, 0.f, 0.f};
#pragma unroll
            for (int ks = 0; ks < 4; ++ks) {
                const float* hp = h0 + (size_t)p * DS + 32 * ks + 8 * q;
                const f32x4 v0 = *(const f32x4*)hp, v1 = *(const f32x4*)(hp + 4);
                float hv[8] = {v0[0], v0[1], v0[2], v0[3], v1[0], v1[1], v1[2], v1[3]}, nv[8];
#pragma unroll
                for (int j = 0; j < 8; ++j) nv[j] = e3 * hv[j];
#pragma unroll
                for (int s = 0; s < 4; ++s) { u32x4 bw; bw.x = __shfl(brow[ks].x, 16 * q + s); bw.y = __shfl(brow[ks].y, 16 * q + s); bw.z = __shfl(brow[ks].z, 16 * q + s); bw.w = __shfl(brow[ks].w, 16 * q + s);
                    float bvv[8]; unpack8(bw, bvv); const float cx = coef[s] * xs[s];
#pragma unroll
                    for (int j = 0; j < 8; ++j) nv[j] += cx * bvv[j]; }
                float* np = hn + (size_t)p * DS + 32 * ks + 8 * q;
                *(f32x4*)np = (f32x4){nv[0], nv[1], nv[2], nv[3]}; *(f32x4*)(np + 4) = (f32x4){nv[4], nv[5], nv[6], nv[7]};
                yo = MFMA16(cfr[ks], as_frag(pack8(hv)), yo);
            }
            if (lane < 16) {
#pragma unroll
                for (int t = 0; t < 4; ++t) {
                    float y = __expf(cs[t]) * yo[t] + Dh * xs[t];
#pragma unroll
                    for (int s = 0; s < 4; ++s) if (s <= t) y += Wm[t][s] * xs[s];
                    const float z = bf1(P[(size_t)(rs0 + t) * PW + POOLW + h * HD + p]);
                    const float yg = y * silu_f(z);
                    MIX[(size_t)(rs0 + t) * DM + POOLW + h * HD + p] = f2bf(yg);
                    ysum[t] += yg * yg;
                }
            }
        }
#pragma unroll
        for (int t = 0; t < 4; ++t) { float s = ysum[t]; s += __shfl_xor(s, 1); s += __shfl_xor(s, 2); s += __shfl_xor(s, 4); s += __shfl_xor(s, 8);
            if (lane == 0) SSQ[(size_t)(rs0 + t) * NH + h] = s; }
    }
}

__device__ __forceinline__ void k3_phase(const Args& a, int l, LAS unsigned char* lds, int G) {
    int tid_ = threadIdx.x; asm volatile("" : "+v"(tid_)); const int tid = tid_, lane = tid & 63, wave = __builtin_amdgcn_readfirstlane(tid >> 6), q = lane >> 4, fr = lane & 15;
    const bf16* XC = (const bf16*)(a.ws + WS_XC); const bf16* P = (const bf16*)(a.ws + WS_P);
    const float* DTB = (const float*)(a.ws + WS_DTB); const float* CSB = (const float*)(a.ws + WS_CSB); const bf16* HS = (const bf16*)(a.ws + WS_HS);
    bf16* MIX = (bf16*)(a.ws + WS_MIX); float* SSQ = (float*)(a.ws + WS_SSQ);
    const float* dsk = a.in[19] + l * NH;
    LAS bf16* Cs = (LAS bf16*)lds;
    LAS bf16* Bs = Cs + 128 * LSTR;
    LAS bf16* xT = Bs + 128 * LSTR;
    LAS bf16* Ms = xT + 64 * LSTR;
    LAS float* csL = (LAS float*)(Ms + 8 * 16 * LSTR);
    LAS float* dtL = csL + 6 * 128;
    for (int u = blockIdx.x; u < NBP * NCH * NG; u += G) {
        const int b = u >> 6, c = (u >> 2) & 15, g = u & 3, r0 = b * SEQ + c * 128;
        for (int it = tid; it < 2 * 128 * 16; it += NTHR) { const int m = it >> 11, row = (it >> 4) & 127, k8 = (it & 15) * 8;
            const u32x4 v = *(const u32x4*)(XC + (size_t)(r0 + row) * XBCW + SSDW + (m ? 0 : 512) + 128 * g + k8);
            *(LAS u32x4*)((m ? Bs : Cs) + row * LSTR + k8) = v; }
        for (int it = tid; it < 6 * 128; it += NTHR) { const int hh = it >> 7, t = it & 127;
            csL[it] = CSB[(size_t)(r0 + t) * NH + HPG * g + hh]; dtL[it] = DTB[(size_t)(r0 + t) * NH + HPG * g + hh]; }
        __syncthreads();
        bf16x8 cf[4];
#pragma unroll
        for (int ks = 0; ks < 4; ++ks) cf[ks] = *(const LAS bf16x8*)(Cs + (16 * wave + fr) * LSTR + 32 * ks + 8 * q);
        f32x4 gacc[8];
#pragma unroll
        for (int st = 0; st < 8; ++st) { gacc[st] = (f32x4){0.f, 0.f, 0.f, 0.f};
            if (st <= wave) {
#pragma unroll
                for (int ks = 0; ks < 4; ++ks) { const bf16x8 bfr = *(const LAS bf16x8*)(Bs + (16 * st + fr) * LSTR + 32 * ks + 8 * q); gacc[st] = MFMA16(bfr, cf[ks], gacc[st]); } } }
        const int lrow = 16 * wave + fr;
#pragma unroll 1
        for (int hh = 0; hh < HPG; ++hh) {
            const int h = HPG * g + hh;
            for (int it = tid; it < 128 * 8; it += NTHR) { const int s = it >> 3, p8 = (it & 7) * 8; float xv[8];
                unpack8(*(const u32x4*)(XC + (size_t)(r0 + s) * XBCW + h * HD + p8), xv);
#pragma unroll
                for (int j = 0; j < 8; ++j) xT[(p8 + j) * LSTR + s] = f2bf(xv[j]); }
            const float csl = csL[hh * 128 + lrow];
#pragma unroll
            for (int st = 0; st < 8; ++st) {
                if (st <= (wave | 1)) { float mv[4];
#pragma unroll
                    for (int r = 0; r < 4; ++r) { const int s = 16 * st + 4 * q + r;
                        mv[r] = (st <= wave && s <= lrow) ? gacc[st][r] * __expf(csl - csL[hh * 128 + s]) * dtL[hh * 128 + s] : 0.f; }
                    u32x2 w; w.x = pk2(mv[0], mv[1]); w.y = pk2(mv[2], mv[3]);
                    *(LAS u32x2*)(Ms + (wave * 16 + fr) * LSTR + 16 * st + 4 * q) = w; } }
            __syncthreads();
            f32x4 y1[4], y2[4];
#pragma unroll
            for (int pt = 0; pt < 4; ++pt) { y1[pt] = (f32x4){0.f, 0.f, 0.f, 0.f}; y2[pt] = (f32x4){0.f, 0.f, 0.f, 0.f}; }
            const bf16* hs = HS + ((size_t)(b * NCH + c) * NH + h) * (HD * DS);
#pragma unroll
            for (int ks = 0; ks < 4; ++ks) {
                if (2 * ks <= wave) { const bf16x8 mfr = *(const LAS bf16x8*)(Ms + (wave * 16 + fr) * LSTR + 32 * ks + 8 * q);
#pragma unroll
                    for (int pt = 0; pt < 4; ++pt) { const bf16x8 xfr = *(const LAS bf16x8*)(xT + (16 * pt + fr) * LSTR + 32 * ks + 8 * q); y1[pt] = MFMA16(xfr, mfr, y1[pt]); } }
#pragma unroll
                for (int pt = 0; pt < 4; ++pt) { const bf16x8 hfr = as_frag(*(const u32x4*)(hs + (size_t)(16 * pt + fr) * DS + 32 * ks + 8 * q)); y2[pt] = MFMA16(hfr, cf[ks], y2[pt]); }
            }
            const float ecs = __expf(csl), Dh = dsk[h]; const int row = r0 + lrow; float ss = 0.f;
#pragma unroll
            for (int pt = 0; pt < 4; ++pt) { const int p0 = 16 * pt + 4 * q;
                const u32x2 xw = *(const u32x2*)(XC + (size_t)row * XBCW + h * HD + p0), zw = *(const u32x2*)(P + (size_t)row * PW + POOLW + h * HD + p0);
                const float xv[4] = {bflo(xw.x), bfhi(xw.x), bflo(xw.y), bfhi(xw.y)}, zv[4] = {bflo(zw.x), bfhi(zw.x), bflo(zw.y), bfhi(zw.y)}; float yg[4];
#pragma unroll
                for (int r = 0; r < 4; ++r) { const float y = y1[pt][r] + ecs * y2[pt][r] + Dh * xv[r]; yg[r] = y * silu_f(zv[r]); ss += yg[r] * yg[r]; }
                u32x2 w; w.x = pk2(yg[0], yg[1]); w.y = pk2(yg[2], yg[3]);
                *(u32x2*)(MIX + (size_t)row * DM + POOLW + h * HD + p0) = w; }
            ss += __shfl_xor(ss, 16); ss += __shfl_xor(ss, 32);
            if (q == 0) SSQ[(size_t)row * NH + h] = ss;
            __syncthreads();
        }
    }
}

__device__ __forceinline__ void pool_phase(const Args& a, int l, int G) {
    int tid_ = threadIdx.x; asm volatile("" : "+v"(tid_)); const int tid = tid_, lane = tid & 63, wave = tid >> 6, q = lane >> 4, fr = lane & 15;
    const bf16* P = (const bf16*)(a.ws + WS_P); const bf16* PWT = (const bf16*)(a.ws + WS_PWT + l * SZ_PWT);
    bf16* MIX = (bf16*)(a.ws + WS_MIX); const float* SSQ = (const float*)(a.ws + WS_SSQ); float* R = (float*)(a.ws + WS_R);
    const float* stp = a.in[4] + (size_t)l * NBS * 15 * POOLW;
    for (int u = blockIdx.x * NWAVES + wave; u < (MROWS / 16) * 4; u += G * NWAVES) {
        const int rb = u >> 2, g = u & 3, row = 16 * rb + fr, w = 2 << g;
        float ssum = 0.f;
#pragma unroll
        for (int i = 0; i < 6; ++i) { const f32x4 v = *(const f32x4*)(SSQ + (size_t)row * NH + 4 * i); ssum += (v[0] + v[1]) + (v[2] + v[3]); }
        const float rr = sqrtf(ssum * (1.f / SSDW) + EPS);
        if (g == 0 && q == 0) R[row] = 1.f / rr;
        f32x4 acc[8];
#pragma unroll
        for (int nt = 0; nt < 8; ++nt) acc[nt] = (f32x4){0.f, 0.f, 0.f, 0.f};
#pragma unroll 1
        for (int ks = 0; ks < 4; ++ks) {
            const int ch = 128 * g + 32 * ks + 8 * q; float sum[8], cur[8];
            unpack8(*(const u32x4*)(P + (size_t)row * PW + ch), cur);
#pragma unroll
            for (int j = 0; j < 8; ++j) sum[j] = cur[j];
            float cnt;
            if (row < NPR) { const int pos = row & (SEQ - 1), nw = (pos + 1 < w) ? pos + 1 : w; cnt = (float)nw;
                for (int i = 1; i < nw; ++i) { float v[8]; unpack8(*(const u32x4*)(P + (size_t)(row - i) * PW + ch), v);
#pragma unroll
                    for (int j = 0; j < 8; ++j) sum[j] += v[j]; }
            } else { const int seq = (row - NPR) >> 2, t4 = (row - NPR) & 3; cnt = (float)w;
                for (int i = 1; i < w; ++i) { float v[8];
                    if (t4 - i >= 0) unpack8(*(const u32x4*)(P + (size_t)(row - i) * PW + ch), v);
                    else { const float* sp = stp + ((size_t)seq * 15 + (15 + t4 - i)) * POOLW + ch; const f32x4 v0 = *(const f32x4*)sp, v1 = *(const f32x4*)(sp + 4);
                        v[0] = v0[0]; v[1] = v0[1]; v[2] = v0[2]; v[3] = v0[3]; v[4] = v1[0]; v[5] = v1[1]; v[6] = v1[2]; v[7] = v1[3]; }
#pragma unroll
                    for (int j = 0; j < 8; ++j) sum[j] += v[j]; }
            }
            const float ic = 1.f / cnt; float d[8];
#pragma unroll
            for (int j = 0; j < 8; ++j) d[j] = sum[j] * ic - cur[j];
            const bf16x8 dfr = as_frag(pack8(d));
#pragma unroll
            for (int nt = 0; nt < 8; ++nt) { const bf16x8 wfr = as_frag(*(const u32x4*)(PWT + ((size_t)g * 128 + 16 * nt + fr) * 128 + 32 * ks + 8 * q)); acc[nt] = MFMA16(wfr, dfr, acc[nt]); }
        }
#pragma unroll
        for (int nt = 0; nt < 8; ++nt) { u32x2 o; o.x = pk2(acc[nt][0] * rr, acc[nt][1] * rr); o.y = pk2(acc[nt][2] * rr, acc[nt][3] * rr);
            *(u32x2*)(MIX + (size_t)row * DM + 128 * g + 16 * nt + 4 * q) = o; }
    }
    { float* o = a.out + O_PP + (size_t)l * NBP * 15 * POOLW;
      for (int it = blockIdx.x * NTHR + tid; it < NBP * 15 * POOLW; it += G * NTHR) { const int b = it / (15 * POOLW), i = (it / POOLW) % 15, cc = it % POOLW;
          o[it] = bf1(P[(size_t)(b * SEQ + SEQ - 15 + i) * PW + cc]); }
      float* os = a.out + O_PS + (size_t)l * NBS * 15 * POOLW;
      for (int it = blockIdx.x * NTHR + tid; it < NBS * 15 * POOLW; it += G * NTHR) { const int bs = it / (15 * POOLW), i = (it / POOLW) % 15, cc = it % POOLW;
          os[it] = i < 11 ? stp[((size_t)bs * 15 + i + 4) * POOLW + cc] : bf1(P[(size_t)(NPR + 4 * bs + i - 11) * PW + cc]); } }
}

__device__ __forceinline__ void act_phase(const Args& a, int l, int G) {
    int tid_ = threadIdx.x; asm volatile("" : "+v"(tid_)); const int tid = tid_;
    const bf16* UP = (const bf16*)(a.ws + WS_UP); bf16* ACT = (bf16*)(a.ws + WS_ACT);
    const float* fw = a.in[23] + (size_t)l * 3 * DFF; const float* fb = a.in[24] + (size_t)l * DFF;
    const float* stf = a.in[7] + (size_t)l * NBS * 2 * DFF;
    for (int it = blockIdx.x * NTHR + tid; it < (MROWS / 4) * (DFF / 8); it += G * NTHR) {
        const int run = it / (DFF / 8), j0 = (it % (DFF / 8)) * 8, row0 = 4 * run;
        const int ucol = (j0 >> 7) * 256 + (j0 & 127);
        float w[3][8], bb[8];
#pragma unroll
        for (int i = 0; i < 3; ++i) { const f32x4 w0 = *(const f32x4*)(fw + i * DFF + j0), w1 = *(const f32x4*)(fw + i * DFF + j0 + 4);
#pragma unroll
            for (int j = 0; j < 4; ++j) { w[i][j] = w0[j]; w[i][4 + j] = w1[j]; } }
        { const f32x4 b0 = *(const f32x4*)(fb + j0), b1 = *(const f32x4*)(fb + j0 + 4);
#pragma unroll
          for (int j = 0; j < 4; ++j) { bb[j] = b0[j]; bb[4 + j] = b1[j]; } }
        float g2[8], g1[8];
        if (row0 < NPR) {
            if ((row0 & (SEQ - 1)) == 0) {
#pragma unroll
                for (int j = 0; j < 8; ++j) { g2[j] = 0.f; g1[j] = 0.f; }
            } else { unpack8(*(const u32x4*)(UP + (size_t)(row0 - 2) * NUP + ucol), g2); unpack8(*(const u32x4*)(UP + (size_t)(row0 - 1) * NUP + ucol), g1); }
        } else { const int bs = (row0 - NPR) >> 2; const float* s0 = stf + ((size_t)bs * 2) * DFF + j0;
            const f32x4 a0 = *(const f32x4*)s0, a1 = *(const f32x4*)(s0 + 4), c0 = *(const f32x4*)(s0 + DFF), c1 = *(const f32x4*)(s0 + DFF + 4);
#pragma unroll
            for (int j = 0; j < 4; ++j) { g2[j] = a0[j]; g2[4 + j] = a1[j]; g1[j] = c0[j]; g1[4 + j] = c1[j]; } }
#pragma unroll
        for (int t = 0; t < 4; ++t) {
            float gc[8], vv[8], o[8];
            unpack8(*(const u32x4*)(UP + (size_t)(row0 + t) * NUP + ucol), gc); unpack8(*(const u32x4*)(UP + (size_t)(row0 + t) * NUP + ucol + 128), vv);
#pragma unroll
            for (int j = 0; j < 8; ++j) o[j] = silu_f(bb[j] + w[0][j] * g2[j] + w[1][j] * g1[j] + w[2][j] * gc[j]) * vv[j];
            *(u32x4*)(ACT + (size_t)(row0 + t) * DFF + j0) = pack8(o);
#pragma unroll
            for (int j = 0; j < 8; ++j) { g2[j] = g1[j]; g1[j] = gc[j]; }
        }
        if (row0 < NPR) { if ((row0 & (SEQ - 1)) == SEQ - 4) { float* o = a.out + O_FP + (((size_t)l * NBP + (row0 >> 11)) * 2) * DFF + j0;
                *(f32x4*)o = (f32x4){g2[0], g2[1], g2[2], g2[3]}; *(f32x4*)(o + 4) = (f32x4){g2[4], g2[5], g2[6], g2[7]};
                *(f32x4*)(o + DFF) = (f32x4){g1[0], g1[1], g1[2], g1[3]}; *(f32x4*)(o + DFF + 4) = (f32x4){g1[4], g1[5], g1[6], g1[7]}; } }
        else { float* o = a.out + O_FS + (((size_t)l * NBS + ((row0 - NPR) >> 2)) * 2) * DFF + j0;
            *(f32x4*)o = (f32x4){g2[0], g2[1], g2[2], g2[3]}; *(f32x4*)(o + 4) = (f32x4){g2[4], g2[5], g2[6], g2[7]};
            *(f32x4*)(o + DFF) = (f32x4){g1[0], g1[1], g1[2], g1[3]}; *(f32x4*)(o + DFF + 4) = (f32x4){g1[4], g1[5], g1[6], g1[7]}; }
    }
}

constexpr int PH_P0A = 0, PH_P0B = 1, PH_L0 = 2, PH_PER_LAYER = 11, PH_FINAL = PH_L0 + DEPTH * PH_PER_LAYER, N_PHASES = PH_FINAL + 1;
#ifndef N_LAUNCH_MODE
#define N_LAUNCH_MODE 1
#endif

__device__ __forceinline__ int grid_size() { int g = gridDim.x; asm volatile("" : "+s"(g)); return g; }
__global__ void __launch_bounds__(NTHR, 2) fwd_kernel(Args a) {
    extern __shared__ __attribute__((aligned(16))) unsigned char lds_raw[];
    LAS unsigned char* lds = (LAS unsigned char*)lds_raw;
    const int tid = threadIdx.x;
#define G grid_size()
    volatile LAS unsigned* misc = (volatile LAS unsigned*)(lds + LDS_MISC);
    if (tid < 64) misc[tid] = 0u;
    __syncthreads();
    XcdBarrier bar; bar.bar = (unsigned*)(a.ws + WS_CTL) + CW_BAR; bar.x = 0; bar.st = misc + 8;
    const int lo = a.ph_lo, hi = a.ph_hi;
    if (hi - lo > 1) bar = xcd_barrier_post((unsigned*)(a.ws + WS_CTL) + CW_BAR, misc + 8);
#ifndef PH_MASK
#define PH_MASK 0xFFFFFFFFu
#endif
#define EN(b) (((PH_MASK) >> (b)) & 1u)
#define IN(k) (lo <= (k) && (k) < hi)
#define SEAM(k) do { if ((k) + 1 < hi) xcd_barrier(bar); } while (0)

    if (EN(0) && IN(PH_P0A)) { p0a_phase(a, lds, G); SEAM(PH_P0A); }
    if (EN(1) && IN(PH_P0B)) { p0b_phase(a, G); SEAM(PH_P0B); }

#define WSP(T, off) ((T*)(a.ws + (off)))
#pragma unroll 1
    for (int l = 0; l < DEPTH; ++l) {
        const int pb = PH_L0 + l * PH_PER_LAYER;
#define MODL (WSP(const float, WS_MOD) + (size_t)l * NB * ADA)
#define XIN_P (l == 0 ? a.in[0] : WSP(const float, WS_XA))
#define XIN_S (l == 0 ? a.in[1] : WSP(const float, WS_XA) + (size_t)NPR * DM)
        if (EN(2) && IN(pb + 0)) { norm_phase(XIN_P, XIN_S, a.in[8] + l * DM, MODL, 0, WSP(bf16, WS_H), G); SEAM(pb + 0); }
        if (EN(3) && IN(pb + 1)) {
            pg8::Gemm g{WSP(const bf16, WS_H), (const bf16*)(a.ws + WS_WIN + l * SZ_WIN), MROWS, NINP, DM}; pg8::StaticOrder S; S.init(MROWS, NINP, G, (int)blockIdx.x);
            EpiProj E{WSP(bf16, WS_P), WSP(float, WS_DT)};
            pg8::gemm_phase<EpiProj, pg8::StaticOrder, true, true>(lds, g, S, E);
            SEAM(pb + 1);
        }
        if (EN(4) && IN(pb + 2)) { k1_phase(a, l, lds, G); SEAM(pb + 2); }
        if (EN(5) && IN(pb + 3)) { k2_phase(a, l, G); SEAM(pb + 3); }
        if (EN(6) && IN(pb + 4)) { k3_phase(a, l, lds, G); SEAM(pb + 4); }
        if (EN(7) && IN(pb + 5)) { pool_phase(a, l, G); SEAM(pb + 5); }
        if (EN(8) && IN(pb + 6)) {
            pg8::Gemm g{WSP(const bf16, WS_MIX), (const bf16*)(a.ws + WS_WOUT + l * SZ_WOUT), MROWS, DM, DM}; pg8::StaticOrder S; S.init(MROWS, DM, G, (int)blockIdx.x);
            EpiRes E{XIN_P, XIN_S, WSP(float, WS_XB), MODL + 2 * DM, WSP(const float, WS_R)};
            pg8::gemm_phase<EpiRes, pg8::StaticOrder, true, true>(lds, g, S, E);
            SEAM(pb + 6);
        }
        if (EN(9) && IN(pb + 7)) { norm_phase(WSP(const float, WS_XB), WSP(const float, WS_XB) + (size_t)NPR * DM, a.in[9] + l * DM, MODL, 3, WSP(bf16, WS_H), G); SEAM(pb + 7); }
        if (EN(10) && IN(pb + 8)) {
            pg8::Gemm g{WSP(const bf16, WS_H), (const bf16*)(a.ws + WS_WUP + l * SZ_WUP), MROWS, NUP, DM}; pg8::StaticOrder S; S.init(MROWS, NUP, G, (int)blockIdx.x);
            EpiBf E{WSP(bf16, WS_UP), NUP};
            pg8::gemm_phase<EpiBf, pg8::StaticOrder, true, true>(lds, g, S, E);
            SEAM(pb + 8);
        }
        if (EN(11) && IN(pb + 9)) { act_phase(a, l, G); SEAM(pb + 9); }
        if (EN(12) && IN(pb + 10)) {
            pg8::Gemm g{WSP(const bf16, WS_ACT), (const bf16*)(a.ws + WS_WDN + l * SZ_WDN), MROWS, DM, DFF}; pg8::StaticOrder S; S.init(MROWS, DM, G, (int)blockIdx.x);
            EpiRes E{WSP(const float, WS_XB), WSP(const float, WS_XB) + (size_t)NPR * DM, WSP(float, WS_XA), MODL + 5 * DM, nullptr};
            pg8::gemm_phase<EpiRes, pg8::StaticOrder, true, true>(lds, g, S, E);
            SEAM(pb + 10);
        }
    }
    if (EN(13) && IN(PH_FINAL)) final_phase(WSP(const float, WS_XA), a.in[26], a.out + O_YP, G);
#undef IN
#undef SEAM
#undef G
}

extern "C" void kernel_launch(void* const* d_in, const int* in_sizes, int n_in, void* d_out, int out_size, void* d_ws, size_t ws_size, hipStream_t stream) {
    static int grid = 0;
    if (grid == 0) {
        if (n_in != 27 || (size_t)out_size != O_END || ws_size < WS_END) { fprintf(stderr, "kernel_launch: unexpected problem shape (n_in %d, out %d, ws %zu; need ws >= %zu)\n", n_in, out_size, ws_size, (size_t)WS_END); grid = -1; return; }
        int dev = 0, cus = 0, per_cu = 0;
        if (hipGetDevice(&dev) != hipSuccess || hipDeviceGetAttribute(&cus, hipDeviceAttributeMultiprocessorCount, dev) != hipSuccess) { grid = -1; return; }
        if (hipFuncSetAttribute((const void*)fwd_kernel, hipFuncAttributeMaxDynamicSharedMemorySize, LDS_BYTES) != hipSuccess) { fprintf(stderr, "kernel_launch: hipFuncSetAttribute failed\n"); grid = -1; return; }
        if (hipOccupancyMaxActiveBlocksPerMultiprocessor(&per_cu, (const void*)fwd_kernel, NTHR, LDS_BYTES) != hipSuccess || per_cu < 1) { fprintf(stderr, "kernel_launch: occupancy query says %d blocks per CU\n", per_cu); (void)hipGetLastError(); grid = -1; return; }
        grid = cus;
    }
    if (grid < 0) return;
    (void)hipMemsetAsync((char*)d_ws + WS_CTL, 0, CTL_BYTES, stream);
    Args a{};
    for (int i = 0; i < 27; ++i) a.in[i] = (const float*)d_in[i];
    a.out = (float*)d_out; a.ws = (unsigned char*)d_ws;
#if N_LAUNCH_MODE == 1
    a.ph_lo = 0; a.ph_hi = N_PHASES;
    hipLaunchKernelGGL(fwd_kernel, dim3(grid), dim3(NTHR), LDS_BYTES, stream, a);
#else
    for (int p = 0; p < N_PHASES; ++p) { a.ph_lo = p; a.ph_hi = p + 1; hipLaunchKernelGGL(fwd_kernel, dim3(grid), dim3(NTHR), LDS_BYTES, stream, a); }
#endif
}
```

```cpp
#include <hip/hip_runtime.h>
#include <cstdio>
#include <cstdint>
namespace pg8 {
#define PG8_LAS __attribute__((address_space(3)))
typedef unsigned short bf16_t;
typedef short bf16x8 __attribute__((ext_vector_type(8)));
typedef float f32x4 __attribute__((ext_vector_type(4)));
typedef unsigned u32x4 __attribute__((ext_vector_type(4)));
constexpr int BM = 256, BK = 64, HALF = 128, HTB = HALF * BK * 2  , STAGE_BYTES = 8 * HTB, NXCD = 8, WGM = 8;

__host__ __device__ __forceinline__ int lds_byte(int r, int c) { const int st = (r >> 4) * 2 + (c >> 5), rr = r & 15, cc = c & 31, ob = rr * 64 + cc * 2; return st * 1024 + (ob ^ (((ob >> 9) & 1) << 5)); }
__host__ __device__ __forceinline__ void stage_rc(int b, int& R, int& C) { const int st = b / 1024, sb = b % 1024, swz = sb ^ (((sb >> 9) & 1) << 5); R = (st >> 1) * 16 + swz / 64; C = (st & 1) * 32 + (swz % 64) / 2; }
__host__ __device__ __forceinline__ int perm32(int rho) { const int n = rho >> 4, i = rho & 15; return 8 * (i >> 2) + 4 * n + (i & 3); }

struct Unit { int pm, pn; };
struct Gemm { const bf16_t* A; const bf16_t* Bt; int M, N, K; };

struct StaticOrder {
    int nM, nN, nwg, G, c;
    __host__ __device__ void init(int M, int N, int G_, int c_) { nM = M / BM; nN = N / BM; nwg = nM * nN; G = G_; c = c_; }
    __host__ __device__ bool next(int i, Unit& u) const {
        const long L = (long)i * G + c; if (L >= nwg) return false;
        int wgid = (int)L; { const int q = nwg / NXCD, r = nwg % NXCD, xcd = wgid % NXCD, off = wgid / NXCD; wgid = (xcd < r ? xcd * (q + 1) : r * (q + 1) + (xcd - r) * q) + off; }
        const int nig = WGM * nN, gid = wgid / nig, fm = gid * WGM, gsz = (nM - fm) < WGM ? (nM - fm) : WGM;
        u.pm = fm + ((wgid % nig) % gsz); u.pn = (wgid % nig) / gsz; return true;
    }
    __device__ __forceinline__ void a_ready(const Unit&) const {}
    __device__ __forceinline__ void done(const Unit&) const {}
};

__device__ __forceinline__ unsigned cvt_pk_bf16(float lo, float hi) { unsigned r; asm volatile("v_cvt_pk_bf16_f32 %0, %1, %2" : "=v"(r) : "v"(lo), "v"(hi)); return r; }
typedef float f32x2 __attribute__((ext_vector_type(2)));
template <class Epi, class Sched, bool ALIGN_EPI = false, bool SP2 = false>
__device__ __forceinline__ void gemm_phase(PG8_LAS unsigned char* lds, const Gemm g, const Sched& S, const Epi& E) {
    int tid_ = threadIdx.x; asm volatile("" : "+v"(tid_)); const int tid = tid_, wid = __builtin_amdgcn_readfirstlane(tid >> 6), lane = tid & 63, wr = wid >> 2, wc = wid & 3, fr = lane & 15, fq = lane >> 4;
    const int K = g.K, nt = K / BK;
    unsigned voffA[2], voffB[2];
#pragma unroll
    for (int i = 0; i < 2; ++i) { int R, C; stage_rc(tid * 16 + i * 8192, R, C); const int Rb = Epi::PERM ? ((R & ~31) + perm32(R & 31)) : R;
        voffA[i] = (unsigned)(R * K + C) * 2u; voffB[i] = (unsigned)(Rb * K + C) * 2u; }
    const size_t kstep = (size_t)(BK * 2);
    const size_t hstep = (size_t)HALF * K * 2;
    const size_t tstep = 2 * hstep;
    const unsigned ldsw = (unsigned)wid * 1024u;
    const int aoff = lds_byte(wr * 64 + fr, fq * 8), boff = lds_byte(wc * 32 + fr, fq * 8);
#define PG8_SA(b, h) (((b) * 2 + (h)) * HTB)
#define PG8_SB(b, h) ((4 + (b) * 2 + (h)) * HTB)
#define PG8_STAGE(bufoff, gbase, voff) do { _Pragma("unroll") for (int _i = 0; _i < 2; ++_i) \
        __builtin_amdgcn_global_load_lds((const unsigned*)((const char*)(gbase) + (voff)[_i]), (PG8_LAS unsigned*)(lds + (bufoff) + ldsw + _i * 8192), 16, 0, 0); } while (0)
#define PG8_LDA(dst, b, h) do { _Pragma("unroll") for (int m = 0; m < 4; ++m) _Pragma("unroll") for (int k = 0; k < 2; ++k) dst[m][k] = *(const PG8_LAS bf16x8*)(lds + PG8_SA(b, h) + aoff + m * 2048 + k * 1024); } while (0)
#define PG8_LDB(dst, b, h) do { _Pragma("unroll") for (int n = 0; n < 2; ++n) _Pragma("unroll") for (int k = 0; k < 2; ++k) dst[n][k] = *(const PG8_LAS bf16x8*)(lds + PG8_SB(b, h) + boff + n * 2048 + k * 1024); } while (0)
#define PG8_MMA(ai, bj, At, Bt) do { __builtin_amdgcn_s_setprio(1); _Pragma("unroll") for (int m = 0; m < 4; ++m) _Pragma("unroll") for (int n = 0; n < 2; ++n) _Pragma("unroll") for (int k = 0; k < 2; ++k) \
        acc[ai][bj][m][n] = __builtin_amdgcn_mfma_f32_16x16x32_bf16(Bt[n][k], At[m][k], acc[ai][bj][m][n], 0, 0, 0); __builtin_amdgcn_s_setprio(0); } while (0)
#define PG8_WAIT_V(n) asm volatile("s_waitcnt vmcnt(" #n ")" ::: "memory")
#define PG8_WAIT_L(n) asm volatile("s_waitcnt lgkmcnt(" #n ")" ::: "memory")
#define PG8_BAR __builtin_amdgcn_s_barrier()
#define PG8_SCHED __builtin_amdgcn_sched_barrier(0)
    Unit cur, nxt; int ui = 0;
    if (!S.next(0, cur)) return;
    f32x4 acc[2][2][4][2];
#pragma unroll
    for (int a = 0; a < 2; ++a)
#pragma unroll
        for (int b = 0; b < 2; ++b)
#pragma unroll
            for (int m = 0; m < 4; ++m)
#pragma unroll
                for (int n = 0; n < 2; ++n) acc[a][b][m][n] = (f32x4){0.f, 0.f, 0.f, 0.f};
    bf16x8 At[4][2], B0[2][2], B1[2][2];
    const char* cA = (const char*)g.A + (size_t)cur.pm * tstep; const char* cB = (const char*)g.Bt + (size_t)cur.pn * tstep;
    S.a_ready(cur);
    if constexpr (SP2) {
        PG8_STAGE(PG8_SB(0, 0), cB, voffB); PG8_STAGE(PG8_SB(0, 1), cB + hstep, voffB); PG8_STAGE(PG8_SA(0, 0), cA, voffA); PG8_STAGE(PG8_SA(0, 1), cA + hstep, voffA);
        if (wr == 1) PG8_BAR;
        PG8_WAIT_V(2); PG8_BAR;
        PG8_STAGE(PG8_SB(1, 0), cB + kstep, voffB); PG8_STAGE(PG8_SA(1, 0), cA + kstep, voffA); PG8_STAGE(PG8_SB(1, 1), cB + hstep + kstep, voffB);
        PG8_WAIT_V(6); PG8_BAR;
    } else {
        PG8_STAGE(PG8_SB(0, 0), cB, voffB); PG8_STAGE(PG8_SA(0, 0), cA, voffA); PG8_STAGE(PG8_SB(0, 1), cB + hstep, voffB); PG8_STAGE(PG8_SA(0, 1), cA + hstep, voffA);
        if (wr == 1) PG8_BAR;
        PG8_WAIT_V(4); PG8_BAR;
        PG8_STAGE(PG8_SB(1, 0), cB + kstep, voffB); PG8_STAGE(PG8_SA(1, 0), cA + kstep, voffA); PG8_STAGE(PG8_SB(1, 1), cB + hstep + kstep, voffB);
        PG8_WAIT_V(6); PG8_BAR;
    }
    for (;;) {
        const bool has_next = S.next(ui + 1, nxt);
        const char* nA = has_next ? (const char*)g.A + (size_t)nxt.pm * tstep : cA; const char* nB = has_next ? (const char*)g.Bt + (size_t)nxt.pn * tstep : cB;
        for (int t = 0; t < nt; t += 2) {
            const bool last = (t == nt - 2);
            const char* a1 = cA + (size_t)(t + 1) * kstep;
            const char* a2 = last ? nA : cA + (size_t)(t + 2) * kstep; const char* b2 = last ? nB : cB + (size_t)(t + 2) * kstep;
            const char* a3 = a2 + kstep; const char* b3 = b2 + kstep;
            if (last && has_next) S.a_ready(nxt);
            if constexpr (SP2) {
            PG8_LDB(B0, 0, 0); PG8_LDB(B1, 0, 1); PG8_SCHED; PG8_LDA(At, 0, 0); PG8_STAGE(PG8_SA(1, 1), a1 + hstep, voffA);
            PG8_WAIT_V(8); PG8_WAIT_L(0); PG8_BAR; PG8_MMA(0, 0, At, B0); PG8_MMA(0, 1, At, B1); PG8_BAR; PG8_SCHED;
            PG8_LDA(At, 0, 1); PG8_STAGE(PG8_SB(0, 0), b2, voffB); PG8_STAGE(PG8_SB(0, 1), b2 + hstep, voffB); PG8_STAGE(PG8_SA(0, 0), a2, voffA);
            PG8_WAIT_V(8); PG8_WAIT_L(0); PG8_BAR; PG8_MMA(1, 0, At, B0); PG8_MMA(1, 1, At, B1); PG8_BAR; PG8_SCHED;
            PG8_LDB(B0, 1, 0); PG8_LDB(B1, 1, 1); PG8_SCHED; PG8_LDA(At, 1, 0); PG8_STAGE(PG8_SA(0, 1), a2 + hstep, voffA);
            PG8_WAIT_V(8); PG8_WAIT_L(0); PG8_BAR; PG8_MMA(0, 0, At, B0); PG8_MMA(0, 1, At, B1); PG8_BAR; PG8_SCHED;
            PG8_LDA(At, 1, 1); PG8_STAGE(PG8_SB(1, 0), b3, voffB); PG8_STAGE(PG8_SB(1, 1), b3 + hstep, voffB); PG8_STAGE(PG8_SA(1, 0), a3, voffA);
            PG8_WAIT_V(8); PG8_WAIT_L(0); PG8_BAR; PG8_MMA(1, 0, At, B0); PG8_MMA(1, 1, At, B1); PG8_BAR; PG8_SCHED;
            } else {
            PG8_LDB(B0, 0, 0); PG8_SCHED; PG8_LDA(At, 0, 0); PG8_STAGE(PG8_SA(1, 1), a1 + hstep, voffA);
            PG8_WAIT_L(8); PG8_BAR; PG8_WAIT_L(0); PG8_MMA(0, 0, At, B0); PG8_BAR; PG8_SCHED;
            PG8_LDB(B1, 0, 1); PG8_STAGE(PG8_SB(0, 0), b2, voffB);
            PG8_BAR; PG8_WAIT_L(0); PG8_MMA(0, 1, At, B1); PG8_BAR;
            PG8_LDA(At, 0, 1); PG8_STAGE(PG8_SA(0, 0), a2, voffA);
            PG8_BAR; PG8_WAIT_L(0); PG8_MMA(1, 0, At, B0); PG8_BAR; PG8_SCHED;
            PG8_STAGE(PG8_SB(0, 1), b2 + hstep, voffB);
            PG8_WAIT_V(6); PG8_BAR; PG8_MMA(1, 1, At, B1); PG8_BAR;
            PG8_LDB(B0, 1, 0); PG8_SCHED; PG8_LDA(At, 1, 0); PG8_STAGE(PG8_SA(0, 1), a2 + hstep, voffA);
            PG8_WAIT_L(8); PG8_BAR; PG8_WAIT_L(0); PG8_MMA(0, 0, At, B0); PG8_BAR; PG8_SCHED;
            PG8_LDB(B1, 1, 1); PG8_STAGE(PG8_SB(1, 0), b3, voffB);
            PG8_BAR; PG8_WAIT_L(0); PG8_MMA(0, 1, At, B1); PG8_BAR;
            PG8_LDA(At, 1, 1); PG8_STAGE(PG8_SA(1, 0), a3, voffA);
            PG8_BAR; PG8_WAIT_L(0); PG8_MMA(1, 0, At, B0); PG8_BAR; PG8_SCHED;
            PG8_STAGE(PG8_SB(1, 1), b3 + hstep, voffB);
            PG8_WAIT_V(6); PG8_BAR; PG8_MMA(1, 1, At, B1); PG8_BAR;
            }
        }
        if constexpr (ALIGN_EPI) { if (wr == 0) PG8_BAR; }
        if constexpr (!Epi::AFTER_DRAIN) { E(acc, cur, wr, wc, fr, fq); S.done(cur); }
        if (!has_next) break;
#pragma unroll
        for (int a = 0; a < 2; ++a)
#pragma unroll
            for (int b = 0; b < 2; ++b)
#pragma unroll
                for (int m = 0; m < 4; ++m)
#pragma unroll
                    for (int n = 0; n < 2; ++n) acc[a][b][m][n] = (f32x4){0.f, 0.f, 0.f, 0.f};
        cur = nxt; cA = nA; cB = nB; ++ui;
        if constexpr (ALIGN_EPI) { if (wr == 1) PG8_BAR; }
    }
    PG8_WAIT_V(0);
    if constexpr (!ALIGN_EPI) { if (wr == 0) PG8_BAR; }
    PG8_BAR;
    if constexpr (Epi::AFTER_DRAIN) { E.fused(acc, cur, wr, wc, fr, fq, lds, wid, lane); S.done(cur); }
#undef PG8_SA
#undef PG8_SB
#undef PG8_STAGE
#undef PG8_LDA
#undef PG8_LDB
#undef PG8_MMA
#undef PG8_WAIT_V
#undef PG8_WAIT_L
#undef PG8_BAR
#undef PG8_SCHED
}
}
namespace pg8 {
template <class Epi, class Sched>
__device__ __forceinline__ void gemm_phase_x(PG8_LAS unsigned char* lds, const Gemm g, const bf16_t* AX, const Sched& S, const Epi& E) {
    static_assert(!Epi::PERM && !Epi::AFTER_DRAIN, "gemm_phase_x: plain f32 epilogues only");
    int tid_ = threadIdx.x; asm volatile("" : "+v"(tid_)); const int tid = tid_, wid = __builtin_amdgcn_readfirstlane(tid >> 6), lane = tid & 63, wr = wid >> 2, wc = wid & 3, fr = lane & 15, fq = lane >> 4;
    const int K = g.K, nt = K / BK;
    unsigned voffA[2], voffB[2];
#pragma unroll
    for (int i = 0; i < 2; ++i) { int R, C; stage_rc(tid * 16 + i * 8192, R, C); voffA[i] = (unsigned)(R * K + C) * 2u; voffB[i] = voffA[i]; }
    unsigned voffX; { const int b_ = lane * 16, swz = b_ ^ (((b_ >> 9) & 1) << 5), r = swz / 64, c = (swz % 64) / 2; voffX = (unsigned)(r * K + c + 32 * (wid & 1)) * 2u; }
    const size_t kstep = (size_t)(BK * 2), hstep = (size_t)HALF * K * 2, tstep = 2 * hstep, xstep = (size_t)16 * K * 2;
    const unsigned ldsw = (unsigned)wid * 1024u;
    const int aoff = lds_byte(wr * 64 + fr, fq * 8), boff = lds_byte(wc * 32 + fr, fq * 8), xoff = lds_byte(fr, fq * 8);
#define PG8_SA(b, h) (((b) * 2 + (h)) * HTB)
#define PG8_SB(b, h) ((4 + (b) * 2 + (h)) * HTB)
#define PG8_SX(b) (STAGE_BYTES + (b) * 2048)
#define PG8_STAGE(bufoff, gbase, voff) do { _Pragma("unroll") for (int _i = 0; _i < 2; ++_i) \
        __builtin_amdgcn_global_load_lds((const unsigned*)((const char*)(gbase) + (voff)[_i]), (PG8_LAS unsigned*)(lds + (bufoff) + ldsw + _i * 8192), 16, 0, 0); } while (0)
#define PG8_STAGEX(b, gbase) do { if (wid < 2) __builtin_amdgcn_global_load_lds((const unsigned*)((const char*)(gbase) + voffX), (PG8_LAS unsigned*)(lds + PG8_SX(b) + ldsw), 16, 0, 0); } while (0)
#define PG8_LDA(dst, b, h) do { _Pragma("unroll") for (int m = 0; m < 4; ++m) _Pragma("unroll") for (int k = 0; k < 2; ++k) dst[m][k] = *(const PG8_LAS bf16x8*)(lds + PG8_SA(b, h) + aoff + m * 2048 + k * 1024); } while (0)
#define PG8_LDB(dst, b, h) do { _Pragma("unroll") for (int n = 0; n < 2; ++n) _Pragma("unroll") for (int k = 0; k < 2; ++k) dst[n][k] = *(const PG8_LAS bf16x8*)(lds + PG8_SB(b, h) + boff + n * 2048 + k * 1024); } while (0)
#define PG8_LDX(b) do { _Pragma("unroll") for (int k = 0; k < 2; ++k) Ax[k] = *(const PG8_LAS bf16x8*)(lds + PG8_SX(b) + k * 1024 + xoff); } while (0)
#define PG8_MMA(ai, bj, At, Bt) do { __builtin_amdgcn_s_setprio(1); _Pragma("unroll") for (int m = 0; m < 4; ++m) _Pragma("unroll") for (int n = 0; n < 2; ++n) _Pragma("unroll") for (int k = 0; k < 2; ++k) \
        acc[ai][bj][m][n] = __builtin_amdgcn_mfma_f32_16x16x32_bf16(Bt[n][k], At[m][k], acc[ai][bj][m][n], 0, 0, 0); __builtin_amdgcn_s_setprio(0); } while (0)
#define PG8_MMAX() do { if (wr == 0) { _Pragma("unroll") for (int n = 0; n < 2; ++n) _Pragma("unroll") for (int k = 0; k < 2; ++k) accx[n] = __builtin_amdgcn_mfma_f32_16x16x32_bf16(B0[n][k], Ax[k], accx[n], 0, 0, 0); } \
        else { _Pragma("unroll") for (int n = 0; n < 2; ++n) _Pragma("unroll") for (int k = 0; k < 2; ++k) accx[n] = __builtin_amdgcn_mfma_f32_16x16x32_bf16(B1[n][k], Ax[k], accx[n], 0, 0, 0); } } while (0)
#define PG8_WAIT_V(n) asm volatile("s_waitcnt vmcnt(" #n ")" ::: "memory")
#define PG8_WAIT_VX() do { if (wid < 2) PG8_WAIT_V(9); else PG8_WAIT_V(8); } while (0)
#define PG8_WAIT_L(n) asm volatile("s_waitcnt lgkmcnt(" #n ")" ::: "memory")
#define PG8_BAR __builtin_amdgcn_s_barrier()
#define PG8_SCHED __builtin_amdgcn_sched_barrier(0)
    Unit cur, nxt; int ui = 0;
    if (!S.next(0, cur)) return;
    f32x4 acc[2][2][4][2], accx[2];
#pragma unroll
    for (int a = 0; a < 2; ++a)
#pragma unroll
        for (int b = 0; b < 2; ++b)
#pragma unroll
            for (int m = 0; m < 4; ++m)
#pragma unroll
                for (int n = 0; n < 2; ++n) acc[a][b][m][n] = (f32x4){0.f, 0.f, 0.f, 0.f};
    accx[0] = (f32x4){0.f, 0.f, 0.f, 0.f}; accx[1] = (f32x4){0.f, 0.f, 0.f, 0.f};
    bf16x8 At[4][2], B0[2][2], B1[2][2], Ax[2];
    const char* cA = (const char*)g.A + (size_t)cur.pm * tstep; const char* cB = (const char*)g.Bt + (size_t)cur.pn * tstep; const char* cX = (const char*)AX + (size_t)cur.pm * xstep;
    S.a_ready(cur);
    PG8_STAGEX(0, cX); PG8_STAGEX(1, cX + kstep);
    PG8_STAGE(PG8_SB(0, 0), cB, voffB); PG8_STAGE(PG8_SB(0, 1), cB + hstep, voffB); PG8_STAGE(PG8_SA(0, 0), cA, voffA); PG8_STAGE(PG8_SA(0, 1), cA + hstep, voffA);
    if (wr == 1) PG8_BAR;
    PG8_WAIT_V(2); PG8_BAR;
    PG8_STAGE(PG8_SB(1, 0), cB + kstep, voffB); PG8_STAGE(PG8_SA(1, 0), cA + kstep, voffA); PG8_STAGE(PG8_SB(1, 1), cB + hstep + kstep, voffB);
    PG8_WAIT_V(6); PG8_BAR;
    for (;;) {
        const bool has_next = S.next(ui + 1, nxt);
        const char* nA = has_next ? (const char*)g.A + (size_t)nxt.pm * tstep : cA; const char* nB = has_next ? (const char*)g.Bt + (size_t)nxt.pn * tstep : cB;
        const char* nX = has_next ? (const char*)AX + (size_t)nxt.pm * xstep : cX;
        for (int t = 0; t < nt; t += 2) {
            const bool last = (t == nt - 2);
            const char* a1 = cA + (size_t)(t + 1) * kstep;
            const char* a2 = last ? nA : cA + (size_t)(t + 2) * kstep; const char* b2 = last ? nB : cB + (size_t)(t + 2) * kstep; const char* x2 = last ? nX : cX + (size_t)(t + 2) * kstep;
            const char* a3 = a2 + kstep; const char* b3 = b2 + kstep; const char* x3 = x2 + kstep;
            if (last && has_next) S.a_ready(nxt);
            PG8_LDB(B0, 0, 0); PG8_LDB(B1, 0, 1); PG8_SCHED; PG8_LDA(At, 0, 0); PG8_LDX(0); PG8_STAGE(PG8_SA(1, 1), a1 + hstep, voffA);
            PG8_WAIT_VX(); PG8_WAIT_L(0); PG8_BAR; PG8_MMA(0, 0, At, B0); PG8_MMA(0, 1, At, B1); PG8_MMAX(); PG8_BAR; PG8_SCHED;
            PG8_LDA(At, 0, 1); PG8_STAGE(PG8_SB(0, 0), b2, voffB); PG8_STAGE(PG8_SB(0, 1), b2 + hstep, voffB); PG8_STAGE(PG8_SA(0, 0), a2, voffA); PG8_STAGEX(0, x2);
            PG8_WAIT_VX(); PG8_WAIT_L(0); PG8_BAR; PG8_MMA(1, 0, At, B0); PG8_MMA(1, 1, At, B1); PG8_BAR; PG8_SCHED;
            PG8_LDB(B0, 1, 0); PG8_LDB(B1, 1, 1); PG8_SCHED; PG8_LDA(At, 1, 0); PG8_LDX(1); PG8_STAGE(PG8_SA(0, 1), a2 + hstep, voffA);
            PG8_WAIT_VX(); PG8_WAIT_L(0); PG8_BAR; PG8_MMA(0, 0, At, B0); PG8_MMA(0, 1, At, B1); PG8_MMAX(); PG8_BAR; PG8_SCHED;
            PG8_LDA(At, 1, 1); PG8_STAGE(PG8_SB(1, 0), b3, voffB); PG8_STAGE(PG8_SB(1, 1), b3 + hstep, voffB); PG8_STAGE(PG8_SA(1, 0), a3, voffA); PG8_STAGEX(1, x3);
            PG8_WAIT_VX(); PG8_WAIT_L(0); PG8_BAR; PG8_MMA(1, 0, At, B0); PG8_MMA(1, 1, At, B1); PG8_BAR; PG8_SCHED;
        }
        if (wr == 0) PG8_BAR;
        E(acc, cur, wr, wc, fr, fq); E.extra(accx, cur, wr, wc, fr, fq); S.done(cur);
        if (!has_next) break;
#pragma unroll
        for (int a = 0; a < 2; ++a)
#pragma unroll
            for (int b = 0; b < 2; ++b)
#pragma unroll
                for (int m = 0; m < 4; ++m)
#pragma unroll
                    for (int n = 0; n < 2; ++n) acc[a][b][m][n] = (f32x4){0.f, 0.f, 0.f, 0.f};
        accx[0] = (f32x4){0.f, 0.f, 0.f, 0.f}; accx[1] = (f32x4){0.f, 0.f, 0.f, 0.f};
        cur = nxt; cA = nA; cB = nB; cX = nX; ++ui;
        if (wr == 1) PG8_BAR;
    }
    PG8_WAIT_V(0);
    PG8_BAR;
#undef PG8_SA
#undef PG8_SB
#undef PG8_SX
#undef PG8_STAGE
#undef PG8_STAGEX
#undef PG8_LDA
#undef PG8_LDB
#undef PG8_LDX
#undef PG8_MMA
#undef PG8_MMAX
#undef PG8_WAIT_V
#undef PG8_WAIT_VX
#undef PG8_WAIT_L
#undef PG8_BAR
#undef PG8_SCHED
}
}

#define LAS __attribute__((address_space(3)))
#define GAS __attribute__((address_space(1)))
typedef unsigned short bf16;
typedef short bf16x8 __attribute__((ext_vector_type(8)));
typedef float f32x4 __attribute__((ext_vector_type(4)));
typedef float f32x16 __attribute__((ext_vector_type(16)));
typedef unsigned u32x4 __attribute__((ext_vector_type(4)));
typedef unsigned u32x2 __attribute__((ext_vector_type(2)));
#define RLX_AGENT __ATOMIC_RELAXED, __HIP_MEMORY_SCOPE_AGENT
#define LDS_WAIT() asm volatile("s_waitcnt lgkmcnt(0)" ::: "memory")
#define VM_WAIT() asm volatile("s_waitcnt vmcnt(0)" ::: "memory")

constexpr int NWAVES = 8, NTHR = 512;
constexpr int DM = 2048, NPR = 8192, NSR = 512, MROWS = 8704, SEQ = 2048, NBP = 4, NBS = 128, NB = 132, DEPTH = 4;
constexpr int NIN = 4632, NINP = 4864, PW = 4608;
constexpr int DFF = 5504, NUP = 11008;
constexpr int XBCW = 2560, SSDW = 1536, NH = 24, HD = 64, NG = 4, HPG = 6, DS = 128, POOLW = 512;
constexpr int NCH = 16;
constexpr int ADA = 12288;
constexpr float EPS = 1e-6f;

constexpr size_t O_YP = 0, O_YS = O_YP + (size_t)NPR * DM, O_PP = O_YS + (size_t)NSR * DM, O_CP = O_PP + (size_t)DEPTH * NBP * 15 * 512,
                 O_SP = O_CP + (size_t)DEPTH * NBP * 3 * XBCW, O_FP = O_SP + (size_t)DEPTH * NBP * NH * HD * DS, O_PS = O_FP + (size_t)DEPTH * NBP * 2 * DFF,
                 O_CS = O_PS + (size_t)DEPTH * NBS * 15 * 512, O_SS = O_CS + (size_t)DEPTH * NBS * 3 * XBCW, O_FS = O_SS + (size_t)DEPTH * NBS * NH * HD * DS,
                 O_END = O_FS + (size_t)DEPTH * NBS * 2 * DFF;
static_assert(O_END == 135557120ull, "output size");

constexpr size_t al256(size_t x) { return (x + 255) & ~(size_t)255; }
constexpr size_t WS_CTL = 0, CTL_BYTES = 1u << 20;
constexpr size_t WS_WIN = CTL_BYTES,                         SZ_WIN = (size_t)NINP * DM * 2;
constexpr size_t WS_WOUT = WS_WIN + DEPTH * SZ_WIN,          SZ_WOUT = (size_t)DM * DM * 2;
constexpr size_t WS_WUP = WS_WOUT + DEPTH * SZ_WOUT,         SZ_WUP = (size_t)NUP * DM * 2;
constexpr size_t WS_WDN = WS_WUP + DEPTH * SZ_WUP,           SZ_WDN = (size_t)DM * DFF * 2;
constexpr size_t WS_PWT = WS_WDN + DEPTH * SZ_WDN,           SZ_PWT = (size_t)4 * 128 * 128 * 2;
constexpr size_t WS_SC = WS_PWT + DEPTH * SZ_PWT;
constexpr size_t WS_MOD = al256(WS_SC + (size_t)160 * DM * 2);
constexpr size_t WS_H = al256(WS_MOD + (size_t)DEPTH * NB * ADA * 4);
constexpr size_t WS_P = al256(WS_H + (size_t)MROWS * DM * 2);
constexpr size_t WS_DT = al256(WS_P + (size_t)MROWS * PW * 2);
constexpr size_t WS_XC = al256(WS_DT + (size_t)MROWS * 32 * 4);
constexpr size_t WS_DTB = al256(WS_XC + (size_t)MROWS * XBCW * 2);
constexpr size_t WS_CSB = al256(WS_DTB + (size_t)MROWS * NH * 4);
constexpr size_t WS_S = al256(WS_CSB + (size_t)MROWS * NH * 4);
constexpr size_t WS_DEC = al256(WS_S + (size_t)NBP * NCH * NH * HD * DS * 4);
constexpr size_t WS_HS = al256(WS_DEC + (size_t)NBP * NCH * NH * 4);
constexpr size_t WS_MIX = al256(WS_HS + (size_t)NBP * NCH * NH * HD * DS * 2);
constexpr size_t WS_SSQ = al256(WS_MIX + (size_t)MROWS * DM * 2);
constexpr size_t WS_R = al256(WS_SSQ + (size_t)MROWS * NH * 4);
constexpr size_t WS_XA = al256(WS_R + (size_t)MROWS * 4);
constexpr size_t WS_XB = al256(WS_XA + (size_t)MROWS * DM * 4);
constexpr size_t WS_UP = al256(WS_XB + (size_t)MROWS * DM * 4);
constexpr size_t WS_ACT = al256(WS_UP + (size_t)MROWS * NUP * 2);
constexpr size_t WS_END = al256(WS_ACT + (size_t)MROWS * DFF * 2);

constexpr int CW_BAR = 4096;
constexpr int LDS_BYTES = 155648;
constexpr int LDS_MISC = 151552;

__device__ __forceinline__ float bflo(unsigned w) { return __uint_as_float(w << 16); }
__device__ __forceinline__ float bfhi(unsigned w) { return __uint_as_float(w & 0xffff0000u); }
__device__ __forceinline__ float bf1(bf16 b) { return __uint_as_float((unsigned)b << 16); }
__device__ __forceinline__ unsigned pk2(float lo, float hi) { return pg8::cvt_pk_bf16(lo, hi); }
__device__ __forceinline__ bf16 f2bf(float f) { return (bf16)(pk2(f, 0.f) & 0xffffu); }
__device__ __forceinline__ void unpack8(const u32x4 w, float (&v)[8]) { v[0] = bflo(w.x); v[1] = bfhi(w.x); v[2] = bflo(w.y); v[3] = bfhi(w.y); v[4] = bflo(w.z); v[5] = bfhi(w.z); v[6] = bflo(w.w); v[7] = bfhi(w.w); }
__device__ __forceinline__ u32x4 pack8(const float (&v)[8]) { u32x4 o; o.x = pk2(v[0], v[1]); o.y = pk2(v[2], v[3]); o.z = pk2(v[4], v[5]); o.w = pk2(v[6], v[7]); return o; }
__device__ __forceinline__ float silu_f(float x) { return x / (1.f + __expf(-x)); }
__device__ __forceinline__ float softplus_f(float x) { return x > 20.f ? x : log1pf(__expf(x)); }
__device__ __forceinline__ float wave_sum(float v) {
#pragma unroll
    for (int o = 1; o < 64; o <<= 1) v += __shfl_xor(v, o);
    return v;
}
#define MFMA16(a, b, c) __builtin_amdgcn_mfma_f32_16x16x32_bf16((a), (b), (c), 0, 0, 0)
__device__ __forceinline__ bf16x8 as_frag(u32x4 w) { return __builtin_bit_cast(bf16x8, w); }

struct Args {
    const float* in[27]; float* out; unsigned char* ws; int ph_lo, ph_hi;
};

__device__ __forceinline__ int row_bidx(int r) { return r < NPR ? (r >> 11) : 4 + ((r - NPR) >> 2); }

struct EpiProj {
    static constexpr bool PERM = true, AFTER_DRAIN = false;
    bf16* P; float* DT;
    __device__ __forceinline__ void operator()(const pg8::f32x4 (&acc)[2][2][4][2], const pg8::Unit& u, int wr, int wc, int fr, int fq) const {
        const int row0 = u.pm * 256 + wr * 64 + fr;
        if (u.pn < 18) {
            const int col0 = u.pn * 256 + wc * 32 + 8 * fq;
#pragma unroll
            for (int ai = 0; ai < 2; ++ai)
#pragma unroll
                for (int m = 0; m < 4; ++m) { bf16* rowp = P + (size_t)(row0 + ai * 128 + m * 16) * PW + col0;
#pragma unroll
                    for (int bj = 0; bj < 2; ++bj) { const pg8::f32x4 v0 = acc[ai][bj][m][0], v1 = acc[ai][bj][m][1];
                        u32x4 w; w.x = pk2(v0[0], v0[1]); w.y = pk2(v0[2], v0[3]); w.z = pk2(v1[0], v1[1]); w.w = pk2(v1[2], v1[3]);
                        *(u32x4*)(rowp + bj * 128) = w; } }
        } else if (wc == 0) {
#pragma unroll
            for (int ai = 0; ai < 2; ++ai)
#pragma unroll
                for (int m = 0; m < 4; ++m) { float* rowp = DT + (size_t)(row0 + ai * 128 + m * 16) * 32 + 8 * fq;
                    *(f32x4*)(rowp) = acc[ai][0][m][0]; *(f32x4*)(rowp + 4) = acc[ai][0][m][1]; }
        }
    }
};
struct EpiBf {
    static constexpr bool PERM = true, AFTER_DRAIN = false;
    bf16* O; int ldc;
    __device__ __forceinline__ void operator()(const pg8::f32x4 (&acc)[2][2][4][2], const pg8::Unit& u, int wr, int wc, int fr, int fq) const {
        const int row0 = u.pm * 256 + wr * 64 + fr, col0 = u.pn * 256 + wc * 32 + 8 * fq;
#pragma unroll
        for (int ai = 0; ai < 2; ++ai)
#pragma unroll
            for (int m = 0; m < 4; ++m) { bf16* rowp = O + (size_t)(row0 + ai * 128 + m * 16) * ldc + col0;
#pragma unroll
                for (int bj = 0; bj < 2; ++bj) { const pg8::f32x4 v0 = acc[ai][bj][m][0], v1 = acc[ai][bj][m][1];
                    u32x4 w; w.x = pk2(v0[0], v0[1]); w.y = pk2(v0[2], v0[3]); w.z = pk2(v1[0], v1[1]); w.w = pk2(v1[2], v1[3]);
                    *(u32x4*)(rowp + bj * 128) = w; } }
    }
};
struct EpiRes {
    static constexpr bool PERM = false, AFTER_DRAIN = false;
    const float* bp; const float* bs; float* out; const float* gate; const float* rs;
    __device__ __forceinline__ void operator()(const pg8::f32x4 (&acc)[2][2][4][2], const pg8::Unit& u, int wr, int wc, int fr, int fq) const {
        const int row0 = u.pm * 256 + wr * 64 + fr, col0 = u.pn * 256 + wc * 32 + 4 * fq;
#pragma unroll
        for (int ai = 0; ai < 2; ++ai)
#pragma unroll
            for (int m = 0; m < 4; ++m) {
                const int r = row0 + ai * 128 + m * 16;
                const float* brow = (r < NPR ? bp + (size_t)r * DM : bs + (size_t)(r - NPR) * DM) + col0;
                const float* grow = gate + (size_t)row_bidx(r) * ADA + col0;
                const float s = rs ? rs[r] : 1.f;
                float* orow = out + (size_t)r * DM + col0;
#pragma unroll
                for (int bj = 0; bj < 2; ++bj)
#pragma unroll
                    for (int n = 0; n < 2; ++n) { const int o = bj * 128 + n * 16;
                        const pg8::f32x4 b = *(const pg8::f32x4*)(brow + o), g = *(const pg8::f32x4*)(grow + o);
                        *(pg8::f32x4*)(orow + o) = b + g * (acc[ai][bj][m][n] * s); }
            }
    }
    __device__ __forceinline__ void extra(const pg8::f32x4 (&accx)[2], const pg8::Unit& u, int wr, int wc, int fr, int fq) const {
        const int r = NPR + 16 * u.pm + fr, col0 = u.pn * 256 + wr * 128 + wc * 32 + 4 * fq;
        const float* brow = bs + (size_t)(r - NPR) * DM + col0;
        const float* grow = gate + (size_t)row_bidx(r) * ADA + col0;
        const float s = rs ? rs[r] : 1.f;
        float* orow = out + (size_t)r * DM + col0;
#pragma unroll
        for (int n = 0; n < 2; ++n) { const int o = n * 16;
            const pg8::f32x4 b = *(const pg8::f32x4*)(brow + o), g = *(const pg8::f32x4*)(grow + o);
            *(pg8::f32x4*)(orow + o) = b + g * (accx[n] * s); }
    }
};

__device__ __forceinline__ void tr_item(const float* W, int K, int N, int nblk, bf16* WT, int mode, const float* ks0, const float* ks1, LAS float* scr, int item, int lane) {
    const int kb = item / nblk, nb = item % nblk, k0 = 64 * kb, n0 = 32 * nb;
    const int n = n0 + (lane & 31);
#pragma unroll 8
    for (int i = 0; i < 32; ++i) { const int kk = 2 * i + (lane >> 5); float v = (n < N) ? W[(size_t)(k0 + kk) * N + n] : 0.f;
        if (mode == 1) { const int k = k0 + kk; v *= (k < 512) ? ks0[k] : ks1[k - 512]; }
        scr[kk * 33 + (lane & 31)] = v; }
    LDS_WAIT(); asm volatile("" ::: "memory");
    const int c = lane & 7;
#pragma unroll
    for (int j = 0; j < 4; ++j) { const int nl = (lane >> 3) + 8 * j; const LAS float* s = scr + (8 * c) * 33 + nl;
        u32x4 o; o.x = pk2(s[0 * 33], s[1 * 33]); o.y = pk2(s[2 * 33], s[3 * 33]); o.z = pk2(s[4 * 33], s[5 * 33]); o.w = pk2(s[6 * 33], s[7 * 33]);
        const int nn = n0 + nl; int row = nn;
        if (mode == 2) row = nn < DFF ? ((nn >> 7) * 256 + (nn & 127)) : (((nn - DFF) >> 7) * 256 + 128 + ((nn - DFF) & 127));
        *(u32x4*)(WT + (size_t)row * K + k0 + 8 * c) = o; }
    LDS_WAIT(); asm volatile("" ::: "memory");
}
__device__ __forceinline__ void p0a_phase(const Args& a, LAS unsigned char* lds, int G) {
    unsigned char* ws_ = a.ws; asm volatile("" : "+s"(ws_));
    int tid_ = threadIdx.x; asm volatile("" : "+v"(tid_)); const int tid = tid_, lane = tid & 63, wave = tid >> 6;
    LAS float* scr = (LAS float*)(lds + wave * 8448);
    const int gw = blockIdx.x * NWAVES + wave, NGW = G * NWAVES;
    constexpr int I_IN = 32 * (NINP / 32), I_OUT = 32 * (DM / 32), I_UP = 32 * (NUP / 32), I_DN = (DFF / 64) * (DM / 32), I_PW = 4 * 2 * 4, I_L = I_IN + I_OUT + I_UP + I_DN + I_PW;
    for (int it = gw; it < DEPTH * I_L; it += NGW) {
        const int l = it / I_L; int r = it % I_L;
        if (r < I_IN) { tr_item(a.in[12] + (size_t)l * DM * NIN, DM, NIN, NINP / 32, (bf16*)(ws_ + WS_WIN + l * SZ_WIN), 0, nullptr, nullptr, scr, r, lane); continue; } r -= I_IN;
        if (r < I_OUT) { tr_item(a.in[21] + (size_t)l * DM * DM, DM, DM, DM / 32, (bf16*)(ws_ + WS_WOUT + l * SZ_WOUT), 1, a.in[14] + l * POOLW, a.in[20] + l * SSDW, scr, r, lane); continue; } r -= I_OUT;
        if (r < I_UP) { tr_item(a.in[22] + (size_t)l * DM * NUP, DM, NUP, NUP / 32, (bf16*)(ws_ + WS_WUP + l * SZ_WUP), 2, nullptr, nullptr, scr, r, lane); continue; } r -= I_UP;
        if (r < I_DN) { tr_item(a.in[25] + (size_t)l * DFF * DM, DFF, DM, DM / 32, (bf16*)(ws_ + WS_WDN + l * SZ_WDN), 0, nullptr, nullptr, scr, r, lane); continue; } r -= I_DN;
        { const int g = r / 8, q = r % 8; tr_item(a.in[13] + ((size_t)l * 4 + g) * 128 * 128, 128, 128, 4, (bf16*)(ws_ + WS_PWT + l * SZ_PWT) + (size_t)g * 128 * 128, 0, nullptr, nullptr, scr, q, lane); }
    }
    bf16* SC = (bf16*)(ws_ + WS_SC);
    for (int i = blockIdx.x * NTHR + tid; i < 160 * (DM / 4); i += G * NTHR) {
        const int row = i / (DM / 4), c4 = (i % (DM / 4)) * 4; f32x4 v = (f32x4){0.f, 0.f, 0.f, 0.f};
        if (row < NBP) v = *(const f32x4*)(a.in[2] + (size_t)row * DM + c4); else if (row < NB) v = *(const f32x4*)(a.in[3] + (size_t)(row - NBP) * DM + c4);
        u32x2 o; o.x = pk2(silu_f(v[0]), silu_f(v[1])); o.y = pk2(silu_f(v[2]), silu_f(v[3]));
        *(u32x2*)(SC + (size_t)row * DM + c4) = o;
    }
}
__device__ __forceinline__ void p0b_phase(const Args& a, int G) {
    unsigned char* ws_ = a.ws; asm volatile("" : "+s"(ws_));
    int tid_ = threadIdx.x; asm volatile("" : "+v"(tid_)); const int tid = tid_, lane = tid & 63, wave = tid >> 6, r = lane & 31, h = lane >> 5;
    const bf16* SC = (const bf16*)(ws_ + WS_SC); float* MOD = (float*)(ws_ + WS_MOD);
    for (int u = blockIdx.x; u < 256; u += G) {
        if (wave >= 6) continue;
        const int l = u >> 6, c0 = (u & 63) * 192 + wave * 32;
        const float* W = a.in[10] + (size_t)l * DM * ADA + c0 + r;
        f32x16 acc[5];
#pragma unroll
        for (int m = 0; m < 5; ++m)
#pragma unroll
            for (int e = 0; e < 16; ++e) acc[m][e] = 0.f;
#pragma unroll 1
        for (int kk = 0; kk < DM / 16; ++kk) {
            const int k0 = kk * 16 + 8 * h;
            float bv[8];
#pragma unroll
            for (int j = 0; j < 8; ++j) bv[j] = W[(size_t)(k0 + j) * ADA];
            const bf16x8 bfr = as_frag(pack8(bv));
#pragma unroll
            for (int m = 0; m < 5; ++m) { const bf16x8 afr = as_frag(*(const u32x4*)(SC + (size_t)(32 * m + r) * DM + k0));
                acc[m] = __builtin_amdgcn_mfma_f32_32x32x16_bf16(afr, bfr, acc[m], 0, 0, 0); }
        }
        const float bias = a.in[11][(size_t)l * ADA + c0 + r];
#pragma unroll
        for (int m = 0; m < 5; ++m)
#pragma unroll
            for (int e4 = 0; e4 < 4; ++e4) {
                const int rowb = 32 * m + 8 * e4 + 4 * h;
                float* p = MOD + ((size_t)l * NB + rowb) * ADA + c0 + r; asm volatile("" : "+v"(p));
#pragma unroll
                for (int e = 0; e < 4; ++e) if (rowb + e < NB) p[(size_t)e * ADA] = acc[m][4 * e4 + e] + bias;
            }
    }
}
__device__ __forceinline__ void norm_phase(const float* xp, const float* xs, const float* gamma, const float* modl, int shc, bf16* H, int G) {
    int tid_ = threadIdx.x; asm volatile("" : "+v"(tid_)); const int tid = tid_, lane = tid & 63, wave = tid >> 6;
    for (int row = blockIdx.x * NWAVES + wave; row < MROWS; row += G * NWAVES) {
        const float* xr = (row < NPR ? xp + (size_t)row * DM : xs + (size_t)(row - NPR) * DM) + 4 * lane;
        f32x4 v[8]; float ss = 0.f;
#pragma unroll
        for (int j = 0; j < 8; ++j) { v[j] = *(const f32x4*)(xr + 256 * j); ss += (v[j][0] * v[j][0] + v[j][1] * v[j][1]) + (v[j][2] * v[j][2] + v[j][3] * v[j][3]); }
        const float rstd = 1.f / sqrtf(wave_sum(ss) * (1.f / DM) + EPS);
        const float* mrow = modl + (size_t)row_bidx(row) * ADA + 4 * lane;
        bf16* hr = H + (size_t)row * DM + 4 * lane;
#pragma unroll
        for (int j = 0; j < 8; ++j) { const f32x4 g = *(const f32x4*)(gamma + 256 * j + 4 * lane), sh = *(const f32x4*)(mrow + shc * DM + 256 * j), sc = *(const f32x4*)(mrow + (shc + 1) * DM + 256 * j);
            const f32x4 y = (v[j] * rstd) * g * (sc + 1.f) + sh;
            u32x2 o; o.x = pk2(y[0], y[1]); o.y = pk2(y[2], y[3]); *(u32x2*)(hr + 256 * j) = o; }
    }
}
__device__ __forceinline__ void final_phase(const float* X, const float* gamma, float* out, int G) {
    int tid_ = threadIdx.x; asm volatile("" : "+v"(tid_)); const int tid = tid_, lane = tid & 63, wave = tid >> 6;
    for (int row = blockIdx.x * NWAVES + wave; row < MROWS; row += G * NWAVES) {
        const float* xr = X + (size_t)row * DM + 4 * lane;
        f32x4 v[8]; float ss = 0.f;
#pragma unroll
        for (int j = 0; j < 8; ++j) { v[j] = *(const f32x4*)(xr + 256 * j); ss += (v[j][0] * v[j][0] + v[j][1] * v[j][1]) + (v[j][2] * v[j][2] + v[j][3] * v[j][3]); }
        const float rstd = 1.f / sqrtf(wave_sum(ss) * (1.f / DM) + EPS);
        float* orow = out + (size_t)row * DM + 4 * lane;
#pragma unroll
        for (int j = 0; j < 8; ++j) { const f32x4 g = *(const f32x4*)(gamma + 256 * j + 4 * lane); *(f32x4*)(orow + 256 * j) = (v[j] * rstd) * g; }
    }
}
#define XB_TMO      128
#define XB_XCNT(j)  (256  + 64 * (j))
#define XB_XSUB(j)  (1280 + 64 * (j))
#define XB_XGEN(j)  (2304 + 64 * (j))
#define XB_TOP      3328
#define XB_TOPGEN   3392
#define XCD_BAR_WORDS 3456
#define XB_SPIN_CAP (1u << 18)

__device__ __forceinline__ unsigned xb_ld(unsigned* p)              { return __hip_atomic_load(p, __ATOMIC_RELAXED, __HIP_MEMORY_SCOPE_AGENT); }
__device__ __forceinline__ unsigned xb_add(unsigned* p, unsigned v) { return __hip_atomic_fetch_add(p, v, __ATOMIC_RELAXED, __HIP_MEMORY_SCOPE_AGENT); }
__device__ __forceinline__ unsigned xb_xcc_id() { return (unsigned)__builtin_amdgcn_s_getreg((3 << 11) | 20) & 0xFu; }
#define XB_SPIN(cond, bar) do { unsigned _sp = 0; while (cond) { __builtin_amdgcn_s_sleep(1); \
    if ((++_sp & 255u) == 0u) { if (xb_ld(&(bar)[XB_TMO])) break; if (_sp > XB_SPIN_CAP) { atomicAdd(&(bar)[XB_TMO], 1u); break; } } } } while (0)

struct XcdBarrier {
    unsigned* bar; unsigned x;
    volatile LAS unsigned* st;
};

__device__ __forceinline__ XcdBarrier xcd_barrier_post(unsigned* bar, volatile LAS unsigned* st) {
    XcdBarrier b; b.bar = bar; b.x = xb_xcc_id(); b.st = st;
    if (threadIdx.x == 0) (void)xb_add(&bar[XB_XCNT(b.x)], 1u);
    return b;
}
__device__ __forceinline__ void xcd_barrier_complete(unsigned* bar, unsigned x, unsigned& nloc, unsigned& nx) {
    const unsigned G = gridDim.x * gridDim.y * gridDim.z;
    unsigned sum, cnt, mine, sp = 0u;
    for (;;) {
        sum = 0u; cnt = 0u; mine = 0u;
#pragma unroll
        for (unsigned j = 0; j < 16; ++j) { const unsigned c = xb_ld(&bar[XB_XCNT(j)]); sum += c; cnt += (c > 0u) ? 1u : 0u; mine = (j == x) ? c : mine; }
        if (sum == G) break;
        __builtin_amdgcn_s_sleep(1);
        if ((++sp & 255u) == 0u) { if (xb_ld(&bar[XB_TMO])) break; if (sp > XB_SPIN_CAP) { atomicAdd(&bar[XB_TMO], 1u); break; } }
    }
    nloc = mine > 0u ? mine : 1u; nx = cnt > 0u ? cnt : 1u;
}

__device__ __forceinline__ void xcd_barrier(const XcdBarrier& b) {
    asm volatile("s_waitcnt vmcnt(0)" ::: "memory");
    __syncthreads();
    if (threadIdx.x == 0) {
        unsigned* bar = b.bar;
        __builtin_amdgcn_s_waitcnt(0);
        unsigned nloc = b.st[0], nx = b.st[1];
        if (nloc == 0u) { xcd_barrier_complete(bar, b.x, nloc, nx); b.st[0] = nloc; b.st[1] = nx; }
        const unsigned old = xb_add(&bar[XB_XSUB(b.x)], 1u);
        const unsigned gen = old / nloc;
        if (old + 1u == (gen + 1u) * nloc) {
            __builtin_amdgcn_fence(__ATOMIC_RELEASE, "agent");
            asm volatile("s_waitcnt vmcnt(0)" ::: "memory");
            const unsigned og = xb_add(&bar[XB_TOP], 1u);
            const unsigned tg = og / nx;
            if (og + 1u == (tg + 1u) * nx) xb_add(&bar[XB_TOPGEN], 1u);
            else XB_SPIN(xb_ld(&bar[XB_TOPGEN]) == tg, bar);
            __builtin_amdgcn_fence(__ATOMIC_ACQUIRE, "agent");
            xb_add(&bar[XB_XGEN(b.x)], 1u);
            asm volatile("s_waitcnt vmcnt(0)" ::: "memory");
        } else {
            XB_SPIN(xb_ld(&bar[XB_XGEN(b.x)]) == gen, bar);
            __builtin_amdgcn_fence(__ATOMIC_ACQUIRE, "agent");
            asm volatile("s_waitcnt vmcnt(0)" ::: "memory");
        }
    }
    __syncthreads();
}

constexpr int LSTR = 136;
__device__ __forceinline__ int k1_chan(int g, int ch8) { return ch8 < 48 ? 384 * g + 8 * ch8 : (ch8 < 64 ? SSDW + 128 * g + 8 * (ch8 - 48) : SSDW + 512 + 128 * g + 8 * (ch8 - 64)); }

__device__ __forceinline__ void k1_phase(const Args& a, int l, LAS unsigned char* lds, int G) {
    unsigned char* ws_ = a.ws; asm volatile("" : "+s"(ws_));
    int tid_ = threadIdx.x; asm volatile("" : "+v"(tid_)); const int tid = tid_, lane = tid & 63, wave = __builtin_amdgcn_readfirstlane(tid >> 6), q = lane >> 4, fr = lane & 15;
    const bf16* P = (const bf16*)(ws_ + WS_P); const float* DT = (const float*)(ws_ + WS_DT);
    bf16* XC = (bf16*)(ws_ + WS_XC); float* DTB = (float*)(ws_ + WS_DTB); float* CSB = (float*)(ws_ + WS_CSB);
    float* S = (float*)(ws_ + WS_S); float* DEC = (float*)(ws_ + WS_DEC);
    const float* cw = a.in[15] + (size_t)l * 4 * XBCW; const float* cb = a.in[16] + (size_t)l * XBCW;
    const float* dtb = a.in[17] + l * NH; const float* alog = a.in[18] + l * NH;
    LAS bf16* xdT = (LAS bf16*)lds;
    LAS bf16* BT = (LAS bf16*)(lds + 6 * 64 * LSTR * 2);
    LAS float* csL = (LAS float*)(lds + 6 * 64 * LSTR * 2 + 128 * LSTR * 2);
    LAS float* scL = csL + 6 * 128;
    for (int u = blockIdx.x; u < NBP * NCH * NG; u += G) {
        const int b = u >> 6, c = (u >> 2) & 15, g = u & 3, r0 = b * SEQ + c * 128;
        if (wave < HPG) {
            const int h = HPG * g + wave; const float A = -__expf(alog[h]), bias = dtb[h];
            const int t0 = 2 * lane;
            const float d0 = softplus_f(DT[(size_t)(r0 + t0) * 32 + h] + bias), d1 = softplus_f(DT[(size_t)(r0 + t0 + 1) * 32 + h] + bias);
            const float a0 = d0 * A, a1 = d1 * A; float s = a0 + a1;
#pragma unroll
            for (int o = 1; o < 64; o <<= 1) { const float t = __shfl_up(s, o); if (lane >= o) s += t; }
            const float cs1 = s, cs0 = s - a1, tot = __shfl(s, 63);
            csL[wave * 128 + t0] = cs0; csL[wave * 128 + t0 + 1] = cs1;
            scL[wave * 128 + t0] = d0 * __expf(tot - cs0); scL[wave * 128 + t0 + 1] = d1 * __expf(tot - cs1);
            DTB[(size_t)(r0 + t0) * NH + h] = d0; DTB[(size_t)(r0 + t0 + 1) * NH + h] = d1;
            CSB[(size_t)(r0 + t0) * NH + h] = cs0; CSB[(size_t)(r0 + t0 + 1) * NH + h] = cs1;
            if (lane == 0) DEC[(b * NCH + c) * NH + h] = __expf(tot);
        }
        __syncthreads();
        for (int it = tid; it < 80 * 16; it += NTHR) {
            const int ch8 = it % 80, tt0 = (it / 80) * 8, j0 = k1_chan(g, ch8);
            float w[4][8], bb[8];
#pragma unroll
            for (int i = 0; i < 4; ++i) { const f32x4 w0 = *(const f32x4*)(cw + i * XBCW + j0), w1 = *(const f32x4*)(cw + i * XBCW + j0 + 4);
#pragma unroll
                for (int j = 0; j < 4; ++j) { w[i][j] = w0[j]; w[i][4 + j] = w1[j]; } }
            { const f32x4 b0 = *(const f32x4*)(cb + j0), b1 = *(const f32x4*)(cb + j0 + 4);
#pragma unroll
              for (int j = 0; j < 4; ++j) { bb[j] = b0[j]; bb[4 + j] = b1[j]; } }
            float xm3[8], xm2[8], xm1[8];
            const bf16* src = P + (size_t)(r0 + tt0) * PW + 2048 + j0;
            const bool has_prev = (c * 128 + tt0) > 0;
            if (has_prev) { unpack8(*(const u32x4*)(src - 3 * PW), xm3); unpack8(*(const u32x4*)(src - 2 * PW), xm2); unpack8(*(const u32x4*)(src - PW), xm1); }
            else {
#pragma unroll
                for (int j = 0; j < 8; ++j) { xm3[j] = 0.f; xm2[j] = 0.f; xm1[j] = 0.f; } }
#pragma unroll
            for (int t = 0; t < 8; ++t) {
                float cur[8], o[8]; unpack8(*(const u32x4*)(src + (size_t)t * PW), cur);
#pragma unroll
                for (int j = 0; j < 8; ++j) o[j] = silu_f(bb[j] + w[0][j] * xm3[j] + w[1][j] * xm2[j] + w[2][j] * xm1[j] + w[3][j] * cur[j]);
                *(u32x4*)(XC + (size_t)(r0 + tt0 + t) * XBCW + j0) = pack8(o);
                const int tt = tt0 + t;
                if (ch8 < 48) { const int hh = ch8 >> 3, p0 = 8 * (ch8 & 7); const float sc = scL[hh * 128 + tt];
#pragma unroll
                    for (int j = 0; j < 8; ++j) xdT[(hh * 64 + p0 + j) * LSTR + tt] = f2bf(o[j] * sc);
                } else if (ch8 < 64) { const int n0 = 8 * (ch8 - 48);
#pragma unroll
                    for (int j = 0; j < 8; ++j) BT[(n0 + j) * LSTR + tt] = f2bf(o[j]); }
#pragma unroll
                for (int j = 0; j < 8; ++j) { xm3[j] = xm2[j]; xm2[j] = xm1[j]; xm1[j] = cur[j]; }
            }
        }
        if (c == NCH - 1) {
            float* o = a.out + O_CP + ((size_t)l * NBP + b) * 3 * XBCW;
            for (int it = tid; it < 3 * 640; it += NTHR) { const int i = it / 640, cc = it % 640, j = k1_chan(g, cc >> 3) + (cc & 7);
                o[i * XBCW + j] = bf1(P[(size_t)(r0 + 125 + i) * PW + 2048 + j]); }
        }
        __syncthreads();
#pragma unroll 1
        for (int hh = 0; hh < HPG; ++hh) {
            f32x4 acc[4];
#pragma unroll
            for (int pt = 0; pt < 4; ++pt) acc[pt] = (f32x4){0.f, 0.f, 0.f, 0.f};
#pragma unroll
            for (int ks = 0; ks < 4; ++ks) {
                const bf16x8 bfr = *(const LAS bf16x8*)(BT + (16 * wave + fr) * LSTR + 32 * ks + 8 * q);
#pragma unroll
                for (int pt = 0; pt < 4; ++pt) { const bf16x8 afr = *(const LAS bf16x8*)(xdT + (hh * 64 + 16 * pt + fr) * LSTR + 32 * ks + 8 * q);
                    acc[pt] = MFMA16(bfr, afr, acc[pt]); }
            }
            float* so = S + ((size_t)(b * NCH + c) * NH + HPG * g + hh) * (HD * DS) + 16 * wave + 4 * q;
#pragma unroll
            for (int pt = 0; pt < 4; ++pt) *(f32x4*)(so + (size_t)(16 * pt + fr) * DS) = acc[pt];
        }
        __syncthreads();
    }
    {
        const float* st = a.in[5] + (size_t)l * NBS * 3 * XBCW;
        float* oc = a.out + O_CS + (size_t)l * NBS * 3 * XBCW;
        for (int it = blockIdx.x * NTHR + tid; it < NBS * (XBCW / 8); it += G * NTHR) {
            const int bs = it / (XBCW / 8), j0 = (it % (XBCW / 8)) * 8, rs0 = NPR + 4 * bs;
            float full[7][8];
#pragma unroll
            for (int i = 0; i < 3; ++i) { const f32x4 p0 = *(const f32x4*)(st + ((size_t)bs * 3 + i) * XBCW + j0), p1 = *(const f32x4*)(st + ((size_t)bs * 3 + i) * XBCW + j0 + 4);
#pragma unroll
                for (int j = 0; j < 4; ++j) { full[i][j] = p0[j]; full[i][4 + j] = p1[j]; } }
#pragma unroll
            for (int t = 0; t < 4; ++t) unpack8(*(const u32x4*)(P + (size_t)(rs0 + t) * PW + 2048 + j0), full[3 + t]);
            float w[4][8], bb[8];
#pragma unroll
            for (int i = 0; i < 4; ++i) { const f32x4 w0 = *(const f32x4*)(cw + i * XBCW + j0), w1 = *(const f32x4*)(cw + i * XBCW + j0 + 4);
#pragma unroll
                for (int j = 0; j < 4; ++j) { w[i][j] = w0[j]; w[i][4 + j] = w1[j]; } }
            { const f32x4 b0 = *(const f32x4*)(cb + j0), b1 = *(const f32x4*)(cb + j0 + 4);
#pragma unroll
              for (int j = 0; j < 4; ++j) { bb[j] = b0[j]; bb[4 + j] = b1[j]; } }
#pragma unroll
            for (int t = 0; t < 4; ++t) { float o[8];
#pragma unroll
                for (int j = 0; j < 8; ++j) o[j] = silu_f(bb[j] + w[0][j] * full[t][j] + w[1][j] * full[t + 1][j] + w[2][j] * full[t + 2][j] + w[3][j] * full[t + 3][j]);
                *(u32x4*)(XC + (size_t)(rs0 + t) * XBCW + j0) = pack8(o); }
#pragma unroll
            for (int i = 0; i < 3; ++i) { float* o = oc + ((size_t)bs * 3 + i) * XBCW + j0;
                *(f32x4*)o = (f32x4){full[4 + i][0], full[4 + i][1], full[4 + i][2], full[4 + i][3]}; *(f32x4*)(o + 4) = (f32x4){full[4 + i][4], full[4 + i][5], full[4 + i][6], full[4 + i][7]}; }
        }
        for (int it = blockIdx.x * NTHR + tid; it < NSR * NH; it += G * NTHR) { const int r = NPR + it / NH, h = it % NH;
            DTB[(size_t)r * NH + h] = softplus_f(DT[(size_t)r * 32 + h] + dtb[h]); }
    }
}

__device__ __forceinline__ void k2_phase(const Args& a, int l, int G) {
    unsigned char* ws_ = a.ws; asm volatile("" : "+s"(ws_));
    int tid_ = threadIdx.x; asm volatile("" : "+v"(tid_)); const int tid = tid_, lane = tid & 63, wave = tid >> 6, q = lane >> 4, fr = lane & 15;
    const float* S = (const float*)(ws_ + WS_S); const float* DEC = (const float*)(ws_ + WS_DEC); bf16* HS = (bf16*)(ws_ + WS_HS);
    for (int it = blockIdx.x * NTHR + tid; it < NBP * NH * (HD * DS / 4); it += G * NTHR) {
        const int bh = it / (HD * DS / 4), e = (it % (HD * DS / 4)) * 4, b = bh / NH, h = bh % NH;
        f32x4 H = (f32x4){0.f, 0.f, 0.f, 0.f};
#pragma unroll 4
        for (int c = 0; c < NCH; ++c) {
            const size_t o = ((size_t)(b * NCH + c) * NH + h) * (HD * DS) + e;
            u32x2 w; w.x = pk2(H[0], H[1]); w.y = pk2(H[2], H[3]); *(u32x2*)(HS + o) = w;
            const float d = DEC[(b * NCH + c) * NH + h]; const f32x4 s = *(const f32x4*)(S + o);
            H = H * d + s;
        }
        *(f32x4*)(a.out + O_SP + (((size_t)l * NBP + b) * NH + h) * (HD * DS) + e) = H;
    }
    const bf16* XC = (const bf16*)(ws_ + WS_XC); const bf16* P = (const bf16*)(ws_ + WS_P); const float* DTB = (const float*)(ws_ + WS_DTB);
    bf16* MIX = (bf16*)(ws_ + WS_MIX); float* SSQ = (float*)(ws_ + WS_SSQ);
    const float* alog = a.in[18] + l * NH; const float* dsk = a.in[19] + l * NH;
    for (int u = blockIdx.x * NWAVES + wave; u < NBS * NH; u += G * NWAVES) {
        const int bs = u / NH, h = u % NH, g = h / HPG, rs0 = NPR + 4 * bs;
        const float A = -__expf(alog[h]), Dh = dsk[h];
        float dt[4], cs[4]; { float s = 0.f;
#pragma unroll
            for (int t = 0; t < 4; ++t) { dt[t] = DTB[(size_t)(rs0 + t) * NH + h]; s += dt[t] * A; cs[t] = s; } }
        bf16x8 cfr[4]; u32x4 brow[4];
#pragma unroll
        for (int ks = 0; ks < 4; ++ks) { u32x4 z = (u32x4){0u, 0u, 0u, 0u}, zb = z;
            if (fr < 4) { z = *(const u32x4*)(XC + (size_t)(rs0 + fr) * XBCW + SSDW + 512 + 128 * g + 32 * ks + 8 * q); zb = *(const u32x4*)(XC + (size_t)(rs0 + fr) * XBCW + SSDW + 128 * g + 32 * ks + 8 * q); }
            cfr[ks] = as_frag(z); brow[ks] = zb; }
        f32x4 cb4 = (f32x4){0.f, 0.f, 0.f, 0.f};
#pragma unroll
        for (int ks = 0; ks < 4; ++ks) cb4 = MFMA16(cfr[ks], as_frag(brow[ks]), cb4);
        float Wm[4][4];
#pragma unroll
        for (int t = 0; t < 4; ++t)
#pragma unroll
            for (int s = 0; s < 4; ++s) Wm[t][s] = 0.f;
#pragma unroll
        for (int t = 0; t < 4; ++t)
#pragma unroll
            for (int s = 0; s < 4; ++s) if (s <= t) Wm[t][s] = __int_as_float(__builtin_amdgcn_readlane(__float_as_int(cb4[t]), s)) * __expf(cs[t] - cs[s]) * dt[s];
        float coef[4];
#pragma unroll
        for (int s = 0; s < 4; ++s) coef[s] = dt[s] * __expf(cs[3] - cs[s]);
        const float e3 = __expf(cs[3]);
        const float* h0 = a.in[6] + (((size_t)l * NBS + bs) * NH + h) * (HD * DS);
        float* hn = a.out + O_SS + (((size_t)l * NBS + bs) * NH + h) * (HD * DS);
        float ysum[4] = {0.f, 0.f, 0.f, 0.f};
#pragma unroll 1
        for (int pt = 0; pt < 4; ++pt) {
            const int p = 16 * pt + fr;
            float xs[4];
#pragma unroll
            for (int s = 0; s < 4; ++s) xs[s] = bf1(XC[(size_t)(rs0 + s) * XBCW + h * HD + p]);
            f32x4 yo = (f32x4){0.f, 0.f, 0.f, 0.f};
#pragma unroll
            for (int ks = 0; ks < 4; ++ks) {
                const float* hp = h0 + (size_t)p * DS + 32 * ks + 8 * q;
                const f32x4 v0 = *(const f32x4*)hp, v1 = *(const f32x4*)(hp + 4);
                float hv[8] = {v0[0], v0[1], v0[2], v0[3], v1[0], v1[1], v1[2], v1[3]}, nv[8];
#pragma unroll
                for (int j = 0; j < 8; ++j) nv[j] = e3 * hv[j];
#pragma unroll
                for (int s = 0; s < 4; ++s) { u32x4 bw; bw.x = __shfl(brow[ks].x, 16 * q + s); bw.y = __shfl(brow[ks].y, 16 * q + s); bw.z = __shfl(brow[ks].z, 16 * q + s); bw.w = __shfl(brow[ks].w, 16 * q + s);
                    float bvv[8]; unpack8(bw, bvv); const float cx = coef[s] * xs[s];
#pragma unroll
                    for (int j = 0; j < 8; ++j) nv[j] += cx * bvv[j]; }
                float* np = hn + (size_t)p * DS + 32 * ks + 8 * q;
                *(f32x4*)np = (f32x4){nv[0], nv[1], nv[2], nv[3]}; *(f32x4*)(np + 4) = (f32x4){nv[4], nv[5], nv[6], nv[7]};
                yo = MFMA16(cfr[ks], as_frag(pack8(hv)), yo);
            }
            if (lane < 16) {
#pragma unroll
                for (int t = 0; t < 4; ++t) {
                    float y = __expf(cs[t]) * yo[t] + Dh * xs[t];
#pragma unroll
                    for (int s = 0; s < 4; ++s) if (s <= t) y += Wm[t][s] * xs[s];
                    const float z = bf1(P[(size_t)(rs0 + t) * PW + POOLW + h * HD + p]);
                    const float yg = y * silu_f(z);
                    MIX[(size_t)(rs0 + t) * DM + POOLW + h * HD + p] = f2bf(yg);
                    ysum[t] += yg * yg;
                }
            }
        }
#pragma unroll
        for (int t = 0; t < 4; ++t) { float s = ysum[t]; s += __shfl_xor(s, 1); s += __shfl_xor(s, 2); s += __shfl_xor(s, 4); s += __shfl_xor(s, 8);
            if (lane == 0) SSQ[(size_t)(rs0 + t) * NH + h] = s; }
    }
}

__device__ __forceinline__ void k3_phase(const Args& a, int l, LAS unsigned char* lds, int G) {
    unsigned char* ws_ = a.ws; asm volatile("" : "+s"(ws_));
    int tid_ = threadIdx.x; asm volatile("" : "+v"(tid_)); const int tid = tid_, lane = tid & 63, wave = __builtin_amdgcn_readfirstlane(tid >> 6), q = lane >> 4, fr = lane & 15;
    const bf16* XC = (const bf16*)(ws_ + WS_XC); const bf16* P = (const bf16*)(ws_ + WS_P);
    const float* DTB = (const float*)(ws_ + WS_DTB); const float* CSB = (const float*)(ws_ + WS_CSB); const bf16* HS = (const bf16*)(ws_ + WS_HS);
    bf16* MIX = (bf16*)(ws_ + WS_MIX); float* SSQ = (float*)(ws_ + WS_SSQ);
    const float* dsk = a.in[19] + l * NH;
    LAS bf16* Cs = (LAS bf16*)lds;
    LAS bf16* Bs = Cs + 128 * LSTR;
    LAS bf16* xT = Bs + 128 * LSTR;
    LAS bf16* Ms = xT + 64 * LSTR;
    LAS float* csL = (LAS float*)(Ms + 8 * 16 * LSTR);
    LAS float* dtL = csL + 6 * 128;
    for (int u = blockIdx.x; u < NBP * NCH * NG; u += G) {
        const int b = u >> 6, c = (u >> 2) & 15, g = u & 3, r0 = b * SEQ + c * 128;
        for (int it = tid; it < 2 * 128 * 16; it += NTHR) { const int m = it >> 11, row = (it >> 4) & 127, k8 = (it & 15) * 8;
            const u32x4 v = *(const u32x4*)(XC + (size_t)(r0 + row) * XBCW + SSDW + (m ? 0 : 512) + 128 * g + k8);
            *(LAS u32x4*)((m ? Bs : Cs) + row * LSTR + k8) = v; }
        for (int it = tid; it < 6 * 128; it += NTHR) { const int hh = it >> 7, t = it & 127;
            csL[it] = CSB[(size_t)(r0 + t) * NH + HPG * g + hh]; dtL[it] = DTB[(size_t)(r0 + t) * NH + HPG * g + hh]; }
        __syncthreads();
        bf16x8 cf[4];
#pragma unroll
        for (int ks = 0; ks < 4; ++ks) cf[ks] = *(const LAS bf16x8*)(Cs + (16 * wave + fr) * LSTR + 32 * ks + 8 * q);
        f32x4 gacc[8];
#pragma unroll
        for (int st = 0; st < 8; ++st) { gacc[st] = (f32x4){0.f, 0.f, 0.f, 0.f};
            if (st <= wave) {
#pragma unroll
                for (int ks = 0; ks < 4; ++ks) { const bf16x8 bfr = *(const LAS bf16x8*)(Bs + (16 * st + fr) * LSTR + 32 * ks + 8 * q); gacc[st] = MFMA16(bfr, cf[ks], gacc[st]); } } }
        const int lrow = 16 * wave + fr;
#pragma unroll 1
        for (int hh = 0; hh < HPG; ++hh) {
            const int h = HPG * g + hh;
            for (int it = tid; it < 128 * 8; it += NTHR) { const int s = it >> 3, p8 = (it & 7) * 8; float xv[8];
                unpack8(*(const u32x4*)(XC + (size_t)(r0 + s) * XBCW + h * HD + p8), xv);
#pragma unroll
                for (int j = 0; j < 8; ++j) xT[(p8 + j) * LSTR + s] = f2bf(xv[j]); }
            const float csl = csL[hh * 128 + lrow];
#pragma unroll
            for (int st = 0; st < 8; ++st) {
                if (st <= (wave | 1)) { float mv[4];
#pragma unroll
                    for (int r = 0; r < 4; ++r) { const int s = 16 * st + 4 * q + r;
                        mv[r] = (st <= wave && s <= lrow) ? gacc[st][r] * __expf(csl - csL[hh * 128 + s]) * dtL[hh * 128 + s] : 0.f; }
                    u32x2 w; w.x = pk2(mv[0], mv[1]); w.y = pk2(mv[2], mv[3]);
                    *(LAS u32x2*)(Ms + (wave * 16 + fr) * LSTR + 16 * st + 4 * q) = w; } }
            __syncthreads();
            f32x4 y1[4], y2[4];
#pragma unroll
            for (int pt = 0; pt < 4; ++pt) { y1[pt] = (f32x4){0.f, 0.f, 0.f, 0.f}; y2[pt] = (f32x4){0.f, 0.f, 0.f, 0.f}; }
            const bf16* hs = HS + ((size_t)(b * NCH + c) * NH + h) * (HD * DS);
#pragma unroll
            for (int ks = 0; ks < 4; ++ks) {
                if (2 * ks <= wave) { const bf16x8 mfr = *(const LAS bf16x8*)(Ms + (wave * 16 + fr) * LSTR + 32 * ks + 8 * q);
#pragma unroll
                    for (int pt = 0; pt < 4; ++pt) { const bf16x8 xfr = *(const LAS bf16x8*)(xT + (16 * pt + fr) * LSTR + 32 * ks + 8 * q); y1[pt] = MFMA16(xfr, mfr, y1[pt]); } }
#pragma unroll
                for (int pt = 0; pt < 4; ++pt) { const bf16x8 hfr = as_frag(*(const u32x4*)(hs + (size_t)(16 * pt + fr) * DS + 32 * ks + 8 * q)); y2[pt] = MFMA16(hfr, cf[ks], y2[pt]); }
            }
            const float ecs = __expf(csl), Dh = dsk[h]; const int row = r0 + lrow; float ss = 0.f;
#pragma unroll
            for (int pt = 0; pt < 4; ++pt) { const int p0 = 16 * pt + 4 * q;
                const u32x2 xw = *(const u32x2*)(XC + (size_t)row * XBCW + h * HD + p0), zw = *(const u32x2*)(P + (size_t)row * PW + POOLW + h * HD + p0);
                const float xv[4] = {bflo(xw.x), bfhi(xw.x), bflo(xw.y), bfhi(xw.y)}, zv[4] = {bflo(zw.x), bfhi(zw.x), bflo(zw.y), bfhi(zw.y)}; float yg[4];
#pragma unroll
                for (int r = 0; r < 4; ++r) { const float y = y1[pt][r] + ecs * y2[pt][r] + Dh * xv[r]; yg[r] = y * silu_f(zv[r]); ss += yg[r] * yg[r]; }
                u32x2 w; w.x = pk2(yg[0], yg[1]); w.y = pk2(yg[2], yg[3]);
                *(u32x2*)(MIX + (size_t)row * DM + POOLW + h * HD + p0) = w; }
            ss += __shfl_xor(ss, 16); ss += __shfl_xor(ss, 32);
            if (q == 0) SSQ[(size_t)row * NH + h] = ss;
            __syncthreads();
        }
    }
}

__device__ __forceinline__ void pool_phase(const Args& a, int l, int G) {
    unsigned char* ws_ = a.ws; asm volatile("" : "+s"(ws_));
    int tid_ = threadIdx.x; asm volatile("" : "+v"(tid_)); const int tid = tid_, lane = tid & 63, wave = tid >> 6, q = lane >> 4, fr = lane & 15;
    const bf16* P = (const bf16*)(ws_ + WS_P); const bf16* PWT = (const bf16*)(ws_ + WS_PWT + l * SZ_PWT);
    bf16* MIX = (bf16*)(ws_ + WS_MIX); const float* SSQ = (const float*)(ws_ + WS_SSQ); float* R = (float*)(ws_ + WS_R);
    const float* stp = a.in[4] + (size_t)l * NBS * 15 * POOLW;
    for (int u = blockIdx.x * NWAVES + wave; u < (MROWS / 16) * 4; u += G * NWAVES) {
        const int rb = u >> 2, g = u & 3, row = 16 * rb + fr, w = 2 << g;
        float ssum = 0.f;
#pragma unroll
        for (int i = 0; i < 6; ++i) { const f32x4 v = *(const f32x4*)(SSQ + (size_t)row * NH + 4 * i); ssum += (v[0] + v[1]) + (v[2] + v[3]); }
        const float rr = sqrtf(ssum * (1.f / SSDW) + EPS);
        if (g == 0 && q == 0) R[row] = 1.f / rr;
        f32x4 acc[8];
#pragma unroll
        for (int nt = 0; nt < 8; ++nt) acc[nt] = (f32x4){0.f, 0.f, 0.f, 0.f};
#pragma unroll 1
        for (int ks = 0; ks < 4; ++ks) {
            const int ch = 128 * g + 32 * ks + 8 * q; float sum[8], cur[8];
            unpack8(*(const u32x4*)(P + (size_t)row * PW + ch), cur);
#pragma unroll
            for (int j = 0; j < 8; ++j) sum[j] = cur[j];
            float cnt;
            if (row < NPR) { const int pos = row & (SEQ - 1), nw = (pos + 1 < w) ? pos + 1 : w; cnt = (float)nw;
                for (int i = 1; i < nw; ++i) { float v[8]; unpack8(*(const u32x4*)(P + (size_t)(row - i) * PW + ch), v);
#pragma unroll
                    for (int j = 0; j < 8; ++j) sum[j] += v[j]; }
            } else { const int seq = (row - NPR) >> 2, t4 = (row - NPR) & 3; cnt = (float)w;
                for (int i = 1; i < w; ++i) { float v[8];
                    if (t4 - i >= 0) unpack8(*(const u32x4*)(P + (size_t)(row - i) * PW + ch), v);
                    else { const float* sp = stp + ((size_t)seq * 15 + (15 + t4 - i)) * POOLW + ch; const f32x4 v0 = *(const f32x4*)sp, v1 = *(const f32x4*)(sp + 4);
                        v[0] = v0[0]; v[1] = v0[1]; v[2] = v0[2]; v[3] = v0[3]; v[4] = v1[0]; v[5] = v1[1]; v[6] = v1[2]; v[7] = v1[3]; }
#pragma unroll
                    for (int j = 0; j < 8; ++j) sum[j] += v[j]; }
            }
            const float ic = 1.f / cnt; float d[8];
#pragma unroll
            for (int j = 0; j < 8; ++j) d[j] = sum[j] * ic - cur[j];
            const bf16x8 dfr = as_frag(pack8(d));
#pragma unroll
            for (int nt = 0; nt < 8; ++nt) { const bf16x8 wfr = as_frag(*(const u32x4*)(PWT + ((size_t)g * 128 + 16 * nt + fr) * 128 + 32 * ks + 8 * q)); acc[nt] = MFMA16(wfr, dfr, acc[nt]); }
        }
#pragma unroll
        for (int nt = 0; nt < 8; ++nt) { u32x2 o; o.x = pk2(acc[nt][0] * rr, acc[nt][1] * rr); o.y = pk2(acc[nt][2] * rr, acc[nt][3] * rr);
            *(u32x2*)(MIX + (size_t)row * DM + 128 * g + 16 * nt + 4 * q) = o; }
    }
    { float* o = a.out + O_PP + (size_t)l * NBP * 15 * POOLW;
      for (int it = blockIdx.x * NTHR + tid; it < NBP * 15 * POOLW; it += G * NTHR) { const int b = it / (15 * POOLW), i = (it / POOLW) % 15, cc = it % POOLW;
          o[it] = bf1(P[(size_t)(b * SEQ + SEQ - 15 + i) * PW + cc]); }
      float* os = a.out + O_PS + (size_t)l * NBS * 15 * POOLW;
      for (int it = blockIdx.x * NTHR + tid; it < NBS * 15 * POOLW; it += G * NTHR) { const int bs = it / (15 * POOLW), i = (it / POOLW) % 15, cc = it % POOLW;
          os[it] = i < 11 ? stp[((size_t)bs * 15 + i + 4) * POOLW + cc] : bf1(P[(size_t)(NPR + 4 * bs + i - 11) * PW + cc]); } }
}

__device__ __forceinline__ void act_phase(const Args& a, int l, int G) {
    unsigned char* ws_ = a.ws; asm volatile("" : "+s"(ws_));
    int tid_ = threadIdx.x; asm volatile("" : "+v"(tid_)); const int tid = tid_;
    const bf16* UP = (const bf16*)(ws_ + WS_UP); bf16* ACT = (bf16*)(ws_ + WS_ACT);
    const float* fw = a.in[23] + (size_t)l * 3 * DFF; const float* fb = a.in[24] + (size_t)l * DFF;
    const float* stf = a.in[7] + (size_t)l * NBS * 2 * DFF;
    for (int it = blockIdx.x * NTHR + tid; it < (MROWS / 4) * (DFF / 8); it += G * NTHR) {
        const int run = it / (DFF / 8), j0 = (it % (DFF / 8)) * 8, row0 = 4 * run;
        const int ucol = (j0 >> 7) * 256 + (j0 & 127);
        float w[3][8], bb[8];
#pragma unroll
        for (int i = 0; i < 3; ++i) { const f32x4 w0 = *(const f32x4*)(fw + i * DFF + j0), w1 = *(const f32x4*)(fw + i * DFF + j0 + 4);
#pragma unroll
            for (int j = 0; j < 4; ++j) { w[i][j] = w0[j]; w[i][4 + j] = w1[j]; } }
        { const f32x4 b0 = *(const f32x4*)(fb + j0), b1 = *(const f32x4*)(fb + j0 + 4);
#pragma unroll
          for (int j = 0; j < 4; ++j) { bb[j] = b0[j]; bb[4 + j] = b1[j]; } }
        float g2[8], g1[8];
        if (row0 < NPR) {
            if ((row0 & (SEQ - 1)) == 0) {
#pragma unroll
                for (int j = 0; j < 8; ++j) { g2[j] = 0.f; g1[j] = 0.f; }
            } else { unpack8(*(const u32x4*)(UP + (size_t)(row0 - 2) * NUP + ucol), g2); unpack8(*(const u32x4*)(UP + (size_t)(row0 - 1) * NUP + ucol), g1); }
        } else { const int bs = (row0 - NPR) >> 2; const float* s0 = stf + ((size_t)bs * 2) * DFF + j0;
            const f32x4 a0 = *(const f32x4*)s0, a1 = *(const f32x4*)(s0 + 4), c0 = *(const f32x4*)(s0 + DFF), c1 = *(const f32x4*)(s0 + DFF + 4);
#pragma unroll
            for (int j = 0; j < 4; ++j) { g2[j] = a0[j]; g2[4 + j] = a1[j]; g1[j] = c0[j]; g1[4 + j] = c1[j]; } }
#pragma unroll
        for (int t = 0; t < 4; ++t) {
            float gc[8], vv[8], o[8];
            unpack8(*(const u32x4*)(UP + (size_t)(row0 + t) * NUP + ucol), gc); unpack8(*(const u32x4*)(UP + (size_t)(row0 + t) * NUP + ucol + 128), vv);
#pragma unroll
            for (int j = 0; j < 8; ++j) o[j] = silu_f(bb[j] + w[0][j] * g2[j] + w[1][j] * g1[j] + w[2][j] * gc[j]) * vv[j];
            *(u32x4*)(ACT + (size_t)(row0 + t) * DFF + j0) = pack8(o);
#pragma unroll
            for (int j = 0; j < 8; ++j) { g2[j] = g1[j]; g1[j] = gc[j]; }
        }
        if (row0 < NPR) { if ((row0 & (SEQ - 1)) == SEQ - 4) { float* o = a.out + O_FP + (((size_t)l * NBP + (row0 >> 11)) * 2) * DFF + j0;
                *(f32x4*)o = (f32x4){g2[0], g2[1], g2[2], g2[3]}; *(f32x4*)(o + 4) = (f32x4){g2[4], g2[5], g2[6], g2[7]};
                *(f32x4*)(o + DFF) = (f32x4){g1[0], g1[1], g1[2], g1[3]}; *(f32x4*)(o + DFF + 4) = (f32x4){g1[4], g1[5], g1[6], g1[7]}; } }
        else { float* o = a.out + O_FS + (((size_t)l * NBS + ((row0 - NPR) >> 2)) * 2) * DFF + j0;
            *(f32x4*)o = (f32x4){g2[0], g2[1], g2[2], g2[3]}; *(f32x4*)(o + 4) = (f32x4){g2[4], g2[5], g2[6], g2[7]};
            *(f32x4*)(o + DFF) = (f32x4){g1[0], g1[1], g1[2], g1[3]}; *(f32x4*)(o + DFF + 4) = (f32x4){g1[4], g1[5], g1[6], g1[7]}; }
    }
}

constexpr int PH_P0A = 0, PH_P0B = 1, PH_L0 = 2, PH_PER_LAYER = 11, PH_FINAL = PH_L0 + DEPTH * PH_PER_LAYER, N_PHASES = PH_FINAL + 1;
#ifndef N_LAUNCH_MODE
#define N_LAUNCH_MODE 1
#endif

__device__ __forceinline__ int grid_size() { int g = gridDim.x; asm volatile("" : "+s"(g)); return g; }
__global__ void __launch_bounds__(NTHR, 2) fwd_kernel(Args a) {
    extern __shared__ __attribute__((aligned(16))) unsigned char lds_raw[];
    LAS unsigned char* lds = (LAS unsigned char*)lds_raw;
    const int tid = threadIdx.x;
#define G grid_size()
    volatile LAS unsigned* misc = (volatile LAS unsigned*)(lds + LDS_MISC);
    if (tid < 64) misc[tid] = 0u;
    __syncthreads();
    XcdBarrier bar; bar.bar = (unsigned*)(a.ws + WS_CTL) + CW_BAR; bar.x = 0; bar.st = misc + 8;
    const int lo = a.ph_lo, hi = a.ph_hi;
    if (hi - lo > 1) bar = xcd_barrier_post((unsigned*)(a.ws + WS_CTL) + CW_BAR, misc + 8);
#ifndef PH_MASK
#define PH_MASK 0xFFFFFFFFu
#endif
#define EN(b) (((PH_MASK) >> (b)) & 1u)
#ifndef REP_MASK
#define REP_MASK 0u
#endif
#define NREP(b) ((((REP_MASK) >> (b)) & 1u) ? 2 : 1)
#define IN(k) (lo <= (k) && (k) < hi)
#define SEAM(k) do { if ((k) + 1 < hi) xcd_barrier(bar); } while (0)
#define WSBASE ({ unsigned char* w_ = a.ws; asm volatile("" : "+s"(w_)); w_; })
#define WSP(T, off) ((T*)(WSBASE + (off)))
#define LDSL ({ LAS unsigned char* l_ = lds; asm volatile("" : "+s"(l_)); l_; })

    for (int rep_ = 0; rep_ < NREP(0); ++rep_) if (EN(0) && IN(PH_P0A)) { p0a_phase(a, LDSL, G); SEAM(PH_P0A); }
    for (int rep_ = 0; rep_ < NREP(1); ++rep_) if (EN(1) && IN(PH_P0B)) { p0b_phase(a, G); SEAM(PH_P0B); }

    { constexpr int l = 0;
        const int pb = PH_L0 + l * PH_PER_LAYER;
#define MODL (WSP(const float, WS_MOD) + (size_t)l * NB * ADA)
#define XIN_P (l == 0 ? a.in[0] : WSP(const float, WS_XA))
#define XIN_S (l == 0 ? a.in[1] : WSP(const float, WS_XA) + (size_t)NPR * DM)
        for (int rep_ = 0; rep_ < NREP(2); ++rep_) if (EN(2) && IN(pb + 0)) { norm_phase(XIN_P, XIN_S, a.in[8] + l * DM, MODL, 0, WSP(bf16, WS_H), G); SEAM(pb + 0); }
        for (int rep_ = 0; rep_ < NREP(3); ++rep_) if (EN(3) && IN(pb + 1)) {
            pg8::Gemm g{WSP(const bf16, WS_H), (const bf16*)(WSBASE + WS_WIN + l * SZ_WIN), MROWS, NINP, DM}; pg8::StaticOrder S; S.init(MROWS, NINP, G, (int)blockIdx.x);
            EpiProj E{WSP(bf16, WS_P), WSP(float, WS_DT)};
            pg8::gemm_phase<EpiProj, pg8::StaticOrder, true, true>(LDSL, g, S, E);
            SEAM(pb + 1);
        }
        for (int rep_ = 0; rep_ < NREP(4); ++rep_) if (EN(4) && IN(pb + 2)) { k1_phase(a, l, LDSL, G); SEAM(pb + 2); }
        for (int rep_ = 0; rep_ < NREP(5); ++rep_) if (EN(5) && IN(pb + 3)) { k2_phase(a, l, G); SEAM(pb + 3); }
        for (int rep_ = 0; rep_ < NREP(6); ++rep_) if (EN(6) && IN(pb + 4)) { k3_phase(a, l, LDSL, G); SEAM(pb + 4); }
        for (int rep_ = 0; rep_ < NREP(7); ++rep_) if (EN(7) && IN(pb + 5)) { pool_phase(a, l, G); SEAM(pb + 5); }
        for (int rep_ = 0; rep_ < NREP(8); ++rep_) if (EN(8) && IN(pb + 6)) {
            pg8::Gemm g{WSP(const bf16, WS_MIX), (const bf16*)(WSBASE + WS_WOUT + l * SZ_WOUT), NPR, DM, DM}; pg8::StaticOrder S; S.init(NPR, DM, G, (int)blockIdx.x);
            EpiRes E{XIN_P, XIN_S, WSP(float, WS_XB), MODL + 2 * DM, WSP(const float, WS_R)};
            pg8::gemm_phase_x<EpiRes, pg8::StaticOrder>(LDSL, g, WSP(const bf16, WS_MIX) + (size_t)NPR * DM, S, E);
            SEAM(pb + 6);
        }
        for (int rep_ = 0; rep_ < NREP(9); ++rep_) if (EN(9) && IN(pb + 7)) { norm_phase(WSP(const float, WS_XB), WSP(const float, WS_XB) + (size_t)NPR * DM, a.in[9] + l * DM, MODL, 3, WSP(bf16, WS_H), G); SEAM(pb + 7); }
        for (int rep_ = 0; rep_ < NREP(10); ++rep_) if (EN(10) && IN(pb + 8)) {
            pg8::Gemm g{WSP(const bf16, WS_H), (const bf16*)(WSBASE + WS_WUP + l * SZ_WUP), MROWS, NUP, DM}; pg8::StaticOrder S; S.init(MROWS, NUP, G, (int)blockIdx.x);
            EpiBf E{WSP(bf16, WS_UP), NUP};
            pg8::gemm_phase<EpiBf, pg8::StaticOrder, true, true>(LDSL, g, S, E);
            SEAM(pb + 8);
        }
        for (int rep_ = 0; rep_ < NREP(11); ++rep_) if (EN(11) && IN(pb + 9)) { act_phase(a, l, G); SEAM(pb + 9); }
        for (int rep_ = 0; rep_ < NREP(12); ++rep_) if (EN(12) && IN(pb + 10)) {
            pg8::Gemm g{WSP(const bf16, WS_ACT), (const bf16*)(WSBASE + WS_WDN + l * SZ_WDN), NPR, DM, DFF}; pg8::StaticOrder S; S.init(NPR, DM, G, (int)blockIdx.x);
            EpiRes E{WSP(const float, WS_XB), WSP(const float, WS_XB) + (size_t)NPR * DM, WSP(float, WS_XA), MODL + 5 * DM, nullptr};
            pg8::gemm_phase_x<EpiRes, pg8::StaticOrder>(LDSL, g, WSP(const bf16, WS_ACT) + (size_t)NPR * DFF, S, E);
            SEAM(pb + 10);
        }
    }
    { constexpr int l = 1;
        const int pb = PH_L0 + l * PH_PER_LAYER;
#define MODL (WSP(const float, WS_MOD) + (size_t)l * NB * ADA)
#define XIN_P (l == 0 ? a.in[0] : WSP(const float, WS_XA))
#define XIN_S (l == 0 ? a.in[1] : WSP(const float, WS_XA) + (size_t)NPR * DM)
        for (int rep_ = 0; rep_ < NREP(2); ++rep_) if (EN(2) && IN(pb + 0)) { norm_phase(XIN_P, XIN_S, a.in[8] + l * DM, MODL, 0, WSP(bf16, WS_H), G); SEAM(pb + 0); }
        for (int rep_ = 0; rep_ < NREP(3); ++rep_) if (EN(3) && IN(pb + 1)) {
            pg8::Gemm g{WSP(const bf16, WS_H), (const bf16*)(WSBASE + WS_WIN + l * SZ_WIN), MROWS, NINP, DM}; pg8::StaticOrder S; S.init(MROWS, NINP, G, (int)blockIdx.x);
            EpiProj E{WSP(bf16, WS_P), WSP(float, WS_DT)};
            pg8::gemm_phase<EpiProj, pg8::StaticOrder, true, true>(LDSL, g, S, E);
            SEAM(pb + 1);
        }
        for (int rep_ = 0; rep_ < NREP(4); ++rep_) if (EN(4) && IN(pb + 2)) { k1_phase(a, l, LDSL, G); SEAM(pb + 2); }
        for (int rep_ = 0; rep_ < NREP(5); ++rep_) if (EN(5) && IN(pb + 3)) { k2_phase(a, l, G); SEAM(pb + 3); }
        for (int rep_ = 0; rep_ < NREP(6); ++rep_) if (EN(6) && IN(pb + 4)) { k3_phase(a, l, LDSL, G); SEAM(pb + 4); }
        for (int rep_ = 0; rep_ < NREP(7); ++rep_) if (EN(7) && IN(pb + 5)) { pool_phase(a, l, G); SEAM(pb + 5); }
        for (int rep_ = 0; rep_ < NREP(8); ++rep_) if (EN(8) && IN(pb + 6)) {
            pg8::Gemm g{WSP(const bf16, WS_MIX), (const bf16*)(WSBASE + WS_WOUT + l * SZ_WOUT), NPR, DM, DM}; pg8::StaticOrder S; S.init(NPR, DM, G, (int)blockIdx.x);
            EpiRes E{XIN_P, XIN_S, WSP(float, WS_XB), MODL + 2 * DM, WSP(const float, WS_R)};
            pg8::gemm_phase_x<EpiRes, pg8::StaticOrder>(LDSL, g, WSP(const bf16, WS_MIX) + (size_t)NPR * DM, S, E);
            SEAM(pb + 6);
        }
        for (int rep_ = 0; rep_ < NREP(9); ++rep_) if (EN(9) && IN(pb + 7)) { norm_phase(WSP(const float, WS_XB), WSP(const float, WS_XB) + (size_t)NPR * DM, a.in[9] + l * DM, MODL, 3, WSP(bf16, WS_H), G); SEAM(pb + 7); }
        for (int rep_ = 0; rep_ < NREP(10); ++rep_) if (EN(10) && IN(pb + 8)) {
            pg8::Gemm g{WSP(const bf16, WS_H), (const bf16*)(WSBASE + WS_WUP + l * SZ_WUP), MROWS, NUP, DM}; pg8::StaticOrder S; S.init(MROWS, NUP, G, (int)blockIdx.x);
            EpiBf E{WSP(bf16, WS_UP), NUP};
            pg8::gemm_phase<EpiBf, pg8::StaticOrder, true, true>(LDSL, g, S, E);
            SEAM(pb + 8);
        }
        for (int rep_ = 0; rep_ < NREP(11); ++rep_) if (EN(11) && IN(pb + 9)) { act_phase(a, l, G); SEAM(pb + 9); }
        for (int rep_ = 0; rep_ < NREP(12); ++rep_) if (EN(12) && IN(pb + 10)) {
            pg8::Gemm g{WSP(const bf16, WS_ACT), (const bf16*)(WSBASE + WS_WDN + l * SZ_WDN), NPR, DM, DFF}; pg8::StaticOrder S; S.init(NPR, DM, G, (int)blockIdx.x);
            EpiRes E{WSP(const float, WS_XB), WSP(const float, WS_XB) + (size_t)NPR * DM, WSP(float, WS_XA), MODL + 5 * DM, nullptr};
            pg8::gemm_phase_x<EpiRes, pg8::StaticOrder>(LDSL, g, WSP(const bf16, WS_ACT) + (size_t)NPR * DFF, S, E);
            SEAM(pb + 10);
        }
    }
    { constexpr int l = 2;
        const int pb = PH_L0 + l * PH_PER_LAYER;
#define MODL (WSP(const float, WS_MOD) + (size_t)l * NB * ADA)
#define XIN_P (l == 0 ? a.in[0] : WSP(const float, WS_XA))
#define XIN_S (l == 0 ? a.in[1] : WSP(const float, WS_XA) + (size_t)NPR * DM)
        for (int rep_ = 0; rep_ < NREP(2); ++rep_) if (EN(2) && IN(pb + 0)) { norm_phase(XIN_P, XIN_S, a.in[8] + l * DM, MODL, 0, WSP(bf16, WS_H), G); SEAM(pb + 0); }
        for (int rep_ = 0; rep_ < NREP(3); ++rep_) if (EN(3) && IN(pb + 1)) {
            pg8::Gemm g{WSP(const bf16, WS_H), (const bf16*)(WSBASE + WS_WIN + l * SZ_WIN), MROWS, NINP, DM}; pg8::StaticOrder S; S.init(MROWS, NINP, G, (int)blockIdx.x);
            EpiProj E{WSP(bf16, WS_P), WSP(float, WS_DT)};
            pg8::gemm_phase<EpiProj, pg8::StaticOrder, true, true>(LDSL, g, S, E);
            SEAM(pb + 1);
        }
        for (int rep_ = 0; rep_ < NREP(4); ++rep_) if (EN(4) && IN(pb + 2)) { k1_phase(a, l, LDSL, G); SEAM(pb + 2); }
        for (int rep_ = 0; rep_ < NREP(5); ++rep_) if (EN(5) && IN(pb + 3)) { k2_phase(a, l, G); SEAM(pb + 3); }
        for (int rep_ = 0; rep_ < NREP(6); ++rep_) if (EN(6) && IN(pb + 4)) { k3_phase(a, l, LDSL, G); SEAM(pb + 4); }
        for (int rep_ = 0; rep_ < NREP(7); ++rep_) if (EN(7) && IN(pb + 5)) { pool_phase(a, l, G); SEAM(pb + 5); }
        for (int rep_ = 0; rep_ < NREP(8); ++rep_) if (EN(8) && IN(pb + 6)) {
            pg8::Gemm g{WSP(const bf16, WS_MIX), (const bf16*)(WSBASE + WS_WOUT + l * SZ_WOUT), NPR, DM, DM}; pg8::StaticOrder S; S.init(NPR, DM, G, (int)blockIdx.x);
            EpiRes E{XIN_P, XIN_S, WSP(float, WS_XB), MODL + 2 * DM, WSP(const float, WS_R)};
            pg8::gemm_phase_x<EpiRes, pg8::StaticOrder>(LDSL, g, WSP(const bf16, WS_MIX) + (size_t)NPR * DM, S, E);
            SEAM(pb + 6);
        }
        for (int rep_ = 0; rep_ < NREP(9); ++rep_) if (EN(9) && IN(pb + 7)) { norm_phase(WSP(const float, WS_XB), WSP(const float, WS_XB) + (size_t)NPR * DM, a.in[9] + l * DM, MODL, 3, WSP(bf16, WS_H), G); SEAM(pb + 7); }
        for (int rep_ = 0; rep_ < NREP(10); ++rep_) if (EN(10) && IN(pb + 8)) {
            pg8::Gemm g{WSP(const bf16, WS_H), (const bf16*)(WSBASE + WS_WUP + l * SZ_WUP), MROWS, NUP, DM}; pg8::StaticOrder S; S.init(MROWS, NUP, G, (int)blockIdx.x);
            EpiBf E{WSP(bf16, WS_UP), NUP};
            pg8::gemm_phase<EpiBf, pg8::StaticOrder, true, true>(LDSL, g, S, E);
            SEAM(pb + 8);
        }
        for (int rep_ = 0; rep_ < NREP(11); ++rep_) if (EN(11) && IN(pb + 9)) { act_phase(a, l, G); SEAM(pb + 9); }
        for (int rep_ = 0; rep_ < NREP(12); ++rep_) if (EN(12) && IN(pb + 10)) {
            pg8::Gemm g{WSP(const bf16, WS_ACT), (const bf16*)(WSBASE + WS_WDN + l * SZ_WDN), NPR, DM, DFF}; pg8::StaticOrder S; S.init(NPR, DM, G, (int)blockIdx.x);
            EpiRes E{WSP(const float, WS_XB), WSP(const float, WS_XB) + (size_t)NPR * DM, WSP(float, WS_XA), MODL + 5 * DM, nullptr};
            pg8::gemm_phase_x<EpiRes, pg8::StaticOrder>(LDSL, g, WSP(const bf16, WS_ACT) + (size_t)NPR * DFF, S, E);
            SEAM(pb + 10);
        }
    }
    { constexpr int l = 3;
        const int pb = PH_L0 + l * PH_PER_LAYER;
#define MODL (WSP(const float, WS_MOD) + (size_t)l * NB * ADA)
#define XIN_P (l == 0 ? a.in[0] : WSP(const float, WS_XA))
#define XIN_S (l == 0 ? a.in[1] : WSP(const float, WS_XA) + (size_t)NPR * DM)
        for (int rep_ = 0; rep_ < NREP(2); ++rep_) if (EN(2) && IN(pb + 0)) { norm_phase(XIN_P, XIN_S, a.in[8] + l * DM, MODL, 0, WSP(bf16, WS_H), G); SEAM(pb + 0); }
        for (int rep_ = 0; rep_ < NREP(3); ++rep_) if (EN(3) && IN(pb + 1)) {
            pg8::Gemm g{WSP(const bf16, WS_H), (const bf16*)(WSBASE + WS_WIN + l * SZ_WIN), MROWS, NINP, DM}; pg8::StaticOrder S; S.init(MROWS, NINP, G, (int)blockIdx.x);
            EpiProj E{WSP(bf16, WS_P), WSP(float, WS_DT)};
            pg8::gemm_phase<EpiProj, pg8::StaticOrder, true, true>(LDSL, g, S, E);
            SEAM(pb + 1);
        }
        for (int rep_ = 0; rep_ < NREP(4); ++rep_) if (EN(4) && IN(pb + 2)) { k1_phase(a, l, LDSL, G); SEAM(pb + 2); }
        for (int rep_ = 0; rep_ < NREP(5); ++rep_) if (EN(5) && IN(pb + 3)) { k2_phase(a, l, G); SEAM(pb + 3); }
        for (int rep_ = 0; rep_ < NREP(6); ++rep_) if (EN(6) && IN(pb + 4)) { k3_phase(a, l, LDSL, G); SEAM(pb + 4); }
        for (int rep_ = 0; rep_ < NREP(7); ++rep_) if (EN(7) && IN(pb + 5)) { pool_phase(a, l, G); SEAM(pb + 5); }
        for (int rep_ = 0; rep_ < NREP(8); ++rep_) if (EN(8) && IN(pb + 6)) {
            pg8::Gemm g{WSP(const bf16, WS_MIX), (const bf16*)(WSBASE + WS_WOUT + l * SZ_WOUT), NPR, DM, DM}; pg8::StaticOrder S; S.init(NPR, DM, G, (int)blockIdx.x);
            EpiRes E{XIN_P, XIN_S, WSP(float, WS_XB), MODL + 2 * DM, WSP(const float, WS_R)};
            pg8::gemm_phase_x<EpiRes, pg8::StaticOrder>(LDSL, g, WSP(const bf16, WS_MIX) + (size_t)NPR * DM, S, E);
            SEAM(pb + 6);
        }
        for (int rep_ = 0; rep_ < NREP(9); ++rep_) if (EN(9) && IN(pb + 7)) { norm_phase(WSP(const float, WS_XB), WSP(const float, WS_XB) + (size_t)NPR * DM, a.in[9] + l * DM, MODL, 3, WSP(bf16, WS_H), G); SEAM(pb + 7); }
        for (int rep_ = 0; rep_ < NREP(10); ++rep_) if (EN(10) && IN(pb + 8)) {
            pg8::Gemm g{WSP(const bf16, WS_H), (const bf16*)(WSBASE + WS_WUP + l * SZ_WUP), MROWS, NUP, DM}; pg8::StaticOrder S; S.init(MROWS, NUP, G, (int)blockIdx.x);
            EpiBf E{WSP(bf16, WS_UP), NUP};
            pg8::gemm_phase<EpiBf, pg8::StaticOrder, true, true>(LDSL, g, S, E);
            SEAM(pb + 8);
        }
        for (int rep_ = 0; rep_ < NREP(11); ++rep_) if (EN(11) && IN(pb + 9)) { act_phase(a, l, G); SEAM(pb + 9); }
        for (int rep_ = 0; rep_ < NREP(12); ++rep_) if (EN(12) && IN(pb + 10)) {
            pg8::Gemm g{WSP(const bf16, WS_ACT), (const bf16*)(WSBASE + WS_WDN + l * SZ_WDN), NPR, DM, DFF}; pg8::StaticOrder S; S.init(NPR, DM, G, (int)blockIdx.x);
            EpiRes E{WSP(const float, WS_XB), WSP(const float, WS_XB) + (size_t)NPR * DM, WSP(float, WS_XA), MODL + 5 * DM, nullptr};
            pg8::gemm_phase_x<EpiRes, pg8::StaticOrder>(LDSL, g, WSP(const bf16, WS_ACT) + (size_t)NPR * DFF, S, E);
            SEAM(pb + 10);
        }
    }
    for (int rep_ = 0; rep_ < NREP(13); ++rep_) if (EN(13) && IN(PH_FINAL)) final_phase(WSP(const float, WS_XA), a.in[26], a.out + O_YP, G);
#undef IN
#undef SEAM
#undef G
}

extern "C" void kernel_launch(void* const* d_in, const int* in_sizes, int n_in, void* d_out, int out_size, void* d_ws, size_t ws_size, hipStream_t stream) {
    static int grid = 0;
    if (grid == 0) {
        if (n_in != 27 || (size_t)out_size != O_END || ws_size < WS_END) { fprintf(stderr, "kernel_launch: unexpected problem shape (n_in %d, out %d, ws %zu; need ws >= %zu)\n", n_in, out_size, ws_size, (size_t)WS_END); grid = -1; return; }
        int dev = 0, cus = 0, per_cu = 0;
        if (hipGetDevice(&dev) != hipSuccess || hipDeviceGetAttribute(&cus, hipDeviceAttributeMultiprocessorCount, dev) != hipSuccess) { grid = -1; return; }
        if (hipFuncSetAttribute((const void*)fwd_kernel, hipFuncAttributeMaxDynamicSharedMemorySize, LDS_BYTES) != hipSuccess) { fprintf(stderr, "kernel_launch: hipFuncSetAttribute failed\n"); grid = -1; return; }
        if (hipOccupancyMaxActiveBlocksPerMultiprocessor(&per_cu, (const void*)fwd_kernel, NTHR, LDS_BYTES) != hipSuccess || per_cu < 1) { fprintf(stderr, "kernel_launch: occupancy query says %d blocks per CU\n", per_cu); (void)hipGetLastError(); grid = -1; return; }
        grid = cus;
    }
    if (grid < 0) return;
    (void)hipMemsetAsync((char*)d_ws + WS_CTL, 0, CTL_BYTES, stream);
    Args a{};
    for (int i = 0; i < 27; ++i) a.in[i] = (const float*)d_in[i];
    a.out = (float*)d_out; a.ws = (unsigned char*)d_ws;
#if N_LAUNCH_MODE == 1
    a.ph_lo = 0; a.ph_hi = N_PHASES;
    hipLaunchKernelGGL(fwd_kernel, dim3(grid), dim3(NTHR), LDS_BYTES, stream, a);
#else
    for (int p = 0; p < N_PHASES; ++p) { a.ph_lo = p; a.ph_hi = p + 1; hipLaunchKernelGGL(fwd_kernel, dim3(grid), dim3(NTHR), LDS_BYTES, stream, a); }
#endif
}
```

```cpp
#include <hip/hip_runtime.h>
#include <cstdio>
#include <cstdint>
namespace pg8 {
#define PG8_LAS __attribute__((address_space(3)))
typedef unsigned short bf16_t;
typedef short bf16x8 __attribute__((ext_vector_type(8)));
typedef float f32x4 __attribute__((ext_vector_type(4)));
typedef unsigned u32x4 __attribute__((ext_vector_type(4)));
constexpr int BM = 256, BK = 64, HALF = 128, HTB = HALF * BK * 2  , STAGE_BYTES = 8 * HTB, NXCD = 8, WGM = 8;

__host__ __device__ __forceinline__ int lds_byte(int r, int c) { const int st = (r >> 4) * 2 + (c >> 5), rr = r & 15, cc = c & 31, ob = rr * 64 + cc * 2; return st * 1024 + (ob ^ (((ob >> 9) & 1) << 5)); }
__host__ __device__ __forceinline__ void stage_rc(int b, int& R, int& C) { const int st = b / 1024, sb = b % 1024, swz = sb ^ (((sb >> 9) & 1) << 5); R = (st >> 1) * 16 + swz / 64; C = (st & 1) * 32 + (swz % 64) / 2; }
__host__ __device__ __forceinline__ int perm32(int rho) { const int n = rho >> 4, i = rho & 15; return 8 * (i >> 2) + 4 * n + (i & 3); }

struct Unit { int pm, pn; };
struct Gemm { const bf16_t* A; const bf16_t* Bt; int M, N, K; };

struct StaticOrder {
    int nM, nN, nwg, G, c;
    __host__ __device__ void init(int M, int N, int G_, int c_) { nM = M / BM; nN = N / BM; nwg = nM * nN; G = G_; c = c_; }
    __host__ __device__ bool next(int i, Unit& u) const {
        const long L = (long)i * G + c; if (L >= nwg) return false;
        int wgid = (int)L; { const int q = nwg / NXCD, r = nwg % NXCD, xcd = wgid % NXCD, off = wgid / NXCD; wgid = (xcd < r ? xcd * (q + 1) : r * (q + 1) + (xcd - r) * q) + off; }
        const int nig = WGM * nN, gid = wgid / nig, fm = gid * WGM, gsz = (nM - fm) < WGM ? (nM - fm) : WGM;
        u.pm = fm + ((wgid % nig) % gsz); u.pn = (wgid % nig) / gsz; return true;
    }
    __device__ __forceinline__ void a_ready(const Unit&) const {}
    __device__ __forceinline__ void done(const Unit&) const {}
};

__device__ __forceinline__ unsigned cvt_pk_bf16(float lo, float hi) { unsigned r; asm volatile("v_cvt_pk_bf16_f32 %0, %1, %2" : "=v"(r) : "v"(lo), "v"(hi)); return r; }
typedef float f32x2 __attribute__((ext_vector_type(2)));
template <class Epi, class Sched, bool ALIGN_EPI = false, bool SP2 = false>
__device__ __forceinline__ void gemm_phase(PG8_LAS unsigned char* lds, const Gemm g, const Sched& S, const Epi& E) {
    int tid_ = threadIdx.x; asm volatile("" : "+v"(tid_)); const int tid = tid_, wid = __builtin_amdgcn_readfirstlane(tid >> 6), lane = tid & 63, wr = wid >> 2, wc = wid & 3, fr = lane & 15, fq = lane >> 4;
    const int K = g.K, nt = K / BK;
    unsigned voffA[2], voffB[2];
#pragma unroll
    for (int i = 0; i < 2; ++i) { int R, C; stage_rc(tid * 16 + i * 8192, R, C); const int Rb = Epi::PERM ? ((R & ~31) + perm32(R & 31)) : R;
        voffA[i] = (unsigned)(R * K + C) * 2u; voffB[i] = (unsigned)(Rb * K + C) * 2u; }
    const size_t kstep = (size_t)(BK * 2);
    const size_t hstep = (size_t)HALF * K * 2;
    const size_t tstep = 2 * hstep;
    const unsigned ldsw = (unsigned)wid * 1024u;
    const int aoff = lds_byte(wr * 64 + fr, fq * 8), boff = lds_byte(wc * 32 + fr, fq * 8);
#define PG8_SA(b, h) (((b) * 2 + (h)) * HTB)
#define PG8_SB(b, h) ((4 + (b) * 2 + (h)) * HTB)
#define PG8_STAGE(bufoff, gbase, voff) do { _Pragma("unroll") for (int _i = 0; _i < 2; ++_i) \
        __builtin_amdgcn_global_load_lds((const unsigned*)((const char*)(gbase) + (voff)[_i]), (PG8_LAS unsigned*)(lds + (bufoff) + ldsw + _i * 8192), 16, 0, 0); } while (0)
#define PG8_LDA(dst, b, h) do { _Pragma("unroll") for (int m = 0; m < 4; ++m) _Pragma("unroll") for (int k = 0; k < 2; ++k) dst[m][k] = *(const PG8_LAS bf16x8*)(lds + PG8_SA(b, h) + aoff + m * 2048 + k * 1024); } while (0)
#define PG8_LDB(dst, b, h) do { _Pragma("unroll") for (int n = 0; n < 2; ++n) _Pragma("unroll") for (int k = 0; k < 2; ++k) dst[n][k] = *(const PG8_LAS bf16x8*)(lds + PG8_SB(b, h) + boff + n * 2048 + k * 1024); } while (0)
#define PG8_MMA(ai, bj, At, Bt) do { __builtin_amdgcn_s_setprio(1); _Pragma("unroll") for (int m = 0; m < 4; ++m) _Pragma("unroll") for (int n = 0; n < 2; ++n) _Pragma("unroll") for (int k = 0; k < 2; ++k) \
        acc[ai][bj][m][n] = __builtin_amdgcn_mfma_f32_16x16x32_bf16(Bt[n][k], At[m][k], acc[ai][bj][m][n], 0, 0, 0); __builtin_amdgcn_s_setprio(0); } while (0)
#define PG8_WAIT_V(n) asm volatile("s_waitcnt vmcnt(" #n ")" ::: "memory")
#define PG8_WAIT_L(n) asm volatile("s_waitcnt lgkmcnt(" #n ")" ::: "memory")
#define PG8_BAR __builtin_amdgcn_s_barrier()
#define PG8_SCHED __builtin_amdgcn_sched_barrier(0)
    Unit cur, nxt; int ui = 0;
    if (!S.next(0, cur)) return;
    f32x4 acc[2][2][4][2];
#pragma unroll
    for (int a = 0; a < 2; ++a)
#pragma unroll
        for (int b = 0; b < 2; ++b)
#pragma unroll
            for (int m = 0; m < 4; ++m)
#pragma unroll
                for (int n = 0; n < 2; ++n) acc[a][b][m][n] = (f32x4){0.f, 0.f, 0.f, 0.f};
    bf16x8 At[4][2], B0[2][2], B1[2][2];
    const char* cA = (const char*)g.A + (size_t)cur.pm * tstep; const char* cB = (const char*)g.Bt + (size_t)cur.pn * tstep;
    S.a_ready(cur);
    if constexpr (SP2) {
        PG8_STAGE(PG8_SB(0, 0), cB, voffB); PG8_STAGE(PG8_SB(0, 1), cB + hstep, voffB); PG8_STAGE(PG8_SA(0, 0), cA, voffA); PG8_STAGE(PG8_SA(0, 1), cA + hstep, voffA);
        if (wr == 1) PG8_BAR;
        PG8_WAIT_V(2); PG8_BAR;
        PG8_STAGE(PG8_SB(1, 0), cB + kstep, voffB); PG8_STAGE(PG8_SA(1, 0), cA + kstep, voffA); PG8_STAGE(PG8_SB(1, 1), cB + hstep + kstep, voffB);
        PG8_WAIT_V(6); PG8_BAR;
    } else {
        PG8_STAGE(PG8_SB(0, 0), cB, voffB); PG8_STAGE(PG8_SA(0, 0), cA, voffA); PG8_STAGE(PG8_SB(0, 1), cB + hstep, voffB); PG8_STAGE(PG8_SA(0, 1), cA + hstep, voffA);
        if (wr == 1) PG8_BAR;
        PG8_WAIT_V(4); PG8_BAR;
        PG8_STAGE(PG8_SB(1, 0), cB + kstep, voffB); PG8_STAGE(PG8_SA(1, 0), cA + kstep, voffA); PG8_STAGE(PG8_SB(1, 1), cB + hstep + kstep, voffB);
        PG8_WAIT_V(6); PG8_BAR;
    }
    for (;;) {
        const bool has_next = S.next(ui + 1, nxt);
        const char* nA = has_next ? (const char*)g.A + (size_t)nxt.pm * tstep : cA; const char* nB = has_next ? (const char*)g.Bt + (size_t)nxt.pn * tstep : cB;
        for (int t = 0; t < nt; t += 2) {
            const bool last = (t == nt - 2);
            const char* a1 = cA + (size_t)(t + 1) * kstep;
            const char* a2 = last ? nA : cA + (size_t)(t + 2) * kstep; const char* b2 = last ? nB : cB + (size_t)(t + 2) * kstep;
            const char* a3 = a2 + kstep; const char* b3 = b2 + kstep;
            if (last && has_next) S.a_ready(nxt);
            if constexpr (SP2) {
            PG8_LDB(B0, 0, 0); PG8_LDB(B1, 0, 1); PG8_SCHED; PG8_LDA(At, 0, 0); PG8_STAGE(PG8_SA(1, 1), a1 + hstep, voffA);
            PG8_WAIT_V(8); PG8_WAIT_L(0); PG8_BAR; PG8_MMA(0, 0, At, B0); PG8_MMA(0, 1, At, B1); PG8_BAR; PG8_SCHED;
            PG8_LDA(At, 0, 1); PG8_STAGE(PG8_SB(0, 0), b2, voffB); PG8_STAGE(PG8_SB(0, 1), b2 + hstep, voffB); PG8_STAGE(PG8_SA(0, 0), a2, voffA);
            PG8_WAIT_V(8); PG8_WAIT_L(0); PG8_BAR; PG8_MMA(1, 0, At, B0); PG8_MMA(1, 1, At, B1); PG8_BAR; PG8_SCHED;
            PG8_LDB(B0, 1, 0); PG8_LDB(B1, 1, 1); PG8_SCHED; PG8_LDA(At, 1, 0); PG8_STAGE(PG8_SA(0, 1), a2 + hstep, voffA);
            PG8_WAIT_V(8); PG8_WAIT_L(0); PG8_BAR; PG8_MMA(0, 0, At, B0); PG8_MMA(0, 1, At, B1); PG8_BAR; PG8_SCHED;
            PG8_LDA(At, 1, 1); PG8_STAGE(PG8_SB(1, 0), b3, voffB); PG8_STAGE(PG8_SB(1, 1), b3 + hstep, voffB); PG8_STAGE(PG8_SA(1, 0), a3, voffA);
            PG8_WAIT_V(8); PG8_WAIT_L(0); PG8_BAR; PG8_MMA(1, 0, At, B0); PG8_MMA(1, 1, At, B1); PG8_BAR; PG8_SCHED;
            } else {
            PG8_LDB(B0, 0, 0); PG8_SCHED; PG8_LDA(At, 0, 0); PG8_STAGE(PG8_SA(1, 1), a1 + hstep, voffA);
            PG8_WAIT_L(8); PG8_BAR; PG8_WAIT_L(0); PG8_MMA(0, 0, At, B0); PG8_BAR; PG8_SCHED;
            PG8_LDB(B1, 0, 1); PG8_STAGE(PG8_SB(0, 0), b2, voffB);
            PG8_BAR; PG8_WAIT_L(0); PG8_MMA(0, 1, At, B1); PG8_BAR;
            PG8_LDA(At, 0, 1); PG8_STAGE(PG8_SA(0, 0), a2, voffA);
            PG8_BAR; PG8_WAIT_L(0); PG8_MMA(1, 0, At, B0); PG8_BAR; PG8_SCHED;
            PG8_STAGE(PG8_SB(0, 1), b2 + hstep, voffB);
            PG8_WAIT_V(6); PG8_BAR; PG8_MMA(1, 1, At, B1); PG8_BAR;
            PG8_LDB(B0, 1, 0); PG8_SCHED; PG8_LDA(At, 1, 0); PG8_STAGE(PG8_SA(0, 1), a2 + hstep, voffA);
            PG8_WAIT_L(8); PG8_BAR; PG8_WAIT_L(0); PG8_MMA(0, 0, At, B0); PG8_BAR; PG8_SCHED;
            PG8_LDB(B1, 1, 1); PG8_STAGE(PG8_SB(1, 0), b3, voffB);
            PG8_BAR; PG8_WAIT_L(0); PG8_MMA(0, 1, At, B1); PG8_BAR;
            PG8_LDA(At, 1, 1); PG8_STAGE(PG8_SA(1, 0), a3, voffA);
            PG8_BAR; PG8_WAIT_L(0); PG8_MMA(1, 0, At, B0); PG8_BAR; PG8_SCHED;
            PG8_STAGE(PG8_SB(1, 1), b3 + hstep, voffB);
            PG8_WAIT_V(6); PG8_BAR; PG8_MMA(1, 1, At, B1); PG8_BAR;
            }
        }
        if constexpr (ALIGN_EPI) { if (wr == 0) PG8_BAR; }
        if constexpr (!Epi::AFTER_DRAIN) { E(acc, cur, wr, wc, fr, fq); S.done(cur); }
        if (!has_next) break;
#pragma unroll
        for (int a = 0; a < 2; ++a)
#pragma unroll
            for (int b = 0; b < 2; ++b)
#pragma unroll
                for (int m = 0; m < 4; ++m)
#pragma unroll
                    for (int n = 0; n < 2; ++n) acc[a][b][m][n] = (f32x4){0.f, 0.f, 0.f, 0.f};
        cur = nxt; cA = nA; cB = nB; ++ui;
        if constexpr (ALIGN_EPI) { if (wr == 1) PG8_BAR; }
    }
    PG8_WAIT_V(0);
    if constexpr (!ALIGN_EPI) { if (wr == 0) PG8_BAR; }
    PG8_BAR;
    if constexpr (Epi::AFTER_DRAIN) { E.fused(acc, cur, wr, wc, fr, fq, lds, wid, lane); S.done(cur); }
#undef PG8_SA
#undef PG8_SB
#undef PG8_STAGE
#undef PG8_LDA
#undef PG8_LDB
#undef PG8_MMA
#undef PG8_WAIT_V
#undef PG8_WAIT_L
#undef PG8_BAR
#undef PG8_SCHED
}
}
namespace pg8 {
template <class Epi, class Sched>
__device__ __forceinline__ void gemm_phase_x(PG8_LAS unsigned char* lds, const Gemm g, const bf16_t* AX, const Sched& S, const Epi& E) {
    static_assert(!Epi::PERM && !Epi::AFTER_DRAIN, "gemm_phase_x: plain f32 epilogues only");
    int tid_ = threadIdx.x; asm volatile("" : "+v"(tid_)); const int tid = tid_, wid = __builtin_amdgcn_readfirstlane(tid >> 6), lane = tid & 63, wr = wid >> 2, wc = wid & 3, fr = lane & 15, fq = lane >> 4;
    const int K = g.K, nt = K / BK;
    unsigned voffA[2], voffB[2];
#pragma unroll
    for (int i = 0; i < 2; ++i) { int R, C; stage_rc(tid * 16 + i * 8192, R, C); voffA[i] = (unsigned)(R * K + C) * 2u; voffB[i] = voffA[i]; }
    unsigned voffX; { const int b_ = lane * 16, swz = b_ ^ (((b_ >> 9) & 1) << 5), r = swz / 64, c = (swz % 64) / 2; voffX = (unsigned)(r * K + c + 32 * (wid & 1)) * 2u; }
    const size_t kstep = (size_t)(BK * 2), hstep = (size_t)HALF * K * 2, tstep = 2 * hstep, xstep = (size_t)16 * K * 2;
    const unsigned ldsw = (unsigned)wid * 1024u;
    const int aoff = lds_byte(wr * 64 + fr, fq * 8), boff = lds_byte(wc * 32 + fr, fq * 8), xoff = lds_byte(fr, fq * 8);
#define PG8_SA(b, h) (((b) * 2 + (h)) * HTB)
#define PG8_SB(b, h) ((4 + (b) * 2 + (h)) * HTB)
#define PG8_SX(b) (STAGE_BYTES + (b) * 2048)
#define PG8_STAGE(bufoff, gbase, voff) do { _Pragma("unroll") for (int _i = 0; _i < 2; ++_i) \
        __builtin_amdgcn_global_load_lds((const unsigned*)((const char*)(gbase) + (voff)[_i]), (PG8_LAS unsigned*)(lds + (bufoff) + ldsw + _i * 8192), 16, 0, 0); } while (0)
#define PG8_STAGEX(b, gbase) do { if (wid < 2) __builtin_amdgcn_global_load_lds((const unsigned*)((const char*)(gbase) + voffX), (PG8_LAS unsigned*)(lds + PG8_SX(b) + ldsw), 16, 0, 0); } while (0)
#define PG8_LDA(dst, b, h) do { _Pragma("unroll") for (int m = 0; m < 4; ++m) _Pragma("unroll") for (int k = 0; k < 2; ++k) dst[m][k] = *(const PG8_LAS bf16x8*)(lds + PG8_SA(b, h) + aoff + m * 2048 + k * 1024); } while (0)
#define PG8_LDB(dst, b, h) do { _Pragma("unroll") for (int n = 0; n < 2; ++n) _Pragma("unroll") for (int k = 0; k < 2; ++k) dst[n][k] = *(const PG8_LAS bf16x8*)(lds + PG8_SB(b, h) + boff + n * 2048 + k * 1024); } while (0)
#define PG8_LDX(b) do { _Pragma("unroll") for (int k = 0; k < 2; ++k) Ax[k] = *(const PG8_LAS bf16x8*)(lds + PG8_SX(b) + k * 1024 + xoff); } while (0)
#define PG8_MMA(ai, bj, At, Bt) do { __builtin_amdgcn_s_setprio(1); _Pragma("unroll") for (int m = 0; m < 4; ++m) _Pragma("unroll") for (int n = 0; n < 2; ++n) _Pragma("unroll") for (int k = 0; k < 2; ++k) \
        acc[ai][bj][m][n] = __builtin_amdgcn_mfma_f32_16x16x32_bf16(Bt[n][k], At[m][k], acc[ai][bj][m][n], 0, 0, 0); __builtin_amdgcn_s_setprio(0); } while (0)
#define PG8_MMAX() do { if (wr == 0) { _Pragma("unroll") for (int n = 0; n < 2; ++n) _Pragma("unroll") for (int k = 0; k < 2; ++k) accx[n] = __builtin_amdgcn_mfma_f32_16x16x32_bf16(B0[n][k], Ax[k], accx[n], 0, 0, 0); } \
        else { _Pragma("unroll") for (int n = 0; n < 2; ++n) _Pragma("unroll") for (int k = 0; k < 2; ++k) accx[n] = __builtin_amdgcn_mfma_f32_16x16x32_bf16(B1[n][k], Ax[k], accx[n], 0, 0, 0); } } while (0)
#define PG8_WAIT_V(n) asm volatile("s_waitcnt vmcnt(" #n ")" ::: "memory")
#define PG8_WAIT_VX() do { if (wid < 2) PG8_WAIT_V(9); else PG8_WAIT_V(8); } while (0)
#define PG8_WAIT_L(n) asm volatile("s_waitcnt lgkmcnt(" #n ")" ::: "memory")
#define PG8_BAR __builtin_amdgcn_s_barrier()
#define PG8_SCHED __builtin_amdgcn_sched_barrier(0)
    Unit cur, nxt; int ui = 0;
    if (!S.next(0, cur)) return;
    f32x4 acc[2][2][4][2], accx[2];
#pragma unroll
    for (int a = 0; a < 2; ++a)
#pragma unroll
        for (int b = 0; b < 2; ++b)
#pragma unroll
            for (int m = 0; m < 4; ++m)
#pragma unroll
                for (int n = 0; n < 2; ++n) acc[a][b][m][n] = (f32x4){0.f, 0.f, 0.f, 0.f};
    accx[0] = (f32x4){0.f, 0.f, 0.f, 0.f}; accx[1] = (f32x4){0.f, 0.f, 0.f, 0.f};
    bf16x8 At[4][2], B0[2][2], B1[2][2], Ax[2];
    const char* cA = (const char*)g.A + (size_t)cur.pm * tstep; const char* cB = (const char*)g.Bt + (size_t)cur.pn * tstep; const char* cX = (const char*)AX + (size_t)cur.pm * xstep;
    S.a_ready(cur);
    PG8_STAGEX(0, cX); PG8_STAGEX(1, cX + kstep);
    PG8_STAGE(PG8_SB(0, 0), cB, voffB); PG8_STAGE(PG8_SB(0, 1), cB + hstep, voffB); PG8_STAGE(PG8_SA(0, 0), cA, voffA); PG8_STAGE(PG8_SA(0, 1), cA + hstep, voffA);
    if (wr == 1) PG8_BAR;
    PG8_WAIT_V(2); PG8_BAR;
    PG8_STAGE(PG8_SB(1, 0), cB + kstep, voffB); PG8_STAGE(PG8_SA(1, 0), cA + kstep, voffA); PG8_STAGE(PG8_SB(1, 1), cB + hstep + kstep, voffB);
    PG8_WAIT_V(6); PG8_BAR;
    for (;;) {
        const bool has_next = S.next(ui + 1, nxt);
        const char* nA = has_next ? (const char*)g.A + (size_t)nxt.pm * tstep : cA; const char* nB = has_next ? (const char*)g.Bt + (size_t)nxt.pn * tstep : cB;
        const char* nX = has_next ? (const char*)AX + (size_t)nxt.pm * xstep : cX;
        for (int t = 0; t < nt; t += 2) {
            const bool last = (t == nt - 2);
            const char* a1 = cA + (size_t)(t + 1) * kstep;
            const char* a2 = last ? nA : cA + (size_t)(t + 2) * kstep; const char* b2 = last ? nB : cB + (size_t)(t + 2) * kstep; const char* x2 = last ? nX : cX + (size_t)(t + 2) * kstep;
            const char* a3 = a2 + kstep; const char* b3 = b2 + kstep; const char* x3 = x2 + kstep;
            if (last && has_next) S.a_ready(nxt);
            PG8_LDB(B0, 0, 0); PG8_LDB(B1, 0, 1); PG8_SCHED; PG8_LDA(At, 0, 0); PG8_LDX(0); PG8_STAGE(PG8_SA(1, 1), a1 + hstep, voffA);
            PG8_WAIT_VX(); PG8_WAIT_L(0); PG8_BAR; PG8_MMA(0, 0, At, B0); PG8_MMA(0, 1, At, B1); PG8_MMAX(); PG8_BAR; PG8_SCHED;
            PG8_LDA(At, 0, 1); PG8_STAGE(PG8_SB(0, 0), b2, voffB); PG8_STAGE(PG8_SB(0, 1), b2 + hstep, voffB); PG8_STAGE(PG8_SA(0, 0), a2, voffA); PG8_STAGEX(0, x2);
            PG8_WAIT_VX(); PG8_WAIT_L(0); PG8_BAR; PG8_MMA(1, 0, At, B0); PG8_MMA(1, 1, At, B1); PG8_BAR; PG8_SCHED;
            PG8_LDB(B0, 1, 0); PG8_LDB(B1, 1, 1); PG8_SCHED; PG8_LDA(At, 1, 0); PG8_LDX(1); PG8_STAGE(PG8_SA(0, 1), a2 + hstep, voffA);
            PG8_WAIT_VX(); PG8_WAIT_L(0); PG8_BAR; PG8_MMA(0, 0, At, B0); PG8_MMA(0, 1, At, B1); PG8_MMAX(); PG8_BAR; PG8_SCHED;
            PG8_LDA(At, 1, 1); PG8_STAGE(PG8_SB(1, 0), b3, voffB); PG8_STAGE(PG8_SB(1, 1), b3 + hstep, voffB); PG8_STAGE(PG8_SA(1, 0), a3, voffA); PG8_STAGEX(1, x3);
            PG8_WAIT_VX(); PG8_WAIT_L(0); PG8_BAR; PG8_MMA(1, 0, At, B0); PG8_MMA(1, 1, At, B1); PG8_BAR; PG8_SCHED;
        }
        if (wr == 0) PG8_BAR;
        E(acc, cur, wr, wc, fr, fq); E.extra(accx, cur, wr, wc, fr, fq); S.done(cur);
        if (!has_next) break;
#pragma unroll
        for (int a = 0; a < 2; ++a)
#pragma unroll
            for (int b = 0; b < 2; ++b)
#pragma unroll
                for (int m = 0; m < 4; ++m)
#pragma unroll
                    for (int n = 0; n < 2; ++n) acc[a][b][m][n] = (f32x4){0.f, 0.f, 0.f, 0.f};
        accx[0] = (f32x4){0.f, 0.f, 0.f, 0.f}; accx[1] = (f32x4){0.f, 0.f, 0.f, 0.f};
        cur = nxt; cA = nA; cB = nB; cX = nX; ++ui;
        if (wr == 1) PG8_BAR;
    }
    PG8_WAIT_V(0);
    PG8_BAR;
#undef PG8_SA
#undef PG8_SB
#undef PG8_SX
#undef PG8_STAGE
#undef PG8_STAGEX
#undef PG8_LDA
#undef PG8_LDB
#undef PG8_LDX
#undef PG8_MMA
#undef PG8_MMAX
#undef PG8_WAIT_V
#undef PG8_WAIT_VX
#undef PG8_WAIT_L
#undef PG8_BAR
#undef PG8_SCHED
}
}

#define LAS __attribute__((address_space(3)))
#define GAS __attribute__((address_space(1)))
typedef unsigned short bf16;
typedef short bf16x8 __attribute__((ext_vector_type(8)));
typedef float f32x4 __attribute__((ext_vector_type(4)));
typedef float f32x16 __attribute__((ext_vector_type(16)));
typedef unsigned u32x4 __attribute__((ext_vector_type(4)));
typedef unsigned u32x2 __attribute__((ext_vector_type(2)));
#define RLX_AGENT __ATOMIC_RELAXED, __HIP_MEMORY_SCOPE_AGENT
#define LDS_WAIT() asm volatile("s_waitcnt lgkmcnt(0)" ::: "memory")
#define VM_WAIT() asm volatile("s_waitcnt vmcnt(0)" ::: "memory")

constexpr int NWAVES = 8, NTHR = 512;
constexpr int DM = 2048, NPR = 8192, NSR = 512, MROWS = 8704, SEQ = 2048, NBP = 4, NBS = 128, NB = 132, DEPTH = 4;
constexpr int NIN = 4632, NINP = 4864, PW = 4608;
constexpr int DFF = 5504, NUP = 11008;
constexpr int XBCW = 2560, SSDW = 1536, NH = 24, HD = 64, NG = 4, HPG = 6, DS = 128, POOLW = 512;
constexpr int NCH = 16;
constexpr int ADA = 12288;
constexpr float EPS = 1e-6f;

constexpr size_t O_YP = 0, O_YS = O_YP + (size_t)NPR * DM, O_PP = O_YS + (size_t)NSR * DM, O_CP = O_PP + (size_t)DEPTH * NBP * 15 * 512,
                 O_SP = O_CP + (size_t)DEPTH * NBP * 3 * XBCW, O_FP = O_SP + (size_t)DEPTH * NBP * NH * HD * DS, O_PS = O_FP + (size_t)DEPTH * NBP * 2 * DFF,
                 O_CS = O_PS + (size_t)DEPTH * NBS * 15 * 512, O_SS = O_CS + (size_t)DEPTH * NBS * 3 * XBCW, O_FS = O_SS + (size_t)DEPTH * NBS * NH * HD * DS,
                 O_END = O_FS + (size_t)DEPTH * NBS * 2 * DFF;
static_assert(O_END == 135557120ull, "output size");

constexpr size_t al256(size_t x) { return (x + 255) & ~(size_t)255; }
constexpr size_t WS_CTL = 0, CTL_BYTES = 1u << 20;
constexpr size_t WS_WIN = CTL_BYTES,                         SZ_WIN = (size_t)NINP * DM * 2;
constexpr size_t WS_WOUT = WS_WIN + DEPTH * SZ_WIN,          SZ_WOUT = (size_t)DM * DM * 2;
constexpr size_t WS_WUP = WS_WOUT + DEPTH * SZ_WOUT,         SZ_WUP = (size_t)NUP * DM * 2;
constexpr size_t WS_WDN = WS_WUP + DEPTH * SZ_WUP,           SZ_WDN = (size_t)DM * DFF * 2;
constexpr size_t WS_PWT = WS_WDN + DEPTH * SZ_WDN,           SZ_PWT = (size_t)4 * 128 * 128 * 2;
constexpr size_t WS_SC = WS_PWT + DEPTH * SZ_PWT;
constexpr size_t WS_MOD = al256(WS_SC + (size_t)160 * DM * 2);
constexpr size_t WS_H = al256(WS_MOD + (size_t)DEPTH * NB * ADA * 4);
constexpr size_t WS_P = al256(WS_H + (size_t)MROWS * DM * 2);
constexpr size_t WS_DT = al256(WS_P + (size_t)MROWS * PW * 2);
constexpr size_t WS_XC = al256(WS_DT + (size_t)MROWS * 32 * 4);
constexpr size_t WS_DTB = al256(WS_XC + (size_t)MROWS * XBCW * 2);
constexpr size_t WS_CSB = al256(WS_DTB + (size_t)MROWS * NH * 4);
constexpr size_t WS_S = al256(WS_CSB + (size_t)MROWS * NH * 4);
constexpr size_t WS_DEC = al256(WS_S + (size_t)NBP * NCH * NH * HD * DS * 4);
constexpr size_t WS_HS = al256(WS_DEC + (size_t)NBP * NCH * NH * 4);
constexpr size_t WS_MIX = al256(WS_HS + (size_t)NBP * NCH * NH * HD * DS * 2);
constexpr size_t WS_SSQ = al256(WS_MIX + (size_t)MROWS * DM * 2);
constexpr size_t WS_SSQ2 = al256(WS_SSQ + (size_t)MROWS * NH * 4);
constexpr size_t WS_R = al256(WS_SSQ2 + (size_t)NSR * NH * 4 * 4);
constexpr size_t WS_XA = al256(WS_R + (size_t)MROWS * 4);
constexpr size_t WS_XB = al256(WS_XA + (size_t)MROWS * DM * 4);
constexpr size_t WS_UP = al256(WS_XB + (size_t)MROWS * DM * 4);
constexpr size_t WS_ACT = al256(WS_UP + (size_t)MROWS * NUP * 2);
constexpr size_t WS_GH = al256(WS_ACT + (size_t)MROWS * DFF * 2);
constexpr size_t WS_VH = al256(WS_GH + (size_t)34 * 4 * DFF * 4);
constexpr size_t WS_END = al256(WS_VH + (size_t)34 * 2 * DFF * 4);

constexpr int CW_BAR = 4096;
constexpr int LDS_BYTES = 155648;
constexpr int LDS_MISC = 151552;
constexpr int LDS_HALO = 135168;

__device__ __forceinline__ float bflo(unsigned w) { return __uint_as_float(w << 16); }
__device__ __forceinline__ float bfhi(unsigned w) { return __uint_as_float(w & 0xffff0000u); }
__device__ __forceinline__ float bf1(bf16 b) { return __uint_as_float((unsigned)b << 16); }
__device__ __forceinline__ unsigned pk2(float lo, float hi) { return pg8::cvt_pk_bf16(lo, hi); }
__device__ __forceinline__ bf16 f2bf(float f) { return (bf16)(pk2(f, 0.f) & 0xffffu); }
__device__ __forceinline__ void unpack8(const u32x4 w, float (&v)[8]) { v[0] = bflo(w.x); v[1] = bfhi(w.x); v[2] = bflo(w.y); v[3] = bfhi(w.y); v[4] = bflo(w.z); v[5] = bfhi(w.z); v[6] = bflo(w.w); v[7] = bfhi(w.w); }
__device__ __forceinline__ u32x4 pack8(const float (&v)[8]) { u32x4 o; o.x = pk2(v[0], v[1]); o.y = pk2(v[2], v[3]); o.z = pk2(v[4], v[5]); o.w = pk2(v[6], v[7]); return o; }
__device__ __forceinline__ float silu_f(float x) { return x / (1.f + __expf(-x)); }
__device__ __forceinline__ float softplus_f(float x) { return x > 20.f ? x : log1pf(__expf(x)); }
__device__ __forceinline__ float wave_sum(float v) {
#pragma unroll
    for (int o = 1; o < 64; o <<= 1) v += __shfl_xor(v, o);
    return v;
}
#define MFMA16(a, b, c) __builtin_amdgcn_mfma_f32_16x16x32_bf16((a), (b), (c), 0, 0, 0)
__device__ __forceinline__ bf16x8 as_frag(u32x4 w) { return __builtin_bit_cast(bf16x8, w); }

struct Args {
    const float* in[27]; float* out; unsigned char* ws; int ph_lo, ph_hi;
};

__device__ __forceinline__ int row_bidx(int r) { return r < NPR ? (r >> 11) : 4 + ((r - NPR) >> 2); }

struct EpiProj {
    static constexpr bool PERM = true, AFTER_DRAIN = false;
    bf16* P; float* DT;
    __device__ __forceinline__ void operator()(const pg8::f32x4 (&acc)[2][2][4][2], const pg8::Unit& u, int wr, int wc, int fr, int fq) const {
        const int row0 = u.pm * 256 + wr * 64 + fr;
        if (u.pn < 18) {
            const int col0 = u.pn * 256 + wc * 32 + 8 * fq;
#pragma unroll
            for (int ai = 0; ai < 2; ++ai)
#pragma unroll
                for (int m = 0; m < 4; ++m) { bf16* rowp = P + (size_t)(row0 + ai * 128 + m * 16) * PW + col0;
#pragma unroll
                    for (int bj = 0; bj < 2; ++bj) { const pg8::f32x4 v0 = acc[ai][bj][m][0], v1 = acc[ai][bj][m][1];
                        u32x4 w; w.x = pk2(v0[0], v0[1]); w.y = pk2(v0[2], v0[3]); w.z = pk2(v1[0], v1[1]); w.w = pk2(v1[2], v1[3]);
                        *(u32x4*)(rowp + bj * 128) = w; } }
        } else if (wc == 0) {
#pragma unroll
            for (int ai = 0; ai < 2; ++ai)
#pragma unroll
                for (int m = 0; m < 4; ++m) { float* rowp = DT + (size_t)(row0 + ai * 128 + m * 16) * 32 + 8 * fq;
                    *(f32x4*)(rowp) = acc[ai][0][m][0]; *(f32x4*)(rowp + 4) = acc[ai][0][m][1]; }
        }
    }
};
struct EpiBf {
    static constexpr bool PERM = true, AFTER_DRAIN = false;
    bf16* O; int ldc;
    __device__ __forceinline__ void operator()(const pg8::f32x4 (&acc)[2][2][4][2], const pg8::Unit& u, int wr, int wc, int fr, int fq) const {
        const int row0 = u.pm * 256 + wr * 64 + fr, col0 = u.pn * 256 + wc * 32 + 8 * fq;
#pragma unroll
        for (int ai = 0; ai < 2; ++ai)
#pragma unroll
            for (int m = 0; m < 4; ++m) { bf16* rowp = O + (size_t)(row0 + ai * 128 + m * 16) * ldc + col0;
#pragma unroll
                for (int bj = 0; bj < 2; ++bj) { const pg8::f32x4 v0 = acc[ai][bj][m][0], v1 = acc[ai][bj][m][1];
                    u32x4 w; w.x = pk2(v0[0], v0[1]); w.y = pk2(v0[2], v0[3]); w.z = pk2(v1[0], v1[1]); w.w = pk2(v1[2], v1[3]);
                    *(u32x4*)(rowp + bj * 128) = w; } }
    }
};
struct EpiRes {
    static constexpr bool PERM = false, AFTER_DRAIN = false;
    const float* bp; const float* bs; float* out; const float* gate; const float* rs;
    __device__ __forceinline__ void operator()(const pg8::f32x4 (&acc)[2][2][4][2], const pg8::Unit& u, int wr, int wc, int fr, int fq) const {
        const int row0 = u.pm * 256 + wr * 64 + fr, col0 = u.pn * 256 + wc * 32 + 4 * fq;
#pragma unroll
        for (int ai = 0; ai < 2; ++ai)
#pragma unroll
            for (int m = 0; m < 4; ++m) {
                const int r = row0 + ai * 128 + m * 16;
                const float* brow = (r < NPR ? bp + (size_t)r * DM : bs + (size_t)(r - NPR) * DM) + col0;
                const float* grow = gate + (size_t)row_bidx(r) * ADA + col0;
                const float s = rs ? rs[r] : 1.f;
                float* orow = out + (size_t)r * DM + col0;
#pragma unroll
                for (int bj = 0; bj < 2; ++bj)
#pragma unroll
                    for (int n = 0; n < 2; ++n) { const int o = bj * 128 + n * 16;
                        const pg8::f32x4 b = *(const pg8::f32x4*)(brow + o), g = *(const pg8::f32x4*)(grow + o);
                        *(pg8::f32x4*)(orow + o) = b + g * (acc[ai][bj][m][n] * s); }
            }
    }
    __device__ __forceinline__ void extra(const pg8::f32x4 (&accx)[2], const pg8::Unit& u, int wr, int wc, int fr, int fq) const {
        const int r = NPR + 16 * u.pm + fr, col0 = u.pn * 256 + wr * 128 + wc * 32 + 4 * fq;
        const float* brow = bs + (size_t)(r - NPR) * DM + col0;
        const float* grow = gate + (size_t)row_bidx(r) * ADA + col0;
        const float s = rs ? rs[r] : 1.f;
        float* orow = out + (size_t)r * DM + col0;
#pragma unroll
        for (int n = 0; n < 2; ++n) { const int o = n * 16;
            const pg8::f32x4 b = *(const pg8::f32x4*)(brow + o), g = *(const pg8::f32x4*)(grow + o);
            *(pg8::f32x4*)(orow + o) = b + g * (accx[n] * s); }
    }
};


__device__ __forceinline__ float dpp_ror1(float v) { return __int_as_float(__builtin_amdgcn_update_dpp(0, __float_as_int(v), 0x121, 0xf, 0xf, false)); }
__device__ __forceinline__ float dpp_ror2(float v) { return __int_as_float(__builtin_amdgcn_update_dpp(0, __float_as_int(v), 0x122, 0xf, 0xf, false)); }
struct EpiAct {
    static constexpr bool PERM = true, AFTER_DRAIN = false;
    bf16* ACT; float* GH; float* VH; const float* fw; const float* fb; const float* stf; float* ofp; float* ofs; LAS float* hl; int l;
    __device__ __forceinline__ void operator()(const pg8::f32x4 (&acc)[2][2][4][2], const pg8::Unit& u, int wr, int wc, int fr, int fq) const {
        const bool sample = u.pm >= NPR / 256;
        if (fr >= 14) {
#pragma unroll
            for (int ai = 0; ai < 2; ++ai) { LAS float* d = hl + ((ai * 2 + wr) * 2 + (fr - 14)) * 128 + 32 * wc + 8 * fq; *(LAS pg8::f32x4*)d = acc[ai][0][3][0]; *(LAS pg8::f32x4*)(d + 4) = acc[ai][0][3][1]; } }
        asm volatile("s_waitcnt lgkmcnt(0)" ::: "memory"); __builtin_amdgcn_s_barrier(); asm volatile("" ::: "memory");
        const int t4 = fr & 3;
#pragma unroll
        for (int n = 0; n < 2; ++n) {
            const int cl = 32 * wc + 8 * fq + 4 * n, jb = 128 * u.pn + cl;
            const f32x4 w0 = *(const f32x4*)(fw + jb), w1 = *(const f32x4*)(fw + DFF + jb), w2 = *(const f32x4*)(fw + 2 * DFF + jb), bb = *(const f32x4*)(fb + jb);
#pragma unroll
            for (int ai = 0; ai < 2; ++ai) {
                f32x4 p1, p2;
                if (wr == 1 || ai == 1) { const LAS float* s = hl + ((wr == 1 ? ai * 2 : 1) * 2) * 128 + cl;
                    const f32x4 x = *(const LAS pg8::f32x4*)s, y = *(const LAS pg8::f32x4*)(s + 128); p1 = y; p2 = fr == 0 ? x : y; }
                else { p1 = (f32x4){0.f, 0.f, 0.f, 0.f}; p2 = p1; }
#pragma unroll
                for (int m = 0; m < 4; ++m) {
                    int rl_ = ai * 128 + wr * 64 + m * 16 + fr; asm volatile("" : "+v"(rl_));
                    const int rl = rl_, r = u.pm * 256 + rl;
                    f32x4 s0 = (f32x4){0.f, 0.f, 0.f, 0.f}, s1 = s0;
                    if (sample) { const float* sp = stf + ((size_t)((r - NPR) >> 2) * 2) * DFF + jb; s0 = *(const f32x4*)sp; s1 = *(const f32x4*)(sp + DFF); }
                    const f32x4 g = acc[ai][0][m][n], v = acc[ai][1][m][n]; f32x4 o;
#pragma unroll
                    for (int c = 0; c < 4; ++c) {
                        const float R1 = dpp_ror1(g[c]), R2 = dpp_ror2(g[c]);
                        float q1, q2;
                        if (sample) { q1 = t4 >= 1 ? R1 : s1[c]; q2 = t4 >= 2 ? R2 : (t4 == 1 ? s1[c] : s0[c]); }
                        else { q1 = fr >= 1 ? R1 : p1[c]; q2 = fr >= 2 ? R2 : p2[c]; }
                        o[c] = silu_f(bb[c] + w2[c] * g[c] + w1[c] * q1 + w0[c] * q2) * v[c];
                        p1[c] = R1; p2[c] = R2;
                    }
                    u32x2 ow; ow.x = pk2(o[0], o[1]); ow.y = pk2(o[2], o[3]);
                    *(u32x2*)(ACT + (size_t)r * DFF + jb) = ow;
                    if (sample) { if (t4 >= 2) *(f32x4*)(ofs + ((size_t)((r - NPR) >> 2) * 2 + (t4 - 2)) * DFF + jb) = g; }
                    else {
                        if (rl < 2) { *(f32x4*)(GH + ((size_t)u.pm * 4 + rl) * DFF + jb) = g; *(f32x4*)(VH + ((size_t)u.pm * 2 + rl) * DFF + jb) = v; }
                        if (rl >= 254) { *(f32x4*)(GH + ((size_t)u.pm * 4 + 2 + (rl - 254)) * DFF + jb) = g;
                                         if ((u.pm & 7) == 7) *(f32x4*)(ofp + ((size_t)(u.pm >> 3) * 2 + (rl - 254)) * DFF + jb) = g; }
                    }
                }
            }
        }
    }
};

__device__ __forceinline__ void tr_item(const float* W, int K, int N, int nblk, bf16* WT, int mode, const float* ks0, const float* ks1, LAS float* scr, int item, int lane) {
    const int kb = item / nblk, nb = item % nblk, k0 = 64 * kb, n0 = 32 * nb;
    const int n = n0 + (lane & 31);
#pragma unroll 8
    for (int i = 0; i < 32; ++i) { const int kk = 2 * i + (lane >> 5); float v = (n < N) ? W[(size_t)(k0 + kk) * N + n] : 0.f;
        if (mode == 1) { const int k = k0 + kk; v *= (k < 512) ? ks0[k] : ks1[k - 512]; }
        scr[kk * 33 + (lane & 31)] = v; }
    LDS_WAIT(); asm volatile("" ::: "memory");
    const int c = lane & 7;
#pragma unroll
    for (int j = 0; j < 4; ++j) { const int nl = (lane >> 3) + 8 * j; const LAS float* s = scr + (8 * c) * 33 + nl;
        u32x4 o; o.x = pk2(s[0 * 33], s[1 * 33]); o.y = pk2(s[2 * 33], s[3 * 33]); o.z = pk2(s[4 * 33], s[5 * 33]); o.w = pk2(s[6 * 33], s[7 * 33]);
        const int nn = n0 + nl; int row = nn;
        if (mode == 2) row = nn < DFF ? ((nn >> 7) * 256 + (nn & 127)) : (((nn - DFF) >> 7) * 256 + 128 + ((nn - DFF) & 127));
        *(u32x4*)(WT + (size_t)row * K + k0 + 8 * c) = o; }
    LDS_WAIT(); asm volatile("" ::: "memory");
}
__device__ __forceinline__ void p0a_phase(const Args& a, LAS unsigned char* lds, int G) {
    unsigned char* ws_ = a.ws; asm volatile("" : "+s"(ws_));
    int tid_ = threadIdx.x; asm volatile("" : "+v"(tid_)); const int tid = tid_, lane = tid & 63, wave = tid >> 6;
    LAS float* scr = (LAS float*)(lds + wave * 8448);
    const int gw = blockIdx.x * NWAVES + wave, NGW = G * NWAVES;
    constexpr int I_IN = 32 * (NINP / 32), I_OUT = 32 * (DM / 32), I_UP = 32 * (NUP / 32), I_DN = (DFF / 64) * (DM / 32), I_PW = 4 * 2 * 4, I_L = I_IN + I_OUT + I_UP + I_DN + I_PW;
    for (int it = gw; it < DEPTH * I_L; it += NGW) {
        const int l = it / I_L; int r = it % I_L;
        if (r < I_IN) { tr_item(a.in[12] + (size_t)l * DM * NIN, DM, NIN, NINP / 32, (bf16*)(ws_ + WS_WIN + l * SZ_WIN), 0, nullptr, nullptr, scr, r, lane); continue; } r -= I_IN;
        if (r < I_OUT) { tr_item(a.in[21] + (size_t)l * DM * DM, DM, DM, DM / 32, (bf16*)(ws_ + WS_WOUT + l * SZ_WOUT), 1, a.in[14] + l * POOLW, a.in[20] + l * SSDW, scr, r, lane); continue; } r -= I_OUT;
        if (r < I_UP) { tr_item(a.in[22] + (size_t)l * DM * NUP, DM, NUP, NUP / 32, (bf16*)(ws_ + WS_WUP + l * SZ_WUP), 2, nullptr, nullptr, scr, r, lane); continue; } r -= I_UP;
        if (r < I_DN) { tr_item(a.in[25] + (size_t)l * DFF * DM, DFF, DM, DM / 32, (bf16*)(ws_ + WS_WDN + l * SZ_WDN), 0, nullptr, nullptr, scr, r, lane); continue; } r -= I_DN;
        { const int g = r / 8, q = r % 8; tr_item(a.in[13] + ((size_t)l * 4 + g) * 128 * 128, 128, 128, 4, (bf16*)(ws_ + WS_PWT + l * SZ_PWT) + (size_t)g * 128 * 128, 0, nullptr, nullptr, scr, q, lane); }
    }
    bf16* SC = (bf16*)(ws_ + WS_SC);
    for (int i = blockIdx.x * NTHR + tid; i < 160 * (DM / 4); i += G * NTHR) {
        const int row = i / (DM / 4), c4 = (i % (DM / 4)) * 4; f32x4 v = (f32x4){0.f, 0.f, 0.f, 0.f};
        if (row < NBP) v = *(const f32x4*)(a.in[2] + (size_t)row * DM + c4); else if (row < NB) v = *(const f32x4*)(a.in[3] + (size_t)(row - NBP) * DM + c4);
        u32x2 o; o.x = pk2(silu_f(v[0]), silu_f(v[1])); o.y = pk2(silu_f(v[2]), silu_f(v[3]));
        *(u32x2*)(SC + (size_t)row * DM + c4) = o;
    }
}
__device__ __forceinline__ void p0b_phase(const Args& a, LAS unsigned char* lds, int G) {
    unsigned char* ws_ = a.ws; asm volatile("" : "+s"(ws_));
    int tid_ = threadIdx.x; asm volatile("" : "+v"(tid_)); const int tid = tid_, lane = tid & 63, wave = __builtin_amdgcn_readfirstlane(tid >> 6), fr = lane & 15, q = lane >> 4;
    const bf16* SC = (const bf16*)(ws_ + WS_SC); float* MOD = (float*)(ws_ + WS_MOD);
    const int cb = wave & 3, kh = wave >> 2;
    for (int u = blockIdx.x; u < DEPTH * (ADA / 256); u += G) {
        const int l = u / (ADA / 256), n0 = (u % (ADA / 256)) * 256 + 64 * cb + 4 * fr;
        const float* W = a.in[10] + (size_t)l * DM * ADA + n0;
        f32x4 acc[4][9];
#pragma unroll
        for (int e = 0; e < 4; ++e)
#pragma unroll
            for (int m = 0; m < 9; ++m) acc[e][m] = (f32x4){0.f, 0.f, 0.f, 0.f};
#pragma unroll 1
        for (int kk = 0; kk < 32; ++kk) {
            const int k0 = kh * 1024 + kk * 32 + 8 * q;
            f32x4 v[8];
#pragma unroll
            for (int j = 0; j < 8; ++j) v[j] = *(const f32x4*)(W + (size_t)(k0 + j) * ADA);
            bf16x8 bfr[4];
#pragma unroll
            for (int e = 0; e < 4; ++e) { u32x4 w; w.x = pk2(v[0][e], v[1][e]); w.y = pk2(v[2][e], v[3][e]); w.z = pk2(v[4][e], v[5][e]); w.w = pk2(v[6][e], v[7][e]); bfr[e] = as_frag(w); }
#pragma unroll
            for (int m = 0; m < 9; ++m) { const bf16x8 afr = as_frag(*(const u32x4*)(SC + (size_t)(16 * m + fr) * DM + k0));
#pragma unroll
                for (int e = 0; e < 4; ++e) acc[e][m] = MFMA16(afr, bfr[e], acc[e][m]); }
        }
        LAS f32x4* red = (LAS f32x4*)lds + (size_t)cb * 36 * 64 + lane;
        if (kh == 1) {
#pragma unroll
            for (int e = 0; e < 4; ++e)
#pragma unroll
                for (int m = 0; m < 9; ++m) red[(e * 9 + m) * 64] = acc[e][m];
        }
        __syncthreads();
        if (kh == 0) {
            const f32x4 bias = *(const f32x4*)(a.in[11] + (size_t)l * ADA + n0);
#pragma unroll
            for (int m = 0; m < 9; ++m) {
                f32x4 t[4];
#pragma unroll
                for (int e = 0; e < 4; ++e) t[e] = acc[e][m] + red[(e * 9 + m) * 64];
                float* p = MOD + ((size_t)l * NB + 16 * m + 4 * q) * ADA + n0; asm volatile("" : "+v"(p));
#pragma unroll
                for (int r = 0; r < 4; ++r) if (16 * m + 4 * q + r < NB) *(f32x4*)(p + (size_t)r * ADA) = (f32x4){t[0][r], t[1][r], t[2][r], t[3][r]} + bias;
            }
        }
        __syncthreads();
    }
}
__device__ __forceinline__ void norm_phase(const float* xp, const float* xs, const float* gamma, const float* modl, int shc, bf16* H, int G) {
    int tid_ = threadIdx.x; asm volatile("" : "+v"(tid_)); const int tid = tid_, lane = tid & 63, wave = tid >> 6;
    for (int row = blockIdx.x * NWAVES + wave; row < MROWS; row += G * NWAVES) {
        const float* xr = (row < NPR ? xp + (size_t)row * DM : xs + (size_t)(row - NPR) * DM) + 4 * lane;
        f32x4 v[8]; float ss = 0.f;
#pragma unroll
        for (int j = 0; j < 8; ++j) { v[j] = *(const f32x4*)(xr + 256 * j); ss += (v[j][0] * v[j][0] + v[j][1] * v[j][1]) + (v[j][2] * v[j][2] + v[j][3] * v[j][3]); }
        const float rstd = 1.f / sqrtf(wave_sum(ss) * (1.f / DM) + EPS);
        const float* mrow = modl + (size_t)row_bidx(row) * ADA + 4 * lane;
        bf16* hr = H + (size_t)row * DM + 4 * lane;
#pragma unroll
        for (int j = 0; j < 8; ++j) { const f32x4 g = *(const f32x4*)(gamma + 256 * j + 4 * lane), sh = *(const f32x4*)(mrow + shc * DM + 256 * j), sc = *(const f32x4*)(mrow + (shc + 1) * DM + 256 * j);
            const f32x4 y = (v[j] * rstd) * g * (sc + 1.f) + sh;
            u32x2 o; o.x = pk2(y[0], y[1]); o.y = pk2(y[2], y[3]); *(u32x2*)(hr + 256 * j) = o; }
    }
}
__device__ __forceinline__ void final_phase(const float* X, const float* gamma, float* out, int G) {
    int tid_ = threadIdx.x; asm volatile("" : "+v"(tid_)); const int tid = tid_, lane = tid & 63, wave = tid >> 6;
    for (int row = blockIdx.x * NWAVES + wave; row < MROWS; row += G * NWAVES) {
        const float* xr = X + (size_t)row * DM + 4 * lane;
        f32x4 v[8]; float ss = 0.f;
#pragma unroll
        for (int j = 0; j < 8; ++j) { v[j] = *(const f32x4*)(xr + 256 * j); ss += (v[j][0] * v[j][0] + v[j][1] * v[j][1]) + (v[j][2] * v[j][2] + v[j][3] * v[j][3]); }
        const float rstd = 1.f / sqrtf(wave_sum(ss) * (1.f / DM) + EPS);
        float* orow = out + (size_t)row * DM + 4 * lane;
#pragma unroll
        for (int j = 0; j < 8; ++j) { const f32x4 g = *(const f32x4*)(gamma + 256 * j + 4 * lane); *(f32x4*)(orow + 256 * j) = (v[j] * rstd) * g; }
    }
}
#define XB_TMO      128
#define XB_XCNT(j)  (256  + 64 * (j))
#define XB_XSUB(j)  (1280 + 64 * (j))
#define XB_XGEN(j)  (2304 + 64 * (j))
#define XB_TOP      3328
#define XB_TOPGEN   3392
#define XCD_BAR_WORDS 3456
#define XB_SPIN_CAP (1u << 18)

__device__ __forceinline__ unsigned xb_ld(unsigned* p)              { return __hip_atomic_load(p, __ATOMIC_RELAXED, __HIP_MEMORY_SCOPE_AGENT); }
__device__ __forceinline__ unsigned xb_add(unsigned* p, unsigned v) { return __hip_atomic_fetch_add(p, v, __ATOMIC_RELAXED, __HIP_MEMORY_SCOPE_AGENT); }
__device__ __forceinline__ unsigned xb_xcc_id() { return (unsigned)__builtin_amdgcn_s_getreg((3 << 11) | 20) & 0xFu; }
#define XB_SPIN(cond, bar) do { unsigned _sp = 0; while (cond) { __builtin_amdgcn_s_sleep(1); \
    if ((++_sp & 255u) == 0u) { if (xb_ld(&(bar)[XB_TMO])) break; if (_sp > XB_SPIN_CAP) { atomicAdd(&(bar)[XB_TMO], 1u); break; } } } } while (0)

struct XcdBarrier {
    unsigned* bar; unsigned x;
    volatile LAS unsigned* st;
};

__device__ __forceinline__ XcdBarrier xcd_barrier_post(unsigned* bar, volatile LAS unsigned* st) {
    XcdBarrier b; b.bar = bar; b.x = xb_xcc_id(); b.st = st;
    if (threadIdx.x == 0) (void)xb_add(&bar[XB_XCNT(b.x)], 1u);
    return b;
}
__device__ __forceinline__ void xcd_barrier_complete(unsigned* bar, unsigned x, unsigned& nloc, unsigned& nx) {
    const unsigned G = gridDim.x * gridDim.y * gridDim.z;
    unsigned sum, cnt, mine, sp = 0u;
    for (;;) {
        sum = 0u; cnt = 0u; mine = 0u;
#pragma unroll
        for (unsigned j = 0; j < 16; ++j) { const unsigned c = xb_ld(&bar[XB_XCNT(j)]); sum += c; cnt += (c > 0u) ? 1u : 0u; mine = (j == x) ? c : mine; }
        if (sum == G) break;
        __builtin_amdgcn_s_sleep(1);
        if ((++sp & 255u) == 0u) { if (xb_ld(&bar[XB_TMO])) break; if (sp > XB_SPIN_CAP) { atomicAdd(&bar[XB_TMO], 1u); break; } }
    }
    nloc = mine > 0u ? mine : 1u; nx = cnt > 0u ? cnt : 1u;
}

__device__ __forceinline__ void xcd_barrier(const XcdBarrier& b) {
    asm volatile("s_waitcnt vmcnt(0)" ::: "memory");
    __syncthreads();
    if (threadIdx.x == 0) {
        unsigned* bar = b.bar;
        __builtin_amdgcn_s_waitcnt(0);
        unsigned nloc = b.st[0], nx = b.st[1];
        if (nloc == 0u) { xcd_barrier_complete(bar, b.x, nloc, nx); b.st[0] = nloc; b.st[1] = nx; }
        const unsigned old = xb_add(&bar[XB_XSUB(b.x)], 1u);
        const unsigned gen = old / nloc;
        if (old + 1u == (gen + 1u) * nloc) {
            __builtin_amdgcn_fence(__ATOMIC_RELEASE, "agent");
            asm volatile("s_waitcnt vmcnt(0)" ::: "memory");
            const unsigned og = xb_add(&bar[XB_TOP], 1u);
            const unsigned tg = og / nx;
            if (og + 1u == (tg + 1u) * nx) xb_add(&bar[XB_TOPGEN], 1u);
            else XB_SPIN(xb_ld(&bar[XB_TOPGEN]) == tg, bar);
            __builtin_amdgcn_fence(__ATOMIC_ACQUIRE, "agent");
            xb_add(&bar[XB_XGEN(b.x)], 1u);
            asm volatile("s_waitcnt vmcnt(0)" ::: "memory");
        } else {
            XB_SPIN(xb_ld(&bar[XB_XGEN(b.x)]) == gen, bar);
            __builtin_amdgcn_fence(__ATOMIC_ACQUIRE, "agent");
            asm volatile("s_waitcnt vmcnt(0)" ::: "memory");
        }
    }
    __syncthreads();
}

#ifndef SUBREP
#define SUBREP 0u
#endif
#define SUBN(b) ((((SUBREP) >> (b)) & 1u) ? 2 : 1)
constexpr int LSTR = 136;
__device__ __forceinline__ int k1_chan(int g, int ch8) { return ch8 < 48 ? 384 * g + 8 * ch8 : (ch8 < 64 ? SSDW + 128 * g + 8 * (ch8 - 48) : SSDW + 512 + 128 * g + 8 * (ch8 - 64)); }

__device__ __forceinline__ void k1_phase(const Args& a, int l, LAS unsigned char* lds, int G) {
    unsigned char* ws_ = a.ws; asm volatile("" : "+s"(ws_));
    int tid_ = threadIdx.x; asm volatile("" : "+v"(tid_)); const int tid = tid_, lane = tid & 63, wave = __builtin_amdgcn_readfirstlane(tid >> 6), q = lane >> 4, fr = lane & 15;
    const bf16* P = (const bf16*)(ws_ + WS_P); const float* DT = (const float*)(ws_ + WS_DT);
    bf16* XC = (bf16*)(ws_ + WS_XC); float* DTB = (float*)(ws_ + WS_DTB); float* CSB = (float*)(ws_ + WS_CSB);
    float* S = (float*)(ws_ + WS_S); float* DEC = (float*)(ws_ + WS_DEC);
    const float* cw = a.in[15] + (size_t)l * 4 * XBCW; const float* cb = a.in[16] + (size_t)l * XBCW;
    const float* dtb = a.in[17] + l * NH; const float* alog = a.in[18] + l * NH;
    LAS bf16* xdT = (LAS bf16*)lds;
    LAS bf16* BT = (LAS bf16*)(lds + 6 * 64 * LSTR * 2);
    LAS float* csL = (LAS float*)(lds + 6 * 64 * LSTR * 2 + 128 * LSTR * 2);
    LAS float* scL = csL + 6 * 128;
    for (int u = blockIdx.x; u < NBP * NCH * NG; u += G) {
        const int b = u >> 6, c = (u >> 2) & 15, g = u & 3, r0 = b * SEQ + c * 128;
        if (wave < HPG) {
            const int h = HPG * g + wave; const float A = -__expf(alog[h]), bias = dtb[h];
            const int t0 = 2 * lane;
            const float d0 = softplus_f(DT[(size_t)(r0 + t0) * 32 + h] + bias), d1 = softplus_f(DT[(size_t)(r0 + t0 + 1) * 32 + h] + bias);
            const float a0 = d0 * A, a1 = d1 * A; float s = a0 + a1;
#pragma unroll
            for (int o = 1; o < 64; o <<= 1) { const float t = __shfl_up(s, o); if (lane >= o) s += t; }
            const float cs1 = s, cs0 = s - a1, tot = __shfl(s, 63);
            csL[wave * 128 + t0] = cs0; csL[wave * 128 + t0 + 1] = cs1;
            scL[wave * 128 + t0] = d0 * __expf(tot - cs0); scL[wave * 128 + t0 + 1] = d1 * __expf(tot - cs1);
            DTB[(size_t)(r0 + t0) * NH + h] = d0; DTB[(size_t)(r0 + t0 + 1) * NH + h] = d1;
            CSB[(size_t)(r0 + t0) * NH + h] = cs0; CSB[(size_t)(r0 + t0 + 1) * NH + h] = cs1;
            if (lane == 0) DEC[(b * NCH + c) * NH + h] = __expf(tot);
        }
        __syncthreads();
        for (int it = tid; it < 80 * 16; it += NTHR) {
            const int ch8 = it % 80, tt0 = (it / 80) * 8, j0 = k1_chan(g, ch8);
            float w[4][8], bb[8];
#pragma unroll
            for (int i = 0; i < 4; ++i) { const f32x4 w0 = *(const f32x4*)(cw + i * XBCW + j0), w1 = *(const f32x4*)(cw + i * XBCW + j0 + 4);
#pragma unroll
                for (int j = 0; j < 4; ++j) { w[i][j] = w0[j]; w[i][4 + j] = w1[j]; } }
            { const f32x4 b0 = *(const f32x4*)(cb + j0), b1 = *(const f32x4*)(cb + j0 + 4);
#pragma unroll
              for (int j = 0; j < 4; ++j) { bb[j] = b0[j]; bb[4 + j] = b1[j]; } }
            float xm3[8], xm2[8], xm1[8];
            const bf16* src = P + (size_t)(r0 + tt0) * PW + 2048 + j0;
            const bool has_prev = (c * 128 + tt0) > 0;
            if (has_prev) { unpack8(*(const u32x4*)(src - 3 * PW), xm3); unpack8(*(const u32x4*)(src - 2 * PW), xm2); unpack8(*(const u32x4*)(src - PW), xm1); }
            else {
#pragma unroll
                for (int j = 0; j < 8; ++j) { xm3[j] = 0.f; xm2[j] = 0.f; xm1[j] = 0.f; } }
#pragma unroll
            for (int t = 0; t < 8; ++t) {
                float cur[8], o[8]; unpack8(*(const u32x4*)(src + (size_t)t * PW), cur);
#pragma unroll
                for (int j = 0; j < 8; ++j) o[j] = silu_f(bb[j] + w[0][j] * xm3[j] + w[1][j] * xm2[j] + w[2][j] * xm1[j] + w[3][j] * cur[j]);
                *(u32x4*)(XC + (size_t)(r0 + tt0 + t) * XBCW + j0) = pack8(o);
                const int tt = tt0 + t;
                if (ch8 < 48) { const int hh = ch8 >> 3, p0 = 8 * (ch8 & 7); const float sc = scL[hh * 128 + tt];
#pragma unroll
                    for (int j = 0; j < 8; ++j) xdT[(hh * 64 + p0 + j) * LSTR + tt] = f2bf(o[j] * sc);
                } else if (ch8 < 64) { const int n0 = 8 * (ch8 - 48);
#pragma unroll
                    for (int j = 0; j < 8; ++j) BT[(n0 + j) * LSTR + tt] = f2bf(o[j]); }
#pragma unroll
                for (int j = 0; j < 8; ++j) { xm3[j] = xm2[j]; xm2[j] = xm1[j]; xm1[j] = cur[j]; }
            }
        }
        if (c == NCH - 1) {
            float* o = a.out + O_CP + ((size_t)l * NBP + b) * 3 * XBCW;
            for (int it = tid; it < 3 * 640; it += NTHR) { const int i = it / 640, cc = it % 640, j = k1_chan(g, cc >> 3) + (cc & 7);
                o[i * XBCW + j] = bf1(P[(size_t)(r0 + 125 + i) * PW + 2048 + j]); }
        }
        __syncthreads();
#pragma unroll 1
        for (int hh = 0; hh < HPG; ++hh) {
            f32x4 acc[4];
#pragma unroll
            for (int pt = 0; pt < 4; ++pt) acc[pt] = (f32x4){0.f, 0.f, 0.f, 0.f};
#pragma unroll
            for (int ks = 0; ks < 4; ++ks) {
                const bf16x8 bfr = *(const LAS bf16x8*)(BT + (16 * wave + fr) * LSTR + 32 * ks + 8 * q);
#pragma unroll
                for (int pt = 0; pt < 4; ++pt) { const bf16x8 afr = *(const LAS bf16x8*)(xdT + (hh * 64 + 16 * pt + fr) * LSTR + 32 * ks + 8 * q);
                    acc[pt] = MFMA16(bfr, afr, acc[pt]); }
            }
            float* so = S + ((size_t)(b * NCH + c) * NH + HPG * g + hh) * (HD * DS) + 16 * wave + 4 * q;
#pragma unroll
            for (int pt = 0; pt < 4; ++pt) *(f32x4*)(so + (size_t)(16 * pt + fr) * DS) = acc[pt];
        }
        __syncthreads();
    }
    {
        const float* st = a.in[5] + (size_t)l * NBS * 3 * XBCW;
        float* oc = a.out + O_CS + (size_t)l * NBS * 3 * XBCW;
        for (int it = blockIdx.x * NTHR + tid; it < NBS * (XBCW / 8); it += G * NTHR) {
            const int bs = it / (XBCW / 8), j0 = (it % (XBCW / 8)) * 8, rs0 = NPR + 4 * bs;
            float full[7][8];
#pragma unroll
            for (int i = 0; i < 3; ++i) { const f32x4 p0 = *(const f32x4*)(st + ((size_t)bs * 3 + i) * XBCW + j0), p1 = *(const f32x4*)(st + ((size_t)bs * 3 + i) * XBCW + j0 + 4);
#pragma unroll
                for (int j = 0; j < 4; ++j) { full[i][j] = p0[j]; full[i][4 + j] = p1[j]; } }
#pragma unroll
            for (int t = 0; t < 4; ++t) unpack8(*(const u32x4*)(P + (size_t)(rs0 + t) * PW + 2048 + j0), full[3 + t]);
            float w[4][8], bb[8];
#pragma unroll
            for (int i = 0; i < 4; ++i) { const f32x4 w0 = *(const f32x4*)(cw + i * XBCW + j0), w1 = *(const f32x4*)(cw + i * XBCW + j0 + 4);
#pragma unroll
                for (int j = 0; j < 4; ++j) { w[i][j] = w0[j]; w[i][4 + j] = w1[j]; } }
            { const f32x4 b0 = *(const f32x4*)(cb + j0), b1 = *(const f32x4*)(cb + j0 + 4);
#pragma unroll
              for (int j = 0; j < 4; ++j) { bb[j] = b0[j]; bb[4 + j] = b1[j]; } }
#pragma unroll
            for (int t = 0; t < 4; ++t) { float o[8];
#pragma unroll
                for (int j = 0; j < 8; ++j) o[j] = silu_f(bb[j] + w[0][j] * full[t][j] + w[1][j] * full[t + 1][j] + w[2][j] * full[t + 2][j] + w[3][j] * full[t + 3][j]);
                *(u32x4*)(XC + (size_t)(rs0 + t) * XBCW + j0) = pack8(o); }
#pragma unroll
            for (int i = 0; i < 3; ++i) { float* o = oc + ((size_t)bs * 3 + i) * XBCW + j0;
                *(f32x4*)o = (f32x4){full[4 + i][0], full[4 + i][1], full[4 + i][2], full[4 + i][3]}; *(f32x4*)(o + 4) = (f32x4){full[4 + i][4], full[4 + i][5], full[4 + i][6], full[4 + i][7]}; }
        }
        for (int it = blockIdx.x * NTHR + tid; it < NSR * NH; it += G * NTHR) { const int r = NPR + it / NH, h = it % NH;
            DTB[(size_t)r * NH + h] = softplus_f(DT[(size_t)r * 32 + h] + dtb[h]); }
    }
}

__device__ __forceinline__ void k2_phase(const Args& a, int l, int G) {
    unsigned char* ws_ = a.ws; asm volatile("" : "+s"(ws_));
    int tid_ = threadIdx.x; asm volatile("" : "+v"(tid_)); const int tid = tid_, lane = tid & 63, wave = tid >> 6, q = lane >> 4, fr = lane & 15;
    const float* S = (const float*)(ws_ + WS_S); const float* DEC = (const float*)(ws_ + WS_DEC); bf16* HS = (bf16*)(ws_ + WS_HS);
    for (int sr_ = 0; sr_ < SUBN(0); ++sr_)
    for (int it = blockIdx.x * NTHR + tid; it < NBP * NH * (HD * DS / 4); it += G * NTHR) {
        const int bh = it / (HD * DS / 4), e = (it % (HD * DS / 4)) * 4, b = bh / NH, h = bh % NH;
        const size_t o0 = ((size_t)(b * NCH) * NH + h) * (HD * DS) + e; constexpr size_t cstr = (size_t)NH * HD * DS;
        f32x4 sv[NCH]; float dv[NCH];
#pragma unroll
        for (int c = 0; c < NCH; ++c) { sv[c] = *(const f32x4*)(S + o0 + c * cstr); dv[c] = DEC[(b * NCH + c) * NH + h]; }
        f32x4 H = (f32x4){0.f, 0.f, 0.f, 0.f};
#pragma unroll
        for (int c = 0; c < NCH; ++c) { u32x2 w; w.x = pk2(H[0], H[1]); w.y = pk2(H[2], H[3]); *(u32x2*)(HS + o0 + c * cstr) = w; H = H * dv[c] + sv[c]; }
        *(f32x4*)(a.out + O_SP + (((size_t)l * NBP + b) * NH + h) * (HD * DS) + e) = H;
    }
    const bf16* XC = (const bf16*)(ws_ + WS_XC); const bf16* P = (const bf16*)(ws_ + WS_P); const float* DTB = (const float*)(ws_ + WS_DTB);
    bf16* MIX = (bf16*)(ws_ + WS_MIX); float* SSQ2 = (float*)(ws_ + WS_SSQ2);
    const float* alog = a.in[18] + l * NH; const float* dsk = a.in[19] + l * NH;
    for (int sr_ = 0; sr_ < SUBN(1); ++sr_)
    for (int u = blockIdx.x * NWAVES + wave; u < NBS * NH * 4; u += G * NWAVES) {
        const int pt = u & 3, bh = u >> 2, bs = bh / NH, h = bh % NH, g = h / HPG, rs0 = NPR + 4 * bs;
        const int p = 16 * pt + fr;
        const float* h0 = a.in[6] + (((size_t)l * NBS + bs) * NH + h) * (HD * DS) + (size_t)p * DS + 8 * q;
        f32x4 hv0[4], hv1[4];
#pragma unroll
        for (int ks = 0; ks < 4; ++ks) { hv0[ks] = *(const f32x4*)(h0 + 32 * ks); hv1[ks] = *(const f32x4*)(h0 + 32 * ks + 4); }
        const float A = -__expf(alog[h]), Dh = dsk[h];
        float dt[4], cs[4]; { float s = 0.f;
#pragma unroll
            for (int t = 0; t < 4; ++t) { dt[t] = DTB[(size_t)(rs0 + t) * NH + h]; s += dt[t] * A; cs[t] = s; } }
        bf16x8 cfr[4]; u32x4 brow[4];
#pragma unroll
        for (int ks = 0; ks < 4; ++ks) { u32x4 z = (u32x4){0u, 0u, 0u, 0u}, zb = z;
            if (fr < 4) { z = *(const u32x4*)(XC + (size_t)(rs0 + fr) * XBCW + SSDW + 512 + 128 * g + 32 * ks + 8 * q); zb = *(const u32x4*)(XC + (size_t)(rs0 + fr) * XBCW + SSDW + 128 * g + 32 * ks + 8 * q); }
            cfr[ks] = as_frag(z); brow[ks] = zb; }
        float xs[4];
#pragma unroll
        for (int s = 0; s < 4; ++s) xs[s] = bf1(XC[(size_t)(rs0 + s) * XBCW + h * HD + p]);
        f32x4 cb4 = (f32x4){0.f, 0.f, 0.f, 0.f};
#pragma unroll
        for (int ks = 0; ks < 4; ++ks) cb4 = MFMA16(cfr[ks], as_frag(brow[ks]), cb4);
        float Wm[4][4];
#pragma unroll
        for (int t = 0; t < 4; ++t)
#pragma unroll
            for (int s = 0; s < 4; ++s) Wm[t][s] = (s <= t) ? __int_as_float(__builtin_amdgcn_readlane(__float_as_int(cb4[t]), s)) * __expf(cs[t] - cs[s]) * dt[s] : 0.f;
        float cx[4];
#pragma unroll
        for (int s = 0; s < 4; ++s) cx[s] = dt[s] * __expf(cs[3] - cs[s]) * xs[s];
        const float e3 = __expf(cs[3]);
        float* hn = a.out + O_SS + (((size_t)l * NBS + bs) * NH + h) * (HD * DS) + (size_t)p * DS + 8 * q;
        f32x4 yo = (f32x4){0.f, 0.f, 0.f, 0.f};
#pragma unroll
        for (int ks = 0; ks < 4; ++ks) {
            float hv[8] = {hv0[ks][0], hv0[ks][1], hv0[ks][2], hv0[ks][3], hv1[ks][0], hv1[ks][1], hv1[ks][2], hv1[ks][3]}, nv[8];
#pragma unroll
            for (int j = 0; j < 8; ++j) nv[j] = e3 * hv[j];
#pragma unroll
            for (int s = 0; s < 4; ++s) { u32x4 bw; bw.x = __shfl(brow[ks].x, 16 * q + s); bw.y = __shfl(brow[ks].y, 16 * q + s); bw.z = __shfl(brow[ks].z, 16 * q + s); bw.w = __shfl(brow[ks].w, 16 * q + s);
                float bvv[8]; unpack8(bw, bvv);
#pragma unroll
                for (int j = 0; j < 8; ++j) nv[j] += cx[s] * bvv[j]; }
            *(f32x4*)(hn + 32 * ks) = (f32x4){nv[0], nv[1], nv[2], nv[3]}; *(f32x4*)(hn + 32 * ks + 4) = (f32x4){nv[4], nv[5], nv[6], nv[7]};
            yo = MFMA16(cfr[ks], as_frag(pack8(hv)), yo);
        }
        float ysq[4];
#pragma unroll
        for (int t = 0; t < 4; ++t) {
            float y = __expf(cs[t]) * yo[t] + Dh * xs[t];
#pragma unroll
            for (int s = 0; s < 4; ++s) if (s <= t) y += Wm[t][s] * xs[s];
            const float z = bf1(P[(size_t)(rs0 + t) * PW + POOLW + h * HD + p]);
            const float yg = y * silu_f(z);
            if (lane < 16) MIX[(size_t)(rs0 + t) * DM + POOLW + h * HD + p] = f2bf(yg);
            ysq[t] = lane < 16 ? yg * yg : 0.f;
        }
#pragma unroll
        for (int t = 0; t < 4; ++t) { float s = ysq[t]; s += __shfl_xor(s, 1); s += __shfl_xor(s, 2); s += __shfl_xor(s, 4); s += __shfl_xor(s, 8);
            if (lane == 0) SSQ2[(size_t)(rs0 - NPR + t) * (NH * 4) + h * 4 + pt] = s; }
    }
}

__device__ __forceinline__ void k3_phase(const Args& a, int l, LAS unsigned char* lds, int G) {
    unsigned char* ws_ = a.ws; asm volatile("" : "+s"(ws_));
    int tid_ = threadIdx.x; asm volatile("" : "+v"(tid_)); const int tid = tid_, lane = tid & 63, wave = __builtin_amdgcn_readfirstlane(tid >> 6), q = lane >> 4, fr = lane & 15;
    const bf16* XC = (const bf16*)(ws_ + WS_XC); const bf16* P = (const bf16*)(ws_ + WS_P);
    const float* DTB = (const float*)(ws_ + WS_DTB); const float* CSB = (const float*)(ws_ + WS_CSB); const bf16* HS = (const bf16*)(ws_ + WS_HS);
    bf16* MIX = (bf16*)(ws_ + WS_MIX); float* SSQ = (float*)(ws_ + WS_SSQ);
    const float* dsk = a.in[19] + l * NH;
    LAS bf16* Cs = (LAS bf16*)lds;
    LAS bf16* Bs = Cs + 128 * LSTR;
    LAS bf16* xT = Bs + 128 * LSTR;
    LAS bf16* Ms = xT + 64 * LSTR;
    LAS float* csL = (LAS float*)(Ms + 8 * 16 * LSTR);
    LAS float* dtL = csL + 6 * 128;
    for (int u = blockIdx.x; u < NBP * NCH * NG; u += G) {
        const int b = u >> 6, c = (u >> 2) & 15, g = u & 3, r0 = b * SEQ + c * 128;
        for (int it = tid; it < 2 * 128 * 16; it += NTHR) { const int m = it >> 11, row = (it >> 4) & 127, k8 = (it & 15) * 8;
            const u32x4 v = *(const u32x4*)(XC + (size_t)(r0 + row) * XBCW + SSDW + (m ? 0 : 512) + 128 * g + k8);
            *(LAS u32x4*)((m ? Bs : Cs) + row * LSTR + k8) = v; }
        for (int it = tid; it < 6 * 128; it += NTHR) { const int hh = it >> 7, t = it & 127;
            csL[it] = CSB[(size_t)(r0 + t) * NH + HPG * g + hh]; dtL[it] = DTB[(size_t)(r0 + t) * NH + HPG * g + hh]; }
        __syncthreads();
        bf16x8 cf[4];
#pragma unroll
        for (int ks = 0; ks < 4; ++ks) cf[ks] = *(const LAS bf16x8*)(Cs + (16 * wave + fr) * LSTR + 32 * ks + 8 * q);
        f32x4 gacc[8];
#pragma unroll
        for (int st = 0; st < 8; ++st) { gacc[st] = (f32x4){0.f, 0.f, 0.f, 0.f};
            if (st <= wave) {
#pragma unroll
                for (int ks = 0; ks < 4; ++ks) { const bf16x8 bfr = *(const LAS bf16x8*)(Bs + (16 * st + fr) * LSTR + 32 * ks + 8 * q); gacc[st] = MFMA16(bfr, cf[ks], gacc[st]); } } }
        const int lrow = 16 * wave + fr;
#pragma unroll 1
        for (int hh = 0; hh < HPG; ++hh) {
            const int h = HPG * g + hh;
            for (int it = tid; it < 128 * 8; it += NTHR) { const int s = it >> 3, p8 = (it & 7) * 8; float xv[8];
                unpack8(*(const u32x4*)(XC + (size_t)(r0 + s) * XBCW + h * HD + p8), xv);
#pragma unroll
                for (int j = 0; j < 8; ++j) xT[(p8 + j) * LSTR + s] = f2bf(xv[j]); }
            const float csl = csL[hh * 128 + lrow];
#pragma unroll
            for (int st = 0; st < 8; ++st) {
                if (st <= (wave | 1)) { float mv[4];
#pragma unroll
                    for (int r = 0; r < 4; ++r) { const int s = 16 * st + 4 * q + r;
                        mv[r] = (st <= wave && s <= lrow) ? gacc[st][r] * __expf(csl - csL[hh * 128 + s]) * dtL[hh * 128 + s] : 0.f; }
                    u32x2 w; w.x = pk2(mv[0], mv[1]); w.y = pk2(mv[2], mv[3]);
                    *(LAS u32x2*)(Ms + (wave * 16 + fr) * LSTR + 16 * st + 4 * q) = w; } }
            __syncthreads();
            f32x4 y1[4], y2[4];
#pragma unroll
            for (int pt = 0; pt < 4; ++pt) { y1[pt] = (f32x4){0.f, 0.f, 0.f, 0.f}; y2[pt] = (f32x4){0.f, 0.f, 0.f, 0.f}; }
            const bf16* hs = HS + ((size_t)(b * NCH + c) * NH + h) * (HD * DS);
#pragma unroll
            for (int ks = 0; ks < 4; ++ks) {
                if (2 * ks <= wave) { const bf16x8 mfr = *(const LAS bf16x8*)(Ms + (wave * 16 + fr) * LSTR + 32 * ks + 8 * q);
#pragma unroll
                    for (int pt = 0; pt < 4; ++pt) { const bf16x8 xfr = *(const LAS bf16x8*)(xT + (16 * pt + fr) * LSTR + 32 * ks + 8 * q); y1[pt] = MFMA16(xfr, mfr, y1[pt]); } }
#pragma unroll
                for (int pt = 0; pt < 4; ++pt) { const bf16x8 hfr = as_frag(*(const u32x4*)(hs + (size_t)(16 * pt + fr) * DS + 32 * ks + 8 * q)); y2[pt] = MFMA16(hfr, cf[ks], y2[pt]); }
            }
            const float ecs = __expf(csl), Dh = dsk[h]; const int row = r0 + lrow; float ss = 0.f;
#pragma unroll
            for (int pt = 0; pt < 4; ++pt) { const int p0 = 16 * pt + 4 * q;
                const u32x2 xw = *(const u32x2*)(XC + (size_t)row * XBCW + h * HD + p0), zw = *(const u32x2*)(P + (size_t)row * PW + POOLW + h * HD + p0);
                const float xv[4] = {bflo(xw.x), bfhi(xw.x), bflo(xw.y), bfhi(xw.y)}, zv[4] = {bflo(zw.x), bfhi(zw.x), bflo(zw.y), bfhi(zw.y)}; float yg[4];
#pragma unroll
                for (int r = 0; r < 4; ++r) { const float y = y1[pt][r] + ecs * y2[pt][r] + Dh * xv[r]; yg[r] = y * silu_f(zv[r]); ss += yg[r] * yg[r]; }
                u32x2 w; w.x = pk2(yg[0], yg[1]); w.y = pk2(yg[2], yg[3]);
                *(u32x2*)(MIX + (size_t)row * DM + POOLW + h * HD + p0) = w; }
            ss += __shfl_xor(ss, 16); ss += __shfl_xor(ss, 32);
            if (q == 0) SSQ[(size_t)row * NH + h] = ss;
            __syncthreads();
        }
    }
}

template <int W> __device__ __forceinline__ float pool_window(const bf16* P, const float* stp, bool prompt, int row, int ch, float (&sum)[8]) {
    if (prompt) { const int pos = row & (SEQ - 1);
#pragma unroll
        for (int i = 1; i < W; ++i) { const bool ok = i <= pos; float v[8]; unpack8(*(const u32x4*)(P + (size_t)(ok ? row - i : row) * PW + ch), v);
#pragma unroll
            for (int j = 0; j < 8; ++j) sum[j] += ok ? v[j] : 0.f; }
        return (float)((pos + 1 < W) ? pos + 1 : W);
    } else { const int seq = (row - NPR) >> 2, t4 = (row - NPR) & 3;
#pragma unroll
        for (int i = 1; i < W; ++i) { float v[8];
            if (t4 - i >= 0) unpack8(*(const u32x4*)(P + (size_t)(row - i) * PW + ch), v);
            else { const float* sp = stp + ((size_t)seq * 15 + (15 + t4 - i)) * POOLW + ch; const f32x4 v0 = *(const f32x4*)sp, v1 = *(const f32x4*)(sp + 4);
                v[0] = v0[0]; v[1] = v0[1]; v[2] = v0[2]; v[3] = v0[3]; v[4] = v1[0]; v[5] = v1[1]; v[6] = v1[2]; v[7] = v1[3]; }
#pragma unroll
            for (int j = 0; j < 8; ++j) sum[j] += v[j]; }
        return (float)W;
    }
}
__device__ __forceinline__ void pool_phase(const Args& a, int l, int G) {
    unsigned char* ws_ = a.ws; asm volatile("" : "+s"(ws_));
    int tid_ = threadIdx.x; asm volatile("" : "+v"(tid_)); const int tid = tid_, lane = tid & 63, wave = __builtin_amdgcn_readfirstlane(tid >> 6), q = lane >> 4, fr = lane & 15;
    const bf16* P = (const bf16*)(ws_ + WS_P); const bf16* PWT = (const bf16*)(ws_ + WS_PWT + l * SZ_PWT);
    bf16* MIX = (bf16*)(ws_ + WS_MIX); const float* SSQ = (const float*)(ws_ + WS_SSQ); const float* SSQ2 = (const float*)(ws_ + WS_SSQ2); float* R = (float*)(ws_ + WS_R);
    const float* stp = a.in[4] + (size_t)l * NBS * 15 * POOLW;
    for (int sr_ = 0; sr_ < SUBN(2); ++sr_)
    for (int u = blockIdx.x * NWAVES + wave; u < (MROWS / 16) * 4; u += G * NWAVES) {
        const int rb = u >> 2, g = u & 3, row = 16 * rb + fr; const bool prompt = rb < NPR / 16;
        float ssum = 0.f;
        if (prompt) {
#pragma unroll
            for (int i = 0; i < 6; ++i) { const f32x4 v = *(const f32x4*)(SSQ + (size_t)row * NH + 4 * i); ssum += (v[0] + v[1]) + (v[2] + v[3]); }
        } else {
#pragma unroll
            for (int i = 0; i < 24; ++i) { const f32x4 v = *(const f32x4*)(SSQ2 + (size_t)(row - NPR) * (NH * 4) + 4 * i); ssum += (v[0] + v[1]) + (v[2] + v[3]); }
        }
        const float rr = sqrtf(ssum * (1.f / SSDW) + EPS);
        if (g == 0 && q == 0) R[row] = 1.f / rr;
        f32x4 acc[8];
#pragma unroll
        for (int nt = 0; nt < 8; ++nt) acc[nt] = (f32x4){0.f, 0.f, 0.f, 0.f};
#pragma unroll 1
        for (int ks = 0; ks < 4; ++ks) {
            const int ch = 128 * g + 32 * ks + 8 * q; float sum[8], cur[8];
            unpack8(*(const u32x4*)(P + (size_t)row * PW + ch), cur);
#pragma unroll
            for (int j = 0; j < 8; ++j) sum[j] = cur[j];
            float cnt;
            if (g == 0) cnt = pool_window<2>(P, stp, prompt, row, ch, sum); else if (g == 1) cnt = pool_window<4>(P, stp, prompt, row, ch, sum);
            else if (g == 2) cnt = pool_window<8>(P, stp, prompt, row, ch, sum); else cnt = pool_window<16>(P, stp, prompt, row, ch, sum);
            const float ic = 1.f / cnt; float d[8];
#pragma unroll
            for (int j = 0; j < 8; ++j) d[j] = sum[j] * ic - cur[j];
            const bf16x8 dfr = as_frag(pack8(d));
#pragma unroll
            for (int nt = 0; nt < 8; ++nt) { const bf16x8 wfr = as_frag(*(const u32x4*)(PWT + ((size_t)g * 128 + 16 * nt + fr) * 128 + 32 * ks + 8 * q)); acc[nt] = MFMA16(wfr, dfr, acc[nt]); }
        }
#pragma unroll
        for (int nt = 0; nt < 8; ++nt) { u32x2 o; o.x = pk2(acc[nt][0] * rr, acc[nt][1] * rr); o.y = pk2(acc[nt][2] * rr, acc[nt][3] * rr);
            *(u32x2*)(MIX + (size_t)row * DM + 128 * g + 16 * nt + 4 * q) = o; }
    }
    for (int sr_ = 0; sr_ < SUBN(3); ++sr_)
    { float* o = a.out + O_PP + (size_t)l * NBP * 15 * POOLW;
      for (int it = blockIdx.x * NTHR + tid; it < NBP * 15 * POOLW; it += G * NTHR) { const int b = it / (15 * POOLW), i = (it / POOLW) % 15, cc = it % POOLW;
          o[it] = bf1(P[(size_t)(b * SEQ + SEQ - 15 + i) * PW + cc]); }
      float* os = a.out + O_PS + (size_t)l * NBS * 15 * POOLW;
      for (int it = blockIdx.x * NTHR + tid; it < NBS * 15 * POOLW; it += G * NTHR) { const int bs = it / (15 * POOLW), i = (it / POOLW) % 15, cc = it % POOLW;
          os[it] = i < 11 ? stp[((size_t)bs * 15 + i + 4) * POOLW + cc] : bf1(P[(size_t)(NPR + 4 * bs + i - 11) * PW + cc]); } }
}

__device__ __forceinline__ void ld8(const float* p, float (&d)[8]) { const f32x4 x = *(const f32x4*)p, y = *(const f32x4*)(p + 4); d[0] = x[0]; d[1] = x[1]; d[2] = x[2]; d[3] = x[3]; d[4] = y[0]; d[5] = y[1]; d[6] = y[2]; d[7] = y[3]; }
__device__ __forceinline__ void fx_phase(const Args& a, int l, int G) {
    unsigned char* ws_ = a.ws; asm volatile("" : "+s"(ws_));
    int tid_ = threadIdx.x; asm volatile("" : "+v"(tid_)); const int tid = tid_;
    bf16* ACT = (bf16*)(ws_ + WS_ACT); const float* GH = (const float*)(ws_ + WS_GH); const float* VH = (const float*)(ws_ + WS_VH);
    const float* fw = a.in[23] + (size_t)l * 3 * DFF; const float* fb = a.in[24] + (size_t)l * DFF;
    for (int it = blockIdx.x * NTHR + tid; it < 28 * (DFF / 8); it += G * NTHR) {
        const int ti = it / (DFF / 8), j0 = (it % (DFF / 8)) * 8, pm = (ti / 7) * 8 + 1 + ti % 7;
        float w[3][8], bb[8], gm2[8], gm1[8], g0[8], g1[8], v0[8], v1[8];
        ld8(fw + j0, w[0]); ld8(fw + DFF + j0, w[1]); ld8(fw + 2 * DFF + j0, w[2]); ld8(fb + j0, bb);
        ld8(GH + ((size_t)(pm - 1) * 4 + 2) * DFF + j0, gm2); ld8(GH + ((size_t)(pm - 1) * 4 + 3) * DFF + j0, gm1);
        ld8(GH + ((size_t)pm * 4 + 0) * DFF + j0, g0); ld8(GH + ((size_t)pm * 4 + 1) * DFF + j0, g1);
        ld8(VH + ((size_t)pm * 2 + 0) * DFF + j0, v0); ld8(VH + ((size_t)pm * 2 + 1) * DFF + j0, v1);
        float o0[8], o1[8];
#pragma unroll
        for (int j = 0; j < 8; ++j) { o0[j] = silu_f(bb[j] + w[0][j] * gm2[j] + w[1][j] * gm1[j] + w[2][j] * g0[j]) * v0[j];
                                      o1[j] = silu_f(bb[j] + w[0][j] * gm1[j] + w[1][j] * g0[j] + w[2][j] * g1[j]) * v1[j]; }
        *(u32x4*)(ACT + (size_t)(pm * 256) * DFF + j0) = pack8(o0); *(u32x4*)(ACT + (size_t)(pm * 256 + 1) * DFF + j0) = pack8(o1);
    }
}

constexpr int PH_P0A = 0, PH_P0B = 1, PH_L0 = 2, PH_PER_LAYER = 11, PH_FINAL = PH_L0 + DEPTH * PH_PER_LAYER, N_PHASES = PH_FINAL + 1;
#ifndef N_LAUNCH_MODE
#define N_LAUNCH_MODE 1
#endif

__device__ __forceinline__ int grid_size() { int g = gridDim.x; asm volatile("" : "+s"(g)); return g; }
__global__ void __launch_bounds__(NTHR, 2) fwd_kernel(Args a) {
    extern __shared__ __attribute__((aligned(16))) unsigned char lds_raw[];
    LAS unsigned char* lds = (LAS unsigned char*)lds_raw;
    const int tid = threadIdx.x;
#define G grid_size()
    volatile LAS unsigned* misc = (volatile LAS unsigned*)(lds + LDS_MISC);
    if (tid < 64) misc[tid] = 0u;
    __syncthreads();
    XcdBarrier bar; bar.bar = (unsigned*)(a.ws + WS_CTL) + CW_BAR; bar.x = 0; bar.st = misc + 8;
    const int lo = a.ph_lo, hi = a.ph_hi;
    if (hi - lo > 1) bar = xcd_barrier_post((unsigned*)(a.ws + WS_CTL) + CW_BAR, misc + 8);
#ifndef PH_MASK
#define PH_MASK 0xFFFFFFFFu
#endif
#define EN(b) (((PH_MASK) >> (b)) & 1u)
#ifndef REP_MASK
#define REP_MASK 0u
#endif
#define NREP(b) ((((REP_MASK) >> (b)) & 1u) ? 2 : 1)
#define IN(k) (lo <= (k) && (k) < hi)
#define SEAM(k) do { if ((k) + 1 < hi) xcd_barrier(bar); } while (0)
#define WSBASE ({ unsigned char* w_ = a.ws; asm volatile("" : "+s"(w_)); w_; })
#define WSP(T, off) ((T*)(WSBASE + (off)))
#define LDSL ({ LAS unsigned char* l_ = lds; asm volatile("" : "+s"(l_)); l_; })

    for (int rep_ = 0; rep_ < NREP(0); ++rep_) if (EN(0) && IN(PH_P0A)) { p0a_phase(a, LDSL, G); SEAM(PH_P0A); }
    for (int rep_ = 0; rep_ < NREP(1); ++rep_) if (EN(1) && IN(PH_P0B)) { p0b_phase(a, LDSL, G); SEAM(PH_P0B); }

    { constexpr int l = 0;
        const int pb = PH_L0 + l * PH_PER_LAYER;
#define MODL (WSP(const float, WS_MOD) + (size_t)l * NB * ADA)
#define XIN_P (l == 0 ? a.in[0] : WSP(const float, WS_XA))
#define XIN_S (l == 0 ? a.in[1] : WSP(const float, WS_XA) + (size_t)NPR * DM)
        for (int rep_ = 0; rep_ < NREP(2); ++rep_) if (EN(2) && IN(pb + 0)) { norm_phase(XIN_P, XIN_S, a.in[8] + l * DM, MODL, 0, WSP(bf16, WS_H), G); SEAM(pb + 0); }
        for (int rep_ = 0; rep_ < NREP(3); ++rep_) if (EN(3) && IN(pb + 1)) {
            pg8::Gemm g{WSP(const bf16, WS_H), (const bf16*)(WSBASE + WS_WIN + l * SZ_WIN), MROWS, NINP, DM}; pg8::StaticOrder S; S.init(MROWS, NINP, G, (int)blockIdx.x);
            EpiProj E{WSP(bf16, WS_P), WSP(float, WS_DT)};
            pg8::gemm_phase<EpiProj, pg8::StaticOrder, true, true>(LDSL, g, S, E);
            SEAM(pb + 1);
        }
        for (int rep_ = 0; rep_ < NREP(4); ++rep_) if (EN(4) && IN(pb + 2)) { k1_phase(a, l, LDSL, G); SEAM(pb + 2); }
        for (int rep_ = 0; rep_ < NREP(5); ++rep_) if (EN(5) && IN(pb + 3)) { k2_phase(a, l, G); SEAM(pb + 3); }
        for (int rep_ = 0; rep_ < NREP(6); ++rep_) if (EN(6) && IN(pb + 4)) { k3_phase(a, l, LDSL, G); SEAM(pb + 4); }
        for (int rep_ = 0; rep_ < NREP(7); ++rep_) if (EN(7) && IN(pb + 5)) { pool_phase(a, l, G); SEAM(pb + 5); }
        for (int rep_ = 0; rep_ < NREP(8); ++rep_) if (EN(8) && IN(pb + 6)) {
            pg8::Gemm g{WSP(const bf16, WS_MIX), (const bf16*)(WSBASE + WS_WOUT + l * SZ_WOUT), NPR, DM, DM}; pg8::StaticOrder S; S.init(NPR, DM, G, (int)blockIdx.x);
            EpiRes E{XIN_P, XIN_S, WSP(float, WS_XB), MODL + 2 * DM, WSP(const float, WS_R)};
            pg8::gemm_phase_x<EpiRes, pg8::StaticOrder>(LDSL, g, WSP(const bf16, WS_MIX) + (size_t)NPR * DM, S, E);
            SEAM(pb + 6);
        }
        for (int rep_ = 0; rep_ < NREP(9); ++rep_) if (EN(9) && IN(pb + 7)) { norm_phase(WSP(const float, WS_XB), WSP(const float, WS_XB) + (size_t)NPR * DM, a.in[9] + l * DM, MODL, 3, WSP(bf16, WS_H), G); SEAM(pb + 7); }
        for (int rep_ = 0; rep_ < NREP(10); ++rep_) if (EN(10) && IN(pb + 8)) {
            pg8::Gemm g{WSP(const bf16, WS_H), (const bf16*)(WSBASE + WS_WUP + l * SZ_WUP), MROWS, NUP, DM}; pg8::StaticOrder S; S.init(MROWS, NUP, G, (int)blockIdx.x);
            EpiAct E{WSP(bf16, WS_ACT), WSP(float, WS_GH), WSP(float, WS_VH), a.in[23] + (size_t)l * 3 * DFF, a.in[24] + (size_t)l * DFF, a.in[7] + (size_t)l * NBS * 2 * DFF,
                     a.out + O_FP + (size_t)l * NBP * 2 * DFF, a.out + O_FS + (size_t)l * NBS * 2 * DFF, (LAS float*)(LDSL + LDS_HALO), l};
            pg8::gemm_phase<EpiAct, pg8::StaticOrder, true, true>(LDSL, g, S, E);
            SEAM(pb + 8);
        }
        for (int rep_ = 0; rep_ < NREP(11); ++rep_) if (EN(11) && IN(pb + 9)) { fx_phase(a, l, G); SEAM(pb + 9); }
        for (int rep_ = 0; rep_ < NREP(12); ++rep_) if (EN(12) && IN(pb + 10)) {
            pg8::Gemm g{WSP(const bf16, WS_ACT), (const bf16*)(WSBASE + WS_WDN + l * SZ_WDN), NPR, DM, DFF}; pg8::StaticOrder S; S.init(NPR, DM, G, (int)blockIdx.x);
            EpiRes E{WSP(const float, WS_XB), WSP(const float, WS_XB) + (size_t)NPR * DM, WSP(float, WS_XA), MODL + 5 * DM, nullptr};
            pg8::gemm_phase_x<EpiRes, pg8::StaticOrder>(LDSL, g, WSP(const bf16, WS_ACT) + (size_t)NPR * DFF, S, E);
            SEAM(pb + 10);
        }
    }
    { constexpr int l = 1;
        const int pb = PH_L0 + l * PH_PER_LAYER;
#define MODL (WSP(const float, WS_MOD) + (size_t)l * NB * ADA)
#define XIN_P (l == 0 ? a.in[0] : WSP(const float, WS_XA))
#define XIN_S (l == 0 ? a.in[1] : WSP(const float, WS_XA) + (size_t)NPR * DM)
        for (int rep_ = 0; rep_ < NREP(2); ++rep_) if (EN(2) && IN(pb + 0)) { norm_phase(XIN_P, XIN_S, a.in[8] + l * DM, MODL, 0, WSP(bf16, WS_H), G); SEAM(pb + 0); }
        for (int rep_ = 0; rep_ < NREP(3); ++rep_) if (EN(3) && IN(pb + 1)) {
            pg8::Gemm g{WSP(const bf16, WS_H), (const bf16*)(WSBASE + WS_WIN + l * SZ_WIN), MROWS, NINP, DM}; pg8::StaticOrder S; S.init(MROWS, NINP, G, (int)blockIdx.x);
            EpiProj E{WSP(bf16, WS_P), WSP(float, WS_DT)};
            pg8::gemm_phase<EpiProj, pg8::StaticOrder, true, true>(LDSL, g, S, E);
            SEAM(pb + 1);
        }
        for (int rep_ = 0; rep_ < NREP(4); ++rep_) if (EN(4) && IN(pb + 2)) { k1_phase(a, l, LDSL, G); SEAM(pb + 2); }
        for (int rep_ = 0; rep_ < NREP(5); ++rep_) if (EN(5) && IN(pb + 3)) { k2_phase(a, l, G); SEAM(pb + 3); }
        for (int rep_ = 0; rep_ < NREP(6); ++rep_) if (EN(6) && IN(pb + 4)) { k3_phase(a, l, LDSL, G); SEAM(pb + 4); }
        for (int rep_ = 0; rep_ < NREP(7); ++rep_) if (EN(7) && IN(pb + 5)) { pool_phase(a, l, G); SEAM(pb + 5); }
        for (int rep_ = 0; rep_ < NREP(8); ++rep_) if (EN(8) && IN(pb + 6)) {
            pg8::Gemm g{WSP(const bf16, WS_MIX), (const bf16*)(WSBASE + WS_WOUT + l * SZ_WOUT), NPR, DM, DM}; pg8::StaticOrder S; S.init(NPR, DM, G, (int)blockIdx.x);
            EpiRes E{XIN_P, XIN_S, WSP(float, WS_XB), MODL + 2 * DM, WSP(const float, WS_R)};
            pg8::gemm_phase_x<EpiRes, pg8::StaticOrder>(LDSL, g, WSP(const bf16, WS_MIX) + (size_t)NPR * DM, S, E);
            SEAM(pb + 6);
        }
        for (int rep_ = 0; rep_ < NREP(9); ++rep_) if (EN(9) && IN(pb + 7)) { norm_phase(WSP(const float, WS_XB), WSP(const float, WS_XB) + (size_t)NPR * DM, a.in[9] + l * DM, MODL, 3, WSP(bf16, WS_H), G); SEAM(pb + 7); }
        for (int rep_ = 0; rep_ < NREP(10); ++rep_) if (EN(10) && IN(pb + 8)) {
            pg8::Gemm g{WSP(const bf16, WS_H), (const bf16*)(WSBASE + WS_WUP + l * SZ_WUP), MROWS, NUP, DM}; pg8::StaticOrder S; S.init(MROWS, NUP, G, (int)blockIdx.x);
            EpiAct E{WSP(bf16, WS_ACT), WSP(float, WS_GH), WSP(float, WS_VH), a.in[23] + (size_t)l * 3 * DFF, a.in[24] + (size_t)l * DFF, a.in[7] + (size_t)l * NBS * 2 * DFF,
                     a.out + O_FP + (size_t)l * NBP * 2 * DFF, a.out + O_FS + (size_t)l * NBS * 2 * DFF, (LAS float*)(LDSL + LDS_HALO), l};
            pg8::gemm_phase<EpiAct, pg8::StaticOrder, true, true>(LDSL, g, S, E);
            SEAM(pb + 8);
        }
        for (int rep_ = 0; rep_ < NREP(11); ++rep_) if (EN(11) && IN(pb + 9)) { fx_phase(a, l, G); SEAM(pb + 9); }
        for (int rep_ = 0; rep_ < NREP(12); ++rep_) if (EN(12) && IN(pb + 10)) {
            pg8::Gemm g{WSP(const bf16, WS_ACT), (const bf16*)(WSBASE + WS_WDN + l * SZ_WDN), NPR, DM, DFF}; pg8::StaticOrder S; S.init(NPR, DM, G, (int)blockIdx.x);
            EpiRes E{WSP(const float, WS_XB), WSP(const float, WS_XB) + (size_t)NPR * DM, WSP(float, WS_XA), MODL + 5 * DM, nullptr};
            pg8::gemm_phase_x<EpiRes, pg8::StaticOrder>(LDSL, g, WSP(const bf16, WS_ACT) + (size_t)NPR * DFF, S, E);
            SEAM(pb + 10);
        }
    }
    { constexpr int l = 2;
        const int pb = PH_L0 + l * PH_PER_LAYER;
#define MODL (WSP(const float, WS_MOD) + (size_t)l * NB * ADA)
#define XIN_P (l == 0 ? a.in[0] : WSP(const float, WS_XA))
#define XIN_S (l == 0 ? a.in[1] : WSP(const float, WS_XA) + (size_t)NPR * DM)
        for (int rep_ = 0; rep_ < NREP(2); ++rep_) if (EN(2) && IN(pb + 0)) { norm_phase(XIN_P, XIN_S, a.in[8] + l * DM, MODL, 0, WSP(bf16, WS_H), G); SEAM(pb + 0); }
        for (int rep_ = 0; rep_ < NREP(3); ++rep_) if (EN(3) && IN(pb + 1)) {
            pg8::Gemm g{WSP(const bf16, WS_H), (const bf16*)(WSBASE + WS_WIN + l * SZ_WIN), MROWS, NINP, DM}; pg8::StaticOrder S; S.init(MROWS, NINP, G, (int)blockIdx.x);
            EpiProj E{WSP(bf16, WS_P), WSP(float, WS_DT)};
            pg8::gemm_phase<EpiProj, pg8::StaticOrder, true, true>(LDSL, g, S, E);
            SEAM(pb + 1);
        }
        for (int rep_ = 0; rep_ < NREP(4); ++rep_) if (EN(4) && IN(pb + 2)) { k1_phase(a, l, LDSL, G); SEAM(pb + 2); }
        for (int rep_ = 0; rep_ < NREP(5); ++rep_) if (EN(5) && IN(pb + 3)) { k2_phase(a, l, G); SEAM(pb + 3); }
        for (int rep_ = 0; rep_ < NREP(6); ++rep_) if (EN(6) && IN(pb + 4)) { k3_phase(a, l, LDSL, G); SEAM(pb + 4); }
        for (int rep_ = 0; rep_ < NREP(7); ++rep_) if (EN(7) && IN(pb + 5)) { pool_phase(a, l, G); SEAM(pb + 5); }
        for (int rep_ = 0; rep_ < NREP(8); ++rep_) if (EN(8) && IN(pb + 6)) {
            pg8::Gemm g{WSP(const bf16, WS_MIX), (const bf16*)(WSBASE + WS_WOUT + l * SZ_WOUT), NPR, DM, DM}; pg8::StaticOrder S; S.init(NPR, DM, G, (int)blockIdx.x);
            EpiRes E{XIN_P, XIN_S, WSP(float, WS_XB), MODL + 2 * DM, WSP(const float, WS_R)};
            pg8::gemm_phase_x<EpiRes, pg8::StaticOrder>(LDSL, g, WSP(const bf16, WS_MIX) + (size_t)NPR * DM, S, E);
            SEAM(pb + 6);
        }
        for (int rep_ = 0; rep_ < NREP(9); ++rep_) if (EN(9) && IN(pb + 7)) { norm_phase(WSP(const float, WS_XB), WSP(const float, WS_XB) + (size_t)NPR * DM, a.in[9] + l * DM, MODL, 3, WSP(bf16, WS_H), G); SEAM(pb + 7); }
        for (int rep_ = 0; rep_ < NREP(10); ++rep_) if (EN(10) && IN(pb + 8)) {
            pg8::Gemm g{WSP(const bf16, WS_H), (const bf16*)(WSBASE + WS_WUP + l * SZ_WUP), MROWS, NUP, DM}; pg8::StaticOrder S; S.init(MROWS, NUP, G, (int)blockIdx.x);
            EpiAct E{WSP(bf16, WS_ACT), WSP(float, WS_GH), WSP(float, WS_VH), a.in[23] + (size_t)l * 3 * DFF, a.in[24] + (size_t)l * DFF, a.in[7] + (size_t)l * NBS * 2 * DFF,
                     a.out + O_FP + (size_t)l * NBP * 2 * DFF, a.out + O_FS + (size_t)l * NBS * 2 * DFF, (LAS float*)(LDSL + LDS_HALO), l};
            pg8::gemm_phase<EpiAct, pg8::StaticOrder, true, true>(LDSL, g, S, E);
            SEAM(pb + 8);
        }
        for (int rep_ = 0; rep_ < NREP(11); ++rep_) if (EN(11) && IN(pb + 9)) { fx_phase(a, l, G); SEAM(pb + 9); }
        for (int rep_ = 0; rep_ < NREP(12); ++rep_) if (EN(12) && IN(pb + 10)) {
            pg8::Gemm g{WSP(const bf16, WS_ACT), (const bf16*)(WSBASE + WS_WDN + l * SZ_WDN), NPR, DM, DFF}; pg8::StaticOrder S; S.init(NPR, DM, G, (int)blockIdx.x);
            EpiRes E{WSP(const float, WS_XB), WSP(const float, WS_XB) + (size_t)NPR * DM, WSP(float, WS_XA), MODL + 5 * DM, nullptr};
            pg8::gemm_phase_x<EpiRes, pg8::StaticOrder>(LDSL, g, WSP(const bf16, WS_ACT) + (size_t)NPR * DFF, S, E);
            SEAM(pb + 10);
        }
    }
    { constexpr int l = 3;
        const int pb = PH_L0 + l * PH_PER_LAYER;
#define MODL (WSP(const float, WS_MOD) + (size_t)l * NB * ADA)
#define XIN_P (l == 0 ? a.in[0] : WSP(const float, WS_XA))
#define XIN_S (l == 0 ? a.in[1] : WSP(const float, WS_XA) + (size_t)NPR * DM)
        for (int rep_ = 0; rep_ < NREP(2); ++rep_) if (EN(2) && IN(pb + 0)) { norm_phase(XIN_P, XIN_S, a.in[8] + l * DM, MODL, 0, WSP(bf16, WS_H), G); SEAM(pb + 0); }
        for (int rep_ = 0; rep_ < NREP(3); ++rep_) if (EN(3) && IN(pb + 1)) {
            pg8::Gemm g{WSP(const bf16, WS_H), (const bf16*)(WSBASE + WS_WIN + l * SZ_WIN), MROWS, NINP, DM}; pg8::StaticOrder S; S.init(MROWS, NINP, G, (int)blockIdx.x);
            EpiProj E{WSP(bf16, WS_P), WSP(float, WS_DT)};
            pg8::gemm_phase<EpiProj, pg8::StaticOrder, true, true>(LDSL, g, S, E);
            SEAM(pb + 1);
        }
        for (int rep_ = 0; rep_ < NREP(4); ++rep_) if (EN(4) && IN(pb + 2)) { k1_phase(a, l, LDSL, G); SEAM(pb + 2); }
        for (int rep_ = 0; rep_ < NREP(5); ++rep_) if (EN(5) && IN(pb + 3)) { k2_phase(a, l, G); SEAM(pb + 3); }
        for (int rep_ = 0; rep_ < NREP(6); ++rep_) if (EN(6) && IN(pb + 4)) { k3_phase(a, l, LDSL, G); SEAM(pb + 4); }
        for (int rep_ = 0; rep_ < NREP(7); ++rep_) if (EN(7) && IN(pb + 5)) { pool_phase(a, l, G); SEAM(pb + 5); }
        for (int rep_ = 0; rep_ < NREP(8); ++rep_) if (EN(8) && IN(pb + 6)) {
            pg8::Gemm g{WSP(const bf16, WS_MIX), (const bf16*)(WSBASE + WS_WOUT + l * SZ_WOUT), NPR, DM, DM}; pg8::StaticOrder S; S.init(NPR, DM, G, (int)blockIdx.x);
            EpiRes E{XIN_P, XIN_S, WSP(float, WS_XB), MODL + 2 * DM, WSP(const float, WS_R)};
            pg8::gemm_phase_x<EpiRes, pg8::StaticOrder>(LDSL, g, WSP(const bf16, WS_MIX) + (size_t)NPR * DM, S, E);
            SEAM(pb + 6);
        }
        for (int rep_ = 0; rep_ < NREP(9); ++rep_) if (EN(9) && IN(pb + 7)) { norm_phase(WSP(const float, WS_XB), WSP(const float, WS_XB) + (size_t)NPR * DM, a.in[9] + l * DM, MODL, 3, WSP(bf16, WS_H), G); SEAM(pb + 7); }
        for (int rep_ = 0; rep_ < NREP(10); ++rep_) if (EN(10) && IN(pb + 8)) {
            pg8::Gemm g{WSP(const bf16, WS_H), (const bf16*)(WSBASE + WS_WUP + l * SZ_WUP), MROWS, NUP, DM}; pg8::StaticOrder S; S.init(MROWS, NUP, G, (int)blockIdx.x);
            EpiAct E{WSP(bf16, WS_ACT), WSP(float, WS_GH), WSP(float, WS_VH), a.in[23] + (size_t)l * 3 * DFF, a.in[24] + (size_t)l * DFF, a.in[7] + (size_t)l * NBS * 2 * DFF,
                     a.out + O_FP + (size_t)l * NBP * 2 * DFF, a.out + O_FS + (size_t)l * NBS * 2 * DFF, (LAS float*)(LDSL + LDS_HALO), l};
            pg8::gemm_phase<EpiAct, pg8::StaticOrder, true, true>(LDSL, g, S, E);
            SEAM(pb + 8);
        }
        for (int rep_ = 0; rep_ < NREP(11); ++rep_) if (EN(11) && IN(pb + 9)) { fx_phase(a, l, G); SEAM(pb + 9); }
        for (int rep_ = 0; rep_ < NREP(12); ++rep_) if (EN(12) && IN(pb + 10)) {
            pg8::Gemm g{WSP(const bf16, WS_ACT), (const bf16*)(WSBASE + WS_WDN + l * SZ_WDN), NPR, DM, DFF}; pg8::StaticOrder S; S.init(NPR, DM, G, (int)blockIdx.x);
            EpiRes E{WSP(const float, WS_XB), WSP(const float, WS_XB) + (size_t)NPR * DM, WSP(float, WS_XA), MODL + 5 * DM, nullptr};
            pg8::gemm_phase_x<EpiRes, pg8::StaticOrder>(LDSL, g, WSP(const bf16, WS_ACT) + (size_t)NPR * DFF, S, E);
            SEAM(pb + 10);
        }
    }
    for (int rep_ = 0; rep_ < NREP(13); ++rep_) if (EN(13) && IN(PH_FINAL)) final_phase(WSP(const float, WS_XA), a.in[26], a.out + O_YP, G);
#undef IN
#undef SEAM
#undef G
}

extern "C" void kernel_launch(void* const* d_in, const int* in_sizes, int n_in, void* d_out, int out_size, void* d_ws, size_t ws_size, hipStream_t stream) {
    static int grid = 0;
    if (grid == 0) {
        if (n_in != 27 || (size_t)out_size != O_END || ws_size < WS_END) { fprintf(stderr, "kernel_launch: unexpected problem shape (n_in %d, out %d, ws %zu; need ws >= %zu)\n", n_in, out_size, ws_size, (size_t)WS_END); grid = -1; return; }
        int dev = 0, cus = 0, per_cu = 0;
        if (hipGetDevice(&dev) != hipSuccess || hipDeviceGetAttribute(&cus, hipDeviceAttributeMultiprocessorCount, dev) != hipSuccess) { grid = -1; return; }
        if (hipFuncSetAttribute((const void*)fwd_kernel, hipFuncAttributeMaxDynamicSharedMemorySize, LDS_BYTES) != hipSuccess) { fprintf(stderr, "kernel_launch: hipFuncSetAttribute failed\n"); grid = -1; return; }
        if (hipOccupancyMaxActiveBlocksPerMultiprocessor(&per_cu, (const void*)fwd_kernel, NTHR, LDS_BYTES) != hipSuccess || per_cu < 1) { fprintf(stderr, "kernel_launch: occupancy query says %d blocks per CU\n", per_cu); (void)hipGetLastError(); grid = -1; return; }
        grid = cus;
    }
    if (grid < 0) return;
    (void)hipMemsetAsync((char*)d_ws + WS_CTL, 0, CTL_BYTES, stream);
    Args a{};
    for (int i = 0; i < 27; ++i) a.in[i] = (const float*)d_in[i];
    a.out = (float*)d_out; a.ws = (unsigned char*)d_ws;
#if N_LAUNCH_MODE == 1
    a.ph_lo = 0; a.ph_hi = N_PHASES;
    hipLaunchKernelGGL(fwd_kernel, dim3(grid), dim3(NTHR), LDS_BYTES, stream, a);
#else
    for (int p = 0; p < N_PHASES; ++p) { a.ph_lo = p; a.ph_hi = p + 1; hipLaunchKernelGGL(fwd_kernel, dim3(grid), dim3(NTHR), LDS_BYTES, stream, a); }
#endif
}
```

```cpp
#include <hip/hip_runtime.h>
#include <cstdio>
#include <cstdint>
namespace pg8 {
#define PG8_LAS __attribute__((address_space(3)))
typedef unsigned short bf16_t;
typedef short bf16x8 __attribute__((ext_vector_type(8)));
typedef float f32x4 __attribute__((ext_vector_type(4)));
typedef unsigned u32x4 __attribute__((ext_vector_type(4)));
constexpr int BM = 256, BK = 64, HALF = 128, HTB = HALF * BK * 2  , STAGE_BYTES = 8 * HTB, NXCD = 8, WGM = 8;

__host__ __device__ __forceinline__ int lds_byte(int r, int c) { const int st = (r >> 4) * 2 + (c >> 5), rr = r & 15, cc = c & 31, ob = rr * 64 + cc * 2; return st * 1024 + (ob ^ (((ob >> 9) & 1) << 5)); }
__host__ __device__ __forceinline__ void stage_rc(int b, int& R, int& C) { const int st = b / 1024, sb = b % 1024, swz = sb ^ (((sb >> 9) & 1) << 5); R = (st >> 1) * 16 + swz / 64; C = (st & 1) * 32 + (swz % 64) / 2; }
__host__ __device__ __forceinline__ int perm32(int rho) { const int n = rho >> 4, i = rho & 15; return 8 * (i >> 2) + 4 * n + (i & 3); }

struct Unit { int pm, pn; };
struct Gemm { const bf16_t* A; const bf16_t* Bt; int M, N, K; };

struct StaticOrder {
    int nM, nN, nwg, G, c;
    __host__ __device__ void init(int M, int N, int G_, int c_) { nM = M / BM; nN = N / BM; nwg = nM * nN; G = G_; c = c_; }
    __host__ __device__ bool next(int i, Unit& u) const {
        const long L = (long)i * G + c; if (L >= nwg) return false;
        int wgid = (int)L; { const int q = nwg / NXCD, r = nwg % NXCD, xcd = wgid % NXCD, off = wgid / NXCD; wgid = (xcd < r ? xcd * (q + 1) : r * (q + 1) + (xcd - r) * q) + off; }
        const int nig = WGM * nN, gid = wgid / nig, fm = gid * WGM, gsz = (nM - fm) < WGM ? (nM - fm) : WGM;
        u.pm = fm + ((wgid % nig) % gsz); u.pn = (wgid % nig) / gsz; return true;
    }
    __device__ __forceinline__ void a_ready(const Unit&) const {}
    __device__ __forceinline__ void done(const Unit&) const {}
};

__device__ __forceinline__ unsigned cvt_pk_bf16(float lo, float hi) { unsigned r; asm volatile("v_cvt_pk_bf16_f32 %0, %1, %2" : "=v"(r) : "v"(lo), "v"(hi)); return r; }
typedef float f32x2 __attribute__((ext_vector_type(2)));
template <class Epi, class Sched, bool ALIGN_EPI = false, bool SP2 = false>
__device__ __forceinline__ void gemm_phase(PG8_LAS unsigned char* lds, const Gemm g, const Sched& S, const Epi& E) {
    int tid_ = threadIdx.x; asm volatile("" : "+v"(tid_)); const int tid = tid_, wid = __builtin_amdgcn_readfirstlane(tid >> 6), lane = tid & 63, wr = wid >> 2, wc = wid & 3, fr = lane & 15, fq = lane >> 4;
    const int K = g.K, nt = K / BK;
    unsigned voffA[2], voffB[2];
#pragma unroll
    for (int i = 0; i < 2; ++i) { int R, C; stage_rc(tid * 16 + i * 8192, R, C); const int Rb = Epi::PERM ? ((R & ~31) + perm32(R & 31)) : R;
        voffA[i] = (unsigned)(R * K + C) * 2u; voffB[i] = (unsigned)(Rb * K + C) * 2u; }
    const size_t kstep = (size_t)(BK * 2);
    const size_t hstep = (size_t)HALF * K * 2;
    const size_t tstep = 2 * hstep;
    const unsigned ldsw = (unsigned)wid * 1024u;
    const int aoff = lds_byte(wr * 64 + fr, fq * 8), boff = lds_byte(wc * 32 + fr, fq * 8);
#define PG8_SA(b, h) (((b) * 2 + (h)) * HTB)
#define PG8_SB(b, h) ((4 + (b) * 2 + (h)) * HTB)
#define PG8_STAGE(bufoff, gbase, voff) do { _Pragma("unroll") for (int _i = 0; _i < 2; ++_i) \
        __builtin_amdgcn_global_load_lds((const unsigned*)((const char*)(gbase) + (voff)[_i]), (PG8_LAS unsigned*)(lds + (bufoff) + ldsw + _i * 8192), 16, 0, 0); } while (0)
#define PG8_LDA(dst, b, h) do { _Pragma("unroll") for (int m = 0; m < 4; ++m) _Pragma("unroll") for (int k = 0; k < 2; ++k) dst[m][k] = *(const PG8_LAS bf16x8*)(lds + PG8_SA(b, h) + aoff + m * 2048 + k * 1024); } while (0)
#define PG8_LDB(dst, b, h) do { _Pragma("unroll") for (int n = 0; n < 2; ++n) _Pragma("unroll") for (int k = 0; k < 2; ++k) dst[n][k] = *(const PG8_LAS bf16x8*)(lds + PG8_SB(b, h) + boff + n * 2048 + k * 1024); } while (0)
#define PG8_MMA(ai, bj, At, Bt) do { __builtin_amdgcn_s_setprio(1); _Pragma("unroll") for (int m = 0; m < 4; ++m) _Pragma("unroll") for (int n = 0; n < 2; ++n) _Pragma("unroll") for (int k = 0; k < 2; ++k) \
        acc[ai][bj][m][n] = __builtin_amdgcn_mfma_f32_16x16x32_bf16(Bt[n][k], At[m][k], acc[ai][bj][m][n], 0, 0, 0); __builtin_amdgcn_s_setprio(0); } while (0)
#define PG8_WAIT_V(n) asm volatile("s_waitcnt vmcnt(" #n ")" ::: "memory")
#define PG8_WAIT_L(n) asm volatile("s_waitcnt lgkmcnt(" #n ")" ::: "memory")
#define PG8_BAR __builtin_amdgcn_s_barrier()
#define PG8_SCHED __builtin_amdgcn_sched_barrier(0)
    Unit cur, nxt; int ui = 0;
    if (!S.next(0, cur)) return;
    f32x4 acc[2][2][4][2];
#pragma unroll
    for (int a = 0; a < 2; ++a)
#pragma unroll
        for (int b = 0; b < 2; ++b)
#pragma unroll
            for (int m = 0; m < 4; ++m)
#pragma unroll
                for (int n = 0; n < 2; ++n) acc[a][b][m][n] = (f32x4){0.f, 0.f, 0.f, 0.f};
    bf16x8 At[4][2], B0[2][2], B1[2][2];
    const char* cA = (const char*)g.A + (size_t)cur.pm * tstep; const char* cB = (const char*)g.Bt + (size_t)cur.pn * tstep;
    S.a_ready(cur);
    if constexpr (SP2) {
        PG8_STAGE(PG8_SB(0, 0), cB, voffB); PG8_STAGE(PG8_SB(0, 1), cB + hstep, voffB); PG8_STAGE(PG8_SA(0, 0), cA, voffA); PG8_STAGE(PG8_SA(0, 1), cA + hstep, voffA);
        if (wr == 1) PG8_BAR;
        PG8_WAIT_V(2); PG8_BAR;
        PG8_STAGE(PG8_SB(1, 0), cB + kstep, voffB); PG8_STAGE(PG8_SA(1, 0), cA + kstep, voffA); PG8_STAGE(PG8_SB(1, 1), cB + hstep + kstep, voffB);
        PG8_WAIT_V(6); PG8_BAR;
    } else {
        PG8_STAGE(PG8_SB(0, 0), cB, voffB); PG8_STAGE(PG8_SA(0, 0), cA, voffA); PG8_STAGE(PG8_SB(0, 1), cB + hstep, voffB); PG8_STAGE(PG8_SA(0, 1), cA + hstep, voffA);
        if (wr == 1) PG8_BAR;
        PG8_WAIT_V(4); PG8_BAR;
        PG8_STAGE(PG8_SB(1, 0), cB + kstep, voffB); PG8_STAGE(PG8_SA(1, 0), cA + kstep, voffA); PG8_STAGE(PG8_SB(1, 1), cB + hstep + kstep, voffB);
        PG8_WAIT_V(6); PG8_BAR;
    }
    for (;;) {
        const bool has_next = S.next(ui + 1, nxt);
        const char* nA = has_next ? (const char*)g.A + (size_t)nxt.pm * tstep : cA; const char* nB = has_next ? (const char*)g.Bt + (size_t)nxt.pn * tstep : cB;
        for (int t = 0; t < nt; t += 2) {
            const bool last = (t == nt - 2);
            const char* a1 = cA + (size_t)(t + 1) * kstep;
            const char* a2 = last ? nA : cA + (size_t)(t + 2) * kstep; const char* b2 = last ? nB : cB + (size_t)(t + 2) * kstep;
            const char* a3 = a2 + kstep; const char* b3 = b2 + kstep;
            if (last && has_next) S.a_ready(nxt);
            if constexpr (SP2) {
            PG8_LDB(B0, 0, 0); PG8_LDB(B1, 0, 1); PG8_SCHED; PG8_LDA(At, 0, 0); PG8_STAGE(PG8_SA(1, 1), a1 + hstep, voffA);
            PG8_WAIT_V(8); PG8_WAIT_L(0); PG8_BAR; PG8_MMA(0, 0, At, B0); PG8_MMA(0, 1, At, B1); PG8_BAR; PG8_SCHED;
            PG8_LDA(At, 0, 1); PG8_STAGE(PG8_SB(0, 0), b2, voffB); PG8_STAGE(PG8_SB(0, 1), b2 + hstep, voffB); PG8_STAGE(PG8_SA(0, 0), a2, voffA);
            PG8_WAIT_V(8); PG8_WAIT_L(0); PG8_BAR; PG8_MMA(1, 0, At, B0); PG8_MMA(1, 1, At, B1); PG8_BAR; PG8_SCHED;
            PG8_LDB(B0, 1, 0); PG8_LDB(B1, 1, 1); PG8_SCHED; PG8_LDA(At, 1, 0); PG8_STAGE(PG8_SA(0, 1), a2 + hstep, voffA);
            PG8_WAIT_V(8); PG8_WAIT_L(0); PG8_BAR; PG8_MMA(0, 0, At, B0); PG8_MMA(0, 1, At, B1); PG8_BAR; PG8_SCHED;
            PG8_LDA(At, 1, 1); PG8_STAGE(PG8_SB(1, 0), b3, voffB); PG8_STAGE(PG8_SB(1, 1), b3 + hstep, voffB); PG8_STAGE(PG8_SA(1, 0), a3, voffA);
            PG8_WAIT_V(8); PG8_WAIT_L(0); PG8_BAR; PG8_MMA(1, 0, At, B0); PG8_MMA(1, 1, At, B1); PG8_BAR; PG8_SCHED;
            } else {
            PG8_LDB(B0, 0, 0); PG8_SCHED; PG8_LDA(At, 0, 0); PG8_STAGE(PG8_SA(1, 1), a1 + hstep, voffA);
            PG8_WAIT_L(8); PG8_BAR; PG8_WAIT_L(0); PG8_MMA(0, 0, At, B0); PG8_BAR; PG8_SCHED;
            PG8_LDB(B1, 0, 1); PG8_STAGE(PG8_SB(0, 0), b2, voffB);
            PG8_BAR; PG8_WAIT_L(0); PG8_MMA(0, 1, At, B1); PG8_BAR;
            PG8_LDA(At, 0, 1); PG8_STAGE(PG8_SA(0, 0), a2, voffA);
            PG8_BAR; PG8_WAIT_L(0); PG8_MMA(1, 0, At, B0); PG8_BAR; PG8_SCHED;
            PG8_STAGE(PG8_SB(0, 1), b2 + hstep, voffB);
            PG8_WAIT_V(6); PG8_BAR; PG8_MMA(1, 1, At, B1); PG8_BAR;
            PG8_LDB(B0, 1, 0); PG8_SCHED; PG8_LDA(At, 1, 0); PG8_STAGE(PG8_SA(0, 1), a2 + hstep, voffA);
            PG8_WAIT_L(8); PG8_BAR; PG8_WAIT_L(0); PG8_MMA(0, 0, At, B0); PG8_BAR; PG8_SCHED;
            PG8_LDB(B1, 1, 1); PG8_STAGE(PG8_SB(1, 0), b3, voffB);
            PG8_BAR; PG8_WAIT_L(0); PG8_MMA(0, 1, At, B1); PG8_BAR;
            PG8_LDA(At, 1, 1); PG8_STAGE(PG8_SA(1, 0), a3, voffA);
            PG8_BAR; PG8_WAIT_L(0); PG8_MMA(1, 0, At, B0); PG8_BAR; PG8_SCHED;
            PG8_STAGE(PG8_SB(1, 1), b3 + hstep, voffB);
            PG8_WAIT_V(6); PG8_BAR; PG8_MMA(1, 1, At, B1); PG8_BAR;
            }
        }
        if constexpr (ALIGN_EPI) { if (wr == 0) PG8_BAR; }
        if constexpr (!Epi::AFTER_DRAIN) { E(acc, cur, wr, wc, fr, fq); S.done(cur); }
        if (!has_next) break;
#pragma unroll
        for (int a = 0; a < 2; ++a)
#pragma unroll
            for (int b = 0; b < 2; ++b)
#pragma unroll
                for (int m = 0; m < 4; ++m)
#pragma unroll
                    for (int n = 0; n < 2; ++n) acc[a][b][m][n] = (f32x4){0.f, 0.f, 0.f, 0.f};
        cur = nxt; cA = nA; cB = nB; ++ui;
        if constexpr (ALIGN_EPI) { if (wr == 1) PG8_BAR; }
    }
    PG8_WAIT_V(0);
    if constexpr (!ALIGN_EPI) { if (wr == 0) PG8_BAR; }
    PG8_BAR;
    if constexpr (Epi::AFTER_DRAIN) { E.fused(acc, cur, wr, wc, fr, fq, lds, wid, lane); S.done(cur); }
#undef PG8_SA
#undef PG8_SB
#undef PG8_STAGE
#undef PG8_LDA
#undef PG8_LDB
#undef PG8_MMA
#undef PG8_WAIT_V
#undef PG8_WAIT_L
#undef PG8_BAR
#undef PG8_SCHED
}
}
namespace pg8 {
template <class Epi, class Sched>
__device__ __forceinline__ void gemm_phase_x(PG8_LAS unsigned char* lds, const Gemm g, const bf16_t* AX, const Sched& S, const Epi& E) {
    static_assert(!Epi::PERM && !Epi::AFTER_DRAIN, "gemm_phase_x: plain f32 epilogues only");
    int tid_ = threadIdx.x; asm volatile("" : "+v"(tid_)); const int tid = tid_, wid = __builtin_amdgcn_readfirstlane(tid >> 6), lane = tid & 63, wr = wid >> 2, wc = wid & 3, fr = lane & 15, fq = lane >> 4;
    const int K = g.K, nt = K / BK;
    unsigned voffA[2], voffB[2];
#pragma unroll
    for (int i = 0; i < 2; ++i) { int R, C; stage_rc(tid * 16 + i * 8192, R, C); voffA[i] = (unsigned)(R * K + C) * 2u; voffB[i] = voffA[i]; }
    unsigned voffX; { const int b_ = lane * 16, swz = b_ ^ (((b_ >> 9) & 1) << 5), r = swz / 64, c = (swz % 64) / 2; voffX = (unsigned)(r * K + c + 32 * (wid & 1)) * 2u; }
    const size_t kstep = (size_t)(BK * 2), hstep = (size_t)HALF * K * 2, tstep = 2 * hstep, xstep = (size_t)16 * K * 2;
    const unsigned ldsw = (unsigned)wid * 1024u;
    const int aoff = lds_byte(wr * 64 + fr, fq * 8), boff = lds_byte(wc * 32 + fr, fq * 8), xoff = lds_byte(fr, fq * 8);
#define PG8_SA(b, h) (((b) * 2 + (h)) * HTB)
#define PG8_SB(b, h) ((4 + (b) * 2 + (h)) * HTB)
#define PG8_SX(b) (STAGE_BYTES + (b) * 2048)
#define PG8_STAGE(bufoff, gbase, voff) do { _Pragma("unroll") for (int _i = 0; _i < 2; ++_i) \
        __builtin_amdgcn_global_load_lds((const unsigned*)((const char*)(gbase) + (voff)[_i]), (PG8_LAS unsigned*)(lds + (bufoff) + ldsw + _i * 8192), 16, 0, 0); } while (0)
#define PG8_STAGEX(b, gbase) do { if (wid < 2) __builtin_amdgcn_global_load_lds((const unsigned*)((const char*)(gbase) + voffX), (PG8_LAS unsigned*)(lds + PG8_SX(b) + ldsw), 16, 0, 0); } while (0)
#define PG8_LDA(dst, b, h) do { _Pragma("unroll") for (int m = 0; m < 4; ++m) _Pragma("unroll") for (int k = 0; k < 2; ++k) dst[m][k] = *(const PG8_LAS bf16x8*)(lds + PG8_SA(b, h) + aoff + m * 2048 + k * 1024); } while (0)
#define PG8_LDB(dst, b, h) do { _Pragma("unroll") for (int n = 0; n < 2; ++n) _Pragma("unroll") for (int k = 0; k < 2; ++k) dst[n][k] = *(const PG8_LAS bf16x8*)(lds + PG8_SB(b, h) + boff + n * 2048 + k * 1024); } while (0)
#define PG8_LDX(b) do { _Pragma("unroll") for (int k = 0; k < 2; ++k) Ax[k] = *(const PG8_LAS bf16x8*)(lds + PG8_SX(b) + k * 1024 + xoff); } while (0)
#define PG8_MMA(ai, bj, At, Bt) do { __builtin_amdgcn_s_setprio(1); _Pragma("unroll") for (int m = 0; m < 4; ++m) _Pragma("unroll") for (int n = 0; n < 2; ++n) _Pragma("unroll") for (int k = 0; k < 2; ++k) \
        acc[ai][bj][m][n] = __builtin_amdgcn_mfma_f32_16x16x32_bf16(Bt[n][k], At[m][k], acc[ai][bj][m][n], 0, 0, 0); __builtin_amdgcn_s_setprio(0); } while (0)
#define PG8_MMAX() do { if (wr == 0) { _Pragma("unroll") for (int n = 0; n < 2; ++n) _Pragma("unroll") for (int k = 0; k < 2; ++k) accx[n] = __builtin_amdgcn_mfma_f32_16x16x32_bf16(B0[n][k], Ax[k], accx[n], 0, 0, 0); } \
        else { _Pragma("unroll") for (int n = 0; n < 2; ++n) _Pragma("unroll") for (int k = 0; k < 2; ++k) accx[n] = __builtin_amdgcn_mfma_f32_16x16x32_bf16(B1[n][k], Ax[k], accx[n], 0, 0, 0); } } while (0)
#define PG8_WAIT_V(n) asm volatile("s_waitcnt vmcnt(" #n ")" ::: "memory")
#define PG8_WAIT_VX() do { if (wid < 2) PG8_WAIT_V(9); else PG8_WAIT_V(8); } while (0)
#define PG8_WAIT_L(n) asm volatile("s_waitcnt lgkmcnt(" #n ")" ::: "memory")
#define PG8_BAR __builtin_amdgcn_s_barrier()
#define PG8_SCHED __builtin_amdgcn_sched_barrier(0)
    Unit cur, nxt; int ui = 0;
    if (!S.next(0, cur)) return;
    f32x4 acc[2][2][4][2], accx[2];
#pragma unroll
    for (int a = 0; a < 2; ++a)
#pragma unroll
        for (int b = 0; b < 2; ++b)
#pragma unroll
            for (int m = 0; m < 4; ++m)
#pragma unroll
                for (int n = 0; n < 2; ++n) acc[a][b][m][n] = (f32x4){0.f, 0.f, 0.f, 0.f};
    accx[0] = (f32x4){0.f, 0.f, 0.f, 0.f}; accx[1] = (f32x4){0.f, 0.f, 0.f, 0.f};
    bf16x8 At[4][2], B0[2][2], B1[2][2], Ax[2];
    const char* cA = (const char*)g.A + (size_t)cur.pm * tstep; const char* cB = (const char*)g.Bt + (size_t)cur.pn * tstep; const char* cX = (const char*)AX + (size_t)cur.pm * xstep;
    S.a_ready(cur);
    PG8_STAGEX(0, cX); PG8_STAGEX(1, cX + kstep);
    PG8_STAGE(PG8_SB(0, 0), cB, voffB); PG8_STAGE(PG8_SB(0, 1), cB + hstep, voffB); PG8_STAGE(PG8_SA(0, 0), cA, voffA); PG8_STAGE(PG8_SA(0, 1), cA + hstep, voffA);
    if (wr == 1) PG8_BAR;
    PG8_WAIT_V(2); PG8_BAR;
    PG8_STAGE(PG8_SB(1, 0), cB + kstep, voffB); PG8_STAGE(PG8_SA(1, 0), cA + kstep, voffA); PG8_STAGE(PG8_SB(1, 1), cB + hstep + kstep, voffB);
    PG8_WAIT_V(6); PG8_BAR;
    for (;;) {
        const bool has_next = S.next(ui + 1, nxt);
        const char* nA = has_next ? (const char*)g.A + (size_t)nxt.pm * tstep : cA; const char* nB = has_next ? (const char*)g.Bt + (size_t)nxt.pn * tstep : cB;
        const char* nX = has_next ? (const char*)AX + (size_t)nxt.pm * xstep : cX;
        for (int t = 0; t < nt; t += 2) {
            const bool last = (t == nt - 2);
            const char* a1 = cA + (size_t)(t + 1) * kstep;
            const char* a2 = last ? nA : cA + (size_t)(t + 2) * kstep; const char* b2 = last ? nB : cB + (size_t)(t + 2) * kstep; const char* x2 = last ? nX : cX + (size_t)(t + 2) * kstep;
            const char* a3 = a2 + kstep; const char* b3 = b2 + kstep; const char* x3 = x2 + kstep;
            if (last && has_next) S.a_ready(nxt);
            PG8_LDB(B0, 0, 0); PG8_LDB(B1, 0, 1); PG8_SCHED; PG8_LDA(At, 0, 0); PG8_LDX(0); PG8_STAGE(PG8_SA(1, 1), a1 + hstep, voffA);
            PG8_WAIT_VX(); PG8_WAIT_L(0); PG8_BAR; PG8_MMA(0, 0, At, B0); PG8_MMA(0, 1, At, B1); PG8_MMAX(); PG8_BAR; PG8_SCHED;
            PG8_LDA(At, 0, 1); PG8_STAGE(PG8_SB(0, 0), b2, voffB); PG8_STAGE(PG8_SB(0, 1), b2 + hstep, voffB); PG8_STAGE(PG8_SA(0, 0), a2, voffA); PG8_STAGEX(0, x2);
            PG8_WAIT_VX(); PG8_WAIT_L(0); PG8_BAR; PG8_MMA(1, 0, At, B0); PG8_MMA(1, 1, At, B1); PG8_BAR; PG8_SCHED;
            PG8_LDB(B0, 1, 0); PG8_LDB(B1, 1, 1); PG8_SCHED; PG8_LDA(At, 1, 0); PG8_LDX(1); PG8_STAGE(PG8_SA(0, 1), a2 + hstep, voffA);
            PG8_WAIT_VX(); PG8_WAIT_L(0); PG8_BAR; PG8_MMA(0, 0, At, B0); PG8_MMA(0, 1, At, B1); PG8_MMAX(); PG8_BAR; PG8_SCHED;
            PG8_LDA(At, 1, 1); PG8_STAGE(PG8_SB(1, 0), b3, voffB); PG8_STAGE(PG8_SB(1, 1), b3 + hstep, voffB); PG8_STAGE(PG8_SA(1, 0), a3, voffA); PG8_STAGEX(1, x3);
            PG8_WAIT_VX(); PG8_WAIT_L(0); PG8_BAR; PG8_MMA(1, 0, At, B0); PG8_MMA(1, 1, At, B1); PG8_BAR; PG8_SCHED;
        }
        if (wr == 0) PG8_BAR;
        E(acc, cur, wr, wc, fr, fq); E.extra(accx, cur, wr, wc, fr, fq); S.done(cur);
        if (!has_next) break;
#pragma unroll
        for (int a = 0; a < 2; ++a)
#pragma unroll
            for (int b = 0; b < 2; ++b)
#pragma unroll
                for (int m = 0; m < 4; ++m)
#pragma unroll
                    for (int n = 0; n < 2; ++n) acc[a][b][m][n] = (f32x4){0.f, 0.f, 0.f, 0.f};
        accx[0] = (f32x4){0.f, 0.f, 0.f, 0.f}; accx[1] = (f32x4){0.f, 0.f, 0.f, 0.f};
        cur = nxt; cA = nA; cB = nB; cX = nX; ++ui;
        if (wr == 1) PG8_BAR;
    }
    PG8_WAIT_V(0);
    PG8_BAR;
#undef PG8_SA
#undef PG8_SB
#undef PG8_SX
#undef PG8_STAGE
#undef PG8_STAGEX
#undef PG8_LDA
#undef PG8_LDB
#undef PG8_LDX
#undef PG8_MMA
#undef PG8_MMAX
#undef PG8_WAIT_V
#undef PG8_WAIT_VX
#undef PG8_WAIT_L
#undef PG8_BAR
#undef PG8_SCHED
}
}

#define LAS __attribute__((address_space(3)))
#define GAS __attribute__((address_space(1)))
typedef unsigned short bf16;
typedef short bf16x8 __attribute__((ext_vector_type(8)));
typedef float f32x4 __attribute__((ext_vector_type(4)));
typedef float f32x16 __attribute__((ext_vector_type(16)));
typedef unsigned u32x4 __attribute__((ext_vector_type(4)));
typedef unsigned u32x2 __attribute__((ext_vector_type(2)));
#define RLX_AGENT __ATOMIC_RELAXED, __HIP_MEMORY_SCOPE_AGENT
#define LDS_WAIT() asm volatile("s_waitcnt lgkmcnt(0)" ::: "memory")
#define VM_WAIT() asm volatile("s_waitcnt vmcnt(0)" ::: "memory")

constexpr int NWAVES = 8, NTHR = 512;
constexpr int DM = 2048, NPR = 8192, NSR = 512, MROWS = 8704, SEQ = 2048, NBP = 4, NBS = 128, NB = 132, DEPTH = 4;
constexpr int NIN = 4632, NINP = 4864, PW = 4608;
constexpr int DFF = 5504, NUP = 11008;
constexpr int XBCW = 2560, SSDW = 1536, NH = 24, HD = 64, NG = 4, HPG = 6, DS = 128, POOLW = 512;
constexpr int NCH = 16;
constexpr int ADA = 12288;
constexpr float EPS = 1e-6f;

constexpr size_t O_YP = 0, O_YS = O_YP + (size_t)NPR * DM, O_PP = O_YS + (size_t)NSR * DM, O_CP = O_PP + (size_t)DEPTH * NBP * 15 * 512,
                 O_SP = O_CP + (size_t)DEPTH * NBP * 3 * XBCW, O_FP = O_SP + (size_t)DEPTH * NBP * NH * HD * DS, O_PS = O_FP + (size_t)DEPTH * NBP * 2 * DFF,
                 O_CS = O_PS + (size_t)DEPTH * NBS * 15 * 512, O_SS = O_CS + (size_t)DEPTH * NBS * 3 * XBCW, O_FS = O_SS + (size_t)DEPTH * NBS * NH * HD * DS,
                 O_END = O_FS + (size_t)DEPTH * NBS * 2 * DFF;
static_assert(O_END == 135557120ull, "output size");

constexpr size_t al256(size_t x) { return (x + 255) & ~(size_t)255; }
constexpr size_t WS_CTL = 0, CTL_BYTES = 1u << 20;
constexpr size_t WS_WIN = CTL_BYTES,                         SZ_WIN = (size_t)NINP * DM * 2;
constexpr size_t WS_WOUT = WS_WIN + DEPTH * SZ_WIN,          SZ_WOUT = (size_t)DM * DM * 2;
constexpr size_t WS_WUP = WS_WOUT + DEPTH * SZ_WOUT,         SZ_WUP = (size_t)NUP * DM * 2;
constexpr size_t WS_WDN = WS_WUP + DEPTH * SZ_WUP,           SZ_WDN = (size_t)DM * DFF * 2;
constexpr size_t WS_PWT = WS_WDN + DEPTH * SZ_WDN,           SZ_PWT = (size_t)4 * 128 * 128 * 2;
constexpr size_t WS_SC = WS_PWT + DEPTH * SZ_PWT;
constexpr size_t WS_MOD = al256(WS_SC + (size_t)160 * DM * 2);
constexpr size_t WS_H = al256(WS_MOD + (size_t)DEPTH * NB * ADA * 4);
constexpr size_t WS_P = al256(WS_H + (size_t)MROWS * DM * 2);
constexpr size_t WS_DT = al256(WS_P + (size_t)MROWS * PW * 2);
constexpr size_t WS_XC = al256(WS_DT + (size_t)MROWS * 32 * 4);
constexpr size_t WS_DTB = al256(WS_XC + (size_t)MROWS * XBCW * 2);
constexpr size_t WS_CSB = al256(WS_DTB + (size_t)MROWS * NH * 4);
constexpr size_t WS_S = al256(WS_CSB + (size_t)MROWS * NH * 4);
constexpr size_t WS_DEC = al256(WS_S + (size_t)NBP * NCH * NH * HD * DS * 4);
constexpr size_t WS_HS = al256(WS_DEC + (size_t)NBP * NCH * NH * 4);
constexpr size_t WS_XT = al256(WS_HS + (size_t)NBP * NCH * NH * HD * DS * 2);
constexpr size_t WS_MIX = al256(WS_XT + (size_t)NBP * NCH * NH * HD * DS * 2);
constexpr size_t WS_SSQ = al256(WS_MIX + (size_t)MROWS * DM * 2);
constexpr size_t WS_SSQ2 = al256(WS_SSQ + (size_t)MROWS * NH * 4);
constexpr size_t WS_R = al256(WS_SSQ2 + (size_t)NSR * NH * 4 * 4);
constexpr size_t WS_XA = al256(WS_R + (size_t)MROWS * 4);
constexpr size_t WS_XB = al256(WS_XA + (size_t)MROWS * DM * 4);
constexpr size_t WS_UP = al256(WS_XB + (size_t)MROWS * DM * 4);
constexpr size_t WS_ACT = al256(WS_UP + (size_t)MROWS * NUP * 2);
constexpr size_t WS_GH = al256(WS_ACT + (size_t)MROWS * DFF * 2);
constexpr size_t WS_VH = al256(WS_GH + (size_t)34 * 4 * DFF * 4);
constexpr size_t WS_END = al256(WS_VH + (size_t)34 * 2 * DFF * 4);

constexpr int CW_BAR = 4096;
constexpr int LDS_BYTES = 155648;
constexpr int LDS_MISC = 151552;
constexpr int LDS_HALO = 135168;

__device__ __forceinline__ float bflo(unsigned w) { return __uint_as_float(w << 16); }
__device__ __forceinline__ float bfhi(unsigned w) { return __uint_as_float(w & 0xffff0000u); }
__device__ __forceinline__ float bf1(bf16 b) { return __uint_as_float((unsigned)b << 16); }
__device__ __forceinline__ unsigned pk2(float lo, float hi) { return pg8::cvt_pk_bf16(lo, hi); }
__device__ __forceinline__ bf16 f2bf(float f) { return (bf16)(pk2(f, 0.f) & 0xffffu); }
__device__ __forceinline__ void unpack8(const u32x4 w, float (&v)[8]) { v[0] = bflo(w.x); v[1] = bfhi(w.x); v[2] = bflo(w.y); v[3] = bfhi(w.y); v[4] = bflo(w.z); v[5] = bfhi(w.z); v[6] = bflo(w.w); v[7] = bfhi(w.w); }
__device__ __forceinline__ u32x4 pack8(const float (&v)[8]) { u32x4 o; o.x = pk2(v[0], v[1]); o.y = pk2(v[2], v[3]); o.z = pk2(v[4], v[5]); o.w = pk2(v[6], v[7]); return o; }
__device__ __forceinline__ float silu_f(float x) { return x / (1.f + __expf(-x)); }
__device__ __forceinline__ float softplus_f(float x) { return x > 20.f ? x : log1pf(__expf(x)); }
__device__ __forceinline__ float wave_sum(float v) {
#pragma unroll
    for (int o = 1; o < 64; o <<= 1) v += __shfl_xor(v, o);
    return v;
}
#define MFMA16(a, b, c) __builtin_amdgcn_mfma_f32_16x16x32_bf16((a), (b), (c), 0, 0, 0)
__device__ __forceinline__ bf16x8 as_frag(u32x4 w) { return __builtin_bit_cast(bf16x8, w); }

struct Args {
    const float* in[27]; float* out; unsigned char* ws; int ph_lo, ph_hi;
};

__device__ __forceinline__ int row_bidx(int r) { return r < NPR ? (r >> 11) : 4 + ((r - NPR) >> 2); }

struct EpiProj {
    static constexpr bool PERM = true, AFTER_DRAIN = false;
    bf16* P; float* DT;
    __device__ __forceinline__ void operator()(const pg8::f32x4 (&acc)[2][2][4][2], const pg8::Unit& u, int wr, int wc, int fr, int fq) const {
        const int row0 = u.pm * 256 + wr * 64 + fr;
        if (u.pn < 18) {
            const int col0 = u.pn * 256 + wc * 32 + 8 * fq;
#pragma unroll
            for (int ai = 0; ai < 2; ++ai)
#pragma unroll
                for (int m = 0; m < 4; ++m) { bf16* rowp = P + (size_t)(row0 + ai * 128 + m * 16) * PW + col0;
#pragma unroll
                    for (int bj = 0; bj < 2; ++bj) { const pg8::f32x4 v0 = acc[ai][bj][m][0], v1 = acc[ai][bj][m][1];
                        u32x4 w; w.x = pk2(v0[0], v0[1]); w.y = pk2(v0[2], v0[3]); w.z = pk2(v1[0], v1[1]); w.w = pk2(v1[2], v1[3]);
                        *(u32x4*)(rowp + bj * 128) = w; } }
        } else if (wc == 0) {
#pragma unroll
            for (int ai = 0; ai < 2; ++ai)
#pragma unroll
                for (int m = 0; m < 4; ++m) { float* rowp = DT + (size_t)(row0 + ai * 128 + m * 16) * 32 + 8 * fq;
                    *(f32x4*)(rowp) = acc[ai][0][m][0]; *(f32x4*)(rowp + 4) = acc[ai][0][m][1]; }
        }
    }
};
struct EpiBf {
    static constexpr bool PERM = true, AFTER_DRAIN = false;
    bf16* O; int ldc;
    __device__ __forceinline__ void operator()(const pg8::f32x4 (&acc)[2][2][4][2], const pg8::Unit& u, int wr, int wc, int fr, int fq) const {
        const int row0 = u.pm * 256 + wr * 64 + fr, col0 = u.pn * 256 + wc * 32 + 8 * fq;
#pragma unroll
        for (int ai = 0; ai < 2; ++ai)
#pragma unroll
            for (int m = 0; m < 4; ++m) { bf16* rowp = O + (size_t)(row0 + ai * 128 + m * 16) * ldc + col0;
#pragma unroll
                for (int bj = 0; bj < 2; ++bj) { const pg8::f32x4 v0 = acc[ai][bj][m][0], v1 = acc[ai][bj][m][1];
                    u32x4 w; w.x = pk2(v0[0], v0[1]); w.y = pk2(v0[2], v0[3]); w.z = pk2(v1[0], v1[1]); w.w = pk2(v1[2], v1[3]);
                    *(u32x4*)(rowp + bj * 128) = w; } }
    }
};
struct EpiRes {
    static constexpr bool PERM = false, AFTER_DRAIN = false;
    const float* bp; const float* bs; float* out; const float* gate; const float* rs;
    __device__ __forceinline__ void operator()(const pg8::f32x4 (&acc)[2][2][4][2], const pg8::Unit& u, int wr, int wc, int fr, int fq) const {
        const int row0 = u.pm * 256 + wr * 64 + fr, col0 = u.pn * 256 + wc * 32 + 4 * fq;
#pragma unroll
        for (int ai = 0; ai < 2; ++ai)
#pragma unroll
            for (int m = 0; m < 4; ++m) {
                const int r = row0 + ai * 128 + m * 16;
                const float* brow = (r < NPR ? bp + (size_t)r * DM : bs + (size_t)(r - NPR) * DM) + col0;
                const float* grow = gate + (size_t)row_bidx(r) * ADA + col0;
                const float s = rs ? rs[r] : 1.f;
                float* orow = out + (size_t)r * DM + col0;
#pragma unroll
                for (int bj = 0; bj < 2; ++bj)
#pragma unroll
                    for (int n = 0; n < 2; ++n) { const int o = bj * 128 + n * 16;
                        const pg8::f32x4 b = *(const pg8::f32x4*)(brow + o), g = *(const pg8::f32x4*)(grow + o);
                        *(pg8::f32x4*)(orow + o) = b + g * (acc[ai][bj][m][n] * s); }
            }
    }
    __device__ __forceinline__ void extra(const pg8::f32x4 (&accx)[2], const pg8::Unit& u, int wr, int wc, int fr, int fq) const {
        const int r = NPR + 16 * u.pm + fr, col0 = u.pn * 256 + wr * 128 + wc * 32 + 4 * fq;
        const float* brow = bs + (size_t)(r - NPR) * DM + col0;
        const float* grow = gate + (size_t)row_bidx(r) * ADA + col0;
        const float s = rs ? rs[r] : 1.f;
        float* orow = out + (size_t)r * DM + col0;
#pragma unroll
        for (int n = 0; n < 2; ++n) { const int o = n * 16;
            const pg8::f32x4 b = *(const pg8::f32x4*)(brow + o), g = *(const pg8::f32x4*)(grow + o);
            *(pg8::f32x4*)(orow + o) = b + g * (accx[n] * s); }
    }
};


__device__ __forceinline__ float dpp_ror1(float v) { return __int_as_float(__builtin_amdgcn_update_dpp(0, __float_as_int(v), 0x121, 0xf, 0xf, false)); }
__device__ __forceinline__ float dpp_ror2(float v) { return __int_as_float(__builtin_amdgcn_update_dpp(0, __float_as_int(v), 0x122, 0xf, 0xf, false)); }
struct EpiAct {
    static constexpr bool PERM = true, AFTER_DRAIN = false;
    bf16* ACT; float* GH; float* VH; const float* fw; const float* fb; const float* stf; float* ofp; float* ofs; LAS float* hl; int l;
    __device__ __forceinline__ void operator()(const pg8::f32x4 (&acc)[2][2][4][2], const pg8::Unit& u, int wr, int wc, int fr, int fq) const {
        const bool sample = u.pm >= NPR / 256;
        if (fr >= 14) {
#pragma unroll
            for (int ai = 0; ai < 2; ++ai) { LAS float* d = hl + ((ai * 2 + wr) * 2 + (fr - 14)) * 128 + 32 * wc + 8 * fq; *(LAS pg8::f32x4*)d = acc[ai][0][3][0]; *(LAS pg8::f32x4*)(d + 4) = acc[ai][0][3][1]; } }
        asm volatile("s_waitcnt lgkmcnt(0)" ::: "memory"); __builtin_amdgcn_s_barrier(); asm volatile("" ::: "memory");
        const int t4 = fr & 3;
#pragma unroll
        for (int n = 0; n < 2; ++n) {
            const int cl = 32 * wc + 8 * fq + 4 * n, jb = 128 * u.pn + cl;
            const f32x4 w0 = *(const f32x4*)(fw + jb), w1 = *(const f32x4*)(fw + DFF + jb), w2 = *(const f32x4*)(fw + 2 * DFF + jb), bb = *(const f32x4*)(fb + jb);
#pragma unroll
            for (int ai = 0; ai < 2; ++ai) {
                f32x4 p1, p2;
                if (wr == 1 || ai == 1) { const LAS float* s = hl + ((wr == 1 ? ai * 2 : 1) * 2) * 128 + cl;
                    const f32x4 x = *(const LAS pg8::f32x4*)s, y = *(const LAS pg8::f32x4*)(s + 128); p1 = y; p2 = fr == 0 ? x : y; }
                else { p1 = (f32x4){0.f, 0.f, 0.f, 0.f}; p2 = p1; }
#pragma unroll
                for (int m = 0; m < 4; ++m) {
                    int rl_ = ai * 128 + wr * 64 + m * 16 + fr; asm volatile("" : "+v"(rl_));
                    const int rl = rl_, r = u.pm * 256 + rl;
                    f32x4 s0 = (f32x4){0.f, 0.f, 0.f, 0.f}, s1 = s0;
                    if (sample) { const float* sp = stf + ((size_t)((r - NPR) >> 2) * 2) * DFF + jb; s0 = *(const f32x4*)sp; s1 = *(const f32x4*)(sp + DFF); }
                    const f32x4 g = acc[ai][0][m][n], v = acc[ai][1][m][n]; f32x4 o;
#pragma unroll
                    for (int c = 0; c < 4; ++c) {
                        const float R1 = dpp_ror1(g[c]), R2 = dpp_ror2(g[c]);
                        float q1, q2;
                        if (sample) { q1 = t4 >= 1 ? R1 : s1[c]; q2 = t4 >= 2 ? R2 : (t4 == 1 ? s1[c] : s0[c]); }
                        else { q1 = fr >= 1 ? R1 : p1[c]; q2 = fr >= 2 ? R2 : p2[c]; }
                        o[c] = silu_f(bb[c] + w2[c] * g[c] + w1[c] * q1 + w0[c] * q2) * v[c];
                        p1[c] = R1; p2[c] = R2;
                    }
                    u32x2 ow; ow.x = pk2(o[0], o[1]); ow.y = pk2(o[2], o[3]);
                    *(u32x2*)(ACT + (size_t)r * DFF + jb) = ow;
                    if (sample) { if (t4 >= 2) *(f32x4*)(ofs + ((size_t)((r - NPR) >> 2) * 2 + (t4 - 2)) * DFF + jb) = g; }
                    else {
                        if (rl < 2) { *(f32x4*)(GH + ((size_t)u.pm * 4 + rl) * DFF + jb) = g; *(f32x4*)(VH + ((size_t)u.pm * 2 + rl) * DFF + jb) = v; }
                        if (rl >= 254) { *(f32x4*)(GH + ((size_t)u.pm * 4 + 2 + (rl - 254)) * DFF + jb) = g;
                                         if ((u.pm & 7) == 7) *(f32x4*)(ofp + ((size_t)(u.pm >> 3) * 2 + (rl - 254)) * DFF + jb) = g; }
                    }
                }
            }
        }
    }
};

__device__ __forceinline__ void tr_item(const float* W, int K, int N, int nblk, bf16* WT, int mode, const float* ks0, const float* ks1, LAS float* scr, int item, int lane) {
    const int kb = item / nblk, nb = item % nblk, k0 = 64 * kb, n0 = 32 * nb;
    const int n4 = n0 + 4 * (lane & 7);
    if (n0 + 32 <= N) {
        f32x4 v[8];
#pragma unroll
        for (int i = 0; i < 8; ++i) v[i] = *(const f32x4*)(W + (size_t)(k0 + 8 * i + (lane >> 3)) * N + n4);
#pragma unroll
        for (int i = 0; i < 8; ++i) { const int kk = 8 * i + (lane >> 3); float sc = 1.f;
            if (mode == 1) { const int k = k0 + kk; sc = (k < 512) ? ks0[k] : ks1[k - 512]; }
            LAS float* d = scr + kk * 33 + 4 * (lane & 7); d[0] = v[i][0] * sc; d[1] = v[i][1] * sc; d[2] = v[i][2] * sc; d[3] = v[i][3] * sc; }
    } else {
        const int n = n0 + (lane & 31);
#pragma unroll 8
        for (int i = 0; i < 32; ++i) { const int kk = 2 * i + (lane >> 5); float v = (n < N) ? W[(size_t)(k0 + kk) * N + n] : 0.f;
            if (mode == 1) { const int k = k0 + kk; v *= (k < 512) ? ks0[k] : ks1[k - 512]; }
            scr[kk * 33 + (lane & 31)] = v; }
    }
    LDS_WAIT(); asm volatile("" ::: "memory");
    const int c = lane & 7;
#pragma unroll
    for (int j = 0; j < 4; ++j) { const int nl = (lane >> 3) + 8 * j; const LAS float* s = scr + (8 * c) * 33 + nl;
        u32x4 o; o.x = pk2(s[0 * 33], s[1 * 33]); o.y = pk2(s[2 * 33], s[3 * 33]); o.z = pk2(s[4 * 33], s[5 * 33]); o.w = pk2(s[6 * 33], s[7 * 33]);
        const int nn = n0 + nl; int row = nn;
        if (mode == 2) row = nn < DFF ? ((nn >> 7) * 256 + (nn & 127)) : (((nn - DFF) >> 7) * 256 + 128 + ((nn - DFF) & 127));
        *(u32x4*)(WT + (size_t)row * K + k0 + 8 * c) = o; }
    LDS_WAIT(); asm volatile("" ::: "memory");
}
__device__ __forceinline__ void p0a_phase(const Args& a, LAS unsigned char* lds, int G) {
    unsigned char* ws_ = a.ws; asm volatile("" : "+s"(ws_));
    int tid_ = threadIdx.x; asm volatile("" : "+v"(tid_)); const int tid = tid_, lane = tid & 63, wave = tid >> 6;
    LAS float* scr = (LAS float*)(lds + wave * 8448);
    const int gw = blockIdx.x * NWAVES + wave, NGW = G * NWAVES;
    constexpr int I_IN = 32 * (NINP / 32), I_OUT = 32 * (DM / 32), I_UP = 32 * (NUP / 32), I_DN = (DFF / 64) * (DM / 32), I_PW = 4 * 2 * 4, I_L = I_IN + I_OUT + I_UP + I_DN + I_PW;
    for (int it = gw; it < DEPTH * I_L; it += NGW) {
        const int l = it / I_L; int r = it % I_L;
        if (r < I_IN) { tr_item(a.in[12] + (size_t)l * DM * NIN, DM, NIN, NINP / 32, (bf16*)(ws_ + WS_WIN + l * SZ_WIN), 0, nullptr, nullptr, scr, r, lane); continue; } r -= I_IN;
        if (r < I_OUT) { tr_item(a.in[21] + (size_t)l * DM * DM, DM, DM, DM / 32, (bf16*)(ws_ + WS_WOUT + l * SZ_WOUT), 1, a.in[14] + l * POOLW, a.in[20] + l * SSDW, scr, r, lane); continue; } r -= I_OUT;
        if (r < I_UP) { tr_item(a.in[22] + (size_t)l * DM * NUP, DM, NUP, NUP / 32, (bf16*)(ws_ + WS_WUP + l * SZ_WUP), 2, nullptr, nullptr, scr, r, lane); continue; } r -= I_UP;
        if (r < I_DN) { tr_item(a.in[25] + (size_t)l * DFF * DM, DFF, DM, DM / 32, (bf16*)(ws_ + WS_WDN + l * SZ_WDN), 0, nullptr, nullptr, scr, r, lane); continue; } r -= I_DN;
        { const int g = r / 8, q = r % 8; tr_item(a.in[13] + ((size_t)l * 4 + g) * 128 * 128, 128, 128, 4, (bf16*)(ws_ + WS_PWT + l * SZ_PWT) + (size_t)g * 128 * 128, 0, nullptr, nullptr, scr, q, lane); }
    }
    bf16* SC = (bf16*)(ws_ + WS_SC);
    for (int i = blockIdx.x * NTHR + tid; i < 160 * (DM / 4); i += G * NTHR) {
        const int row = i / (DM / 4), c4 = (i % (DM / 4)) * 4; f32x4 v = (f32x4){0.f, 0.f, 0.f, 0.f};
        if (row < NBP) v = *(const f32x4*)(a.in[2] + (size_t)row * DM + c4); else if (row < NB) v = *(const f32x4*)(a.in[3] + (size_t)(row - NBP) * DM + c4);
        u32x2 o; o.x = pk2(silu_f(v[0]), silu_f(v[1])); o.y = pk2(silu_f(v[2]), silu_f(v[3]));
        *(u32x2*)(SC + (size_t)row * DM + c4) = o;
    }
}
__device__ __forceinline__ void p0b_phase(const Args& a, LAS unsigned char* lds, int G) {
    unsigned char* ws_ = a.ws; asm volatile("" : "+s"(ws_));
    int tid_ = threadIdx.x; asm volatile("" : "+v"(tid_)); const int tid = tid_, lane = tid & 63, wave = __builtin_amdgcn_readfirstlane(tid >> 6), fr = lane & 15, q = lane >> 4;
    const bf16* SC = (const bf16*)(ws_ + WS_SC); float* MOD = (float*)(ws_ + WS_MOD);
    const int cb = wave & 3, kh = wave >> 2;
    for (int u = blockIdx.x; u < DEPTH * (ADA / 256); u += G) {
        const int l = u / (ADA / 256), n0 = (u % (ADA / 256)) * 256 + 64 * cb + 4 * fr;
        const float* W = a.in[10] + (size_t)l * DM * ADA + n0;
        f32x4 acc[4][9];
#pragma unroll
        for (int e = 0; e < 4; ++e)
#pragma unroll
            for (int m = 0; m < 9; ++m) acc[e][m] = (f32x4){0.f, 0.f, 0.f, 0.f};
        f32x4 v[8];
#pragma unroll
        for (int j = 0; j < 8; ++j) v[j] = __builtin_nontemporal_load((const f32x4*)(W + (size_t)(kh * 1024 + 8 * q + j) * ADA));
#pragma unroll 1
        for (int kk = 0; kk < 32; ++kk) {
            const int k0 = kh * 1024 + kk * 32 + 8 * q;
            bf16x8 bfr[4];
#pragma unroll
            for (int e = 0; e < 4; ++e) { u32x4 w; w.x = pk2(v[0][e], v[1][e]); w.y = pk2(v[2][e], v[3][e]); w.z = pk2(v[4][e], v[5][e]); w.w = pk2(v[6][e], v[7][e]); bfr[e] = as_frag(w); }
            const int kn = (kk < 31) ? k0 + 32 : k0;
#pragma unroll
            for (int j = 0; j < 8; ++j) v[j] = __builtin_nontemporal_load((const f32x4*)(W + (size_t)(kn + j) * ADA));
#pragma unroll
            for (int m = 0; m < 9; ++m) { const bf16x8 afr = as_frag(*(const u32x4*)(SC + (size_t)(16 * m + fr) * DM + k0));
#pragma unroll
                for (int e = 0; e < 4; ++e) acc[e][m] = MFMA16(afr, bfr[e], acc[e][m]); }
        }
        LAS f32x4* red = (LAS f32x4*)lds + (size_t)cb * 36 * 64 + lane;
        if (kh == 1) {
#pragma unroll
            for (int e = 0; e < 4; ++e)
#pragma unroll
                for (int m = 0; m < 9; ++m) red[(e * 9 + m) * 64] = acc[e][m];
        }
        __syncthreads();
        if (kh == 0) {
            const f32x4 bias = *(const f32x4*)(a.in[11] + (size_t)l * ADA + n0);
#pragma unroll
            for (int m = 0; m < 9; ++m) {
                f32x4 t[4];
#pragma unroll
                for (int e = 0; e < 4; ++e) t[e] = acc[e][m] + red[(e * 9 + m) * 64];
                float* p = MOD + ((size_t)l * NB + 16 * m + 4 * q) * ADA + n0; asm volatile("" : "+v"(p));
#pragma unroll
                for (int r = 0; r < 4; ++r) if (16 * m + 4 * q + r < NB) *(f32x4*)(p + (size_t)r * ADA) = (f32x4){t[0][r], t[1][r], t[2][r], t[3][r]} + bias;
            }
        }
        __syncthreads();
    }
}
__device__ __forceinline__ void norm_phase(const float* xp, const float* xs, const float* gamma, const float* modl, int shc, bf16* H, int G) {
    int tid_ = threadIdx.x; asm volatile("" : "+v"(tid_)); const int tid = tid_, lane = tid & 63, wave = tid >> 6;
    for (int row = blockIdx.x * NWAVES + wave; row < MROWS; row += G * NWAVES) {
        const float* xr = (row < NPR ? xp + (size_t)row * DM : xs + (size_t)(row - NPR) * DM) + 4 * lane;
        f32x4 v[8]; float ss = 0.f;
#pragma unroll
        for (int j = 0; j < 8; ++j) { v[j] = *(const f32x4*)(xr + 256 * j); ss += (v[j][0] * v[j][0] + v[j][1] * v[j][1]) + (v[j][2] * v[j][2] + v[j][3] * v[j][3]); }
        const float rstd = 1.f / sqrtf(wave_sum(ss) * (1.f / DM) + EPS);
        const float* mrow = modl + (size_t)row_bidx(row) * ADA + 4 * lane;
        bf16* hr = H + (size_t)row * DM + 4 * lane;
#pragma unroll
        for (int j = 0; j < 8; ++j) { const f32x4 g = *(const f32x4*)(gamma + 256 * j + 4 * lane), sh = *(const f32x4*)(mrow + shc * DM + 256 * j), sc = *(const f32x4*)(mrow + (shc + 1) * DM + 256 * j);
            const f32x4 y = (v[j] * rstd) * g * (sc + 1.f) + sh;
            u32x2 o; o.x = pk2(y[0], y[1]); o.y = pk2(y[2], y[3]); *(u32x2*)(hr + 256 * j) = o; }
    }
}
__device__ __forceinline__ void final_phase(const float* X, const float* gamma, float* out, int G) {
    int tid_ = threadIdx.x; asm volatile("" : "+v"(tid_)); const int tid = tid_, lane = tid & 63, wave = tid >> 6;
    for (int row = blockIdx.x * NWAVES + wave; row < MROWS; row += G * NWAVES) {
        const float* xr = X + (size_t)row * DM + 4 * lane;
        f32x4 v[8]; float ss = 0.f;
#pragma unroll
        for (int j = 0; j < 8; ++j) { v[j] = *(const f32x4*)(xr + 256 * j); ss += (v[j][0] * v[j][0] + v[j][1] * v[j][1]) + (v[j][2] * v[j][2] + v[j][3] * v[j][3]); }
        const float rstd = 1.f / sqrtf(wave_sum(ss) * (1.f / DM) + EPS);
        float* orow = out + (size_t)row * DM + 4 * lane;
#pragma unroll
        for (int j = 0; j < 8; ++j) { const f32x4 g = *(const f32x4*)(gamma + 256 * j + 4 * lane); *(f32x4*)(orow + 256 * j) = (v[j] * rstd) * g; }
    }
}
#define XB_TMO      128
#define XB_XCNT(j)  (256  + 64 * (j))
#define XB_XSUB(j)  (1280 + 64 * (j))
#define XB_XGEN(j)  (2304 + 64 * (j))
#define XB_TOP      3328
#define XB_TOPGEN   3392
#define XCD_BAR_WORDS 3456
#define XB_SPIN_CAP (1u << 18)

__device__ __forceinline__ unsigned xb_ld(unsigned* p)              { return __hip_atomic_load(p, __ATOMIC_RELAXED, __HIP_MEMORY_SCOPE_AGENT); }
__device__ __forceinline__ unsigned xb_add(unsigned* p, unsigned v) { return __hip_atomic_fetch_add(p, v, __ATOMIC_RELAXED, __HIP_MEMORY_SCOPE_AGENT); }
__device__ __forceinline__ unsigned xb_xcc_id() { return (unsigned)__builtin_amdgcn_s_getreg((3 << 11) | 20) & 0xFu; }
#define XB_SPIN(cond, bar) do { unsigned _sp = 0; while (cond) { __builtin_amdgcn_s_sleep(1); \
    if ((++_sp & 255u) == 0u) { if (xb_ld(&(bar)[XB_TMO])) break; if (_sp > XB_SPIN_CAP) { atomicAdd(&(bar)[XB_TMO], 1u); break; } } } } while (0)

struct XcdBarrier {
    unsigned* bar; unsigned x;
    volatile LAS unsigned* st;
};

__device__ __forceinline__ XcdBarrier xcd_barrier_post(unsigned* bar, volatile LAS unsigned* st) {
    XcdBarrier b; b.bar = bar; b.x = xb_xcc_id(); b.st = st;
    if (threadIdx.x == 0) (void)xb_add(&bar[XB_XCNT(b.x)], 1u);
    return b;
}
__device__ __forceinline__ void xcd_barrier_complete(unsigned* bar, unsigned x, unsigned& nloc, unsigned& nx) {
    const unsigned G = gridDim.x * gridDim.y * gridDim.z;
    unsigned sum, cnt, mine, sp = 0u;
    for (;;) {
        sum = 0u; cnt = 0u; mine = 0u;
#pragma unroll
        for (unsigned j = 0; j < 16; ++j) { const unsigned c = xb_ld(&bar[XB_XCNT(j)]); sum += c; cnt += (c > 0u) ? 1u : 0u; mine = (j == x) ? c : mine; }
        if (sum == G) break;
        __builtin_amdgcn_s_sleep(1);
        if ((++sp & 255u) == 0u) { if (xb_ld(&bar[XB_TMO])) break; if (sp > XB_SPIN_CAP) { atomicAdd(&bar[XB_TMO], 1u); break; } }
    }
    nloc = mine > 0u ? mine : 1u; nx = cnt > 0u ? cnt : 1u;
}

__device__ __forceinline__ void xcd_barrier(const XcdBarrier& b) {
    asm volatile("s_waitcnt vmcnt(0)" ::: "memory");
    __syncthreads();
    if (threadIdx.x == 0) {
        unsigned* bar = b.bar;
        __builtin_amdgcn_s_waitcnt(0);
        unsigned nloc = b.st[0], nx = b.st[1];
        if (nloc == 0u) { xcd_barrier_complete(bar, b.x, nloc, nx); b.st[0] = nloc; b.st[1] = nx; }
        const unsigned old = xb_add(&bar[XB_XSUB(b.x)], 1u);
        const unsigned gen = old / nloc;
        if (old + 1u == (gen + 1u) * nloc) {
            __builtin_amdgcn_fence(__ATOMIC_RELEASE, "agent");
            asm volatile("s_waitcnt vmcnt(0)" ::: "memory");
            const unsigned og = xb_add(&bar[XB_TOP], 1u);
            const unsigned tg = og / nx;
            if (og + 1u == (tg + 1u) * nx) xb_add(&bar[XB_TOPGEN], 1u);
            else XB_SPIN(xb_ld(&bar[XB_TOPGEN]) == tg, bar);
            __builtin_amdgcn_fence(__ATOMIC_ACQUIRE, "agent");
            xb_add(&bar[XB_XGEN(b.x)], 1u);
            asm volatile("s_waitcnt vmcnt(0)" ::: "memory");
        } else {
            XB_SPIN(xb_ld(&bar[XB_XGEN(b.x)]) == gen, bar);
            __builtin_amdgcn_fence(__ATOMIC_ACQUIRE, "agent");
            asm volatile("s_waitcnt vmcnt(0)" ::: "memory");
        }
    }
    __syncthreads();
}

#ifndef SUBREP
#define SUBREP 0u
#endif
#define SUBN(b) ((((SUBREP) >> (b)) & 1u) ? 2 : 1)
constexpr int LSTR = 136;
__device__ __forceinline__ int k1_chan(int g, int ch8) { return ch8 < 48 ? 384 * g + 8 * ch8 : (ch8 < 64 ? SSDW + 128 * g + 8 * (ch8 - 48) : SSDW + 512 + 128 * g + 8 * (ch8 - 64)); }

__device__ __forceinline__ void k1_phase(const Args& a, int l, LAS unsigned char* lds, int G) {
    unsigned char* ws_ = a.ws; asm volatile("" : "+s"(ws_));
    int tid_ = threadIdx.x; asm volatile("" : "+v"(tid_)); const int tid = tid_, lane = tid & 63, wave = __builtin_amdgcn_readfirstlane(tid >> 6), q = lane >> 4, fr = lane & 15;
    const bf16* P = (const bf16*)(ws_ + WS_P); const float* DT = (const float*)(ws_ + WS_DT);
    bf16* XC = (bf16*)(ws_ + WS_XC); float* DTB = (float*)(ws_ + WS_DTB); float* CSB = (float*)(ws_ + WS_CSB);
    float* S = (float*)(ws_ + WS_S); float* DEC = (float*)(ws_ + WS_DEC); bf16* XT = (bf16*)(ws_ + WS_XT);
    const float* cw = a.in[15] + (size_t)l * 4 * XBCW; const float* cb = a.in[16] + (size_t)l * XBCW;
    const float* dtb = a.in[17] + l * NH; const float* alog = a.in[18] + l * NH;
    LAS bf16* xdT = (LAS bf16*)lds;
    LAS bf16* BT = (LAS bf16*)(lds + 6 * 64 * LSTR * 2);
    LAS float* csL = (LAS float*)(lds + 6 * 64 * LSTR * 2 + 128 * LSTR * 2);
    LAS float* scL = csL + 6 * 128;
    for (int u = blockIdx.x; u < NBP * NCH * NG; u += G) {
        const int b = u >> 6, c = (u >> 2) & 15, g = u & 3, r0 = b * SEQ + c * 128;
        if (wave < HPG) {
            const int h = HPG * g + wave; const float A = -__expf(alog[h]), bias = dtb[h];
            const int t0 = 2 * lane;
            const float d0 = softplus_f(DT[(size_t)(r0 + t0) * 32 + h] + bias), d1 = softplus_f(DT[(size_t)(r0 + t0 + 1) * 32 + h] + bias);
            const float a0 = d0 * A, a1 = d1 * A; float s = a0 + a1;
#pragma unroll
            for (int o = 1; o < 64; o <<= 1) { const float t = __shfl_up(s, o); if (lane >= o) s += t; }
            const float cs1 = s, cs0 = s - a1, tot = __shfl(s, 63);
            csL[wave * 128 + t0] = cs0; csL[wave * 128 + t0 + 1] = cs1;
            scL[wave * 128 + t0] = d0 * __expf(tot - cs0); scL[wave * 128 + t0 + 1] = d1 * __expf(tot - cs1);
            DTB[(size_t)(r0 + t0) * NH + h] = d0; DTB[(size_t)(r0 + t0 + 1) * NH + h] = d1;
            CSB[(size_t)(r0 + t0) * NH + h] = cs0; CSB[(size_t)(r0 + t0 + 1) * NH + h] = cs1;
            if (lane == 0) DEC[(b * NCH + c) * NH + h] = __expf(tot);
        }
        __syncthreads();
        for (int sr_ = 0; sr_ < SUBN(7); ++sr_)
        for (int it = tid; it < 80 * 16; it += NTHR) {
            const int ch8 = it % 80, rr = it / 80, tt0 = rr * 8, j0 = k1_chan(g, ch8);
            float w[4][8], bb[8];
#pragma unroll
            for (int i = 0; i < 4; ++i) { const f32x4 w0 = *(const f32x4*)(cw + i * XBCW + j0), w1 = *(const f32x4*)(cw + i * XBCW + j0 + 4);
#pragma unroll
                for (int j = 0; j < 4; ++j) { w[i][j] = w0[j]; w[i][4 + j] = w1[j]; } }
            { const f32x4 b0 = *(const f32x4*)(cb + j0), b1 = *(const f32x4*)(cb + j0 + 4);
#pragma unroll
              for (int j = 0; j < 4; ++j) { bb[j] = b0[j]; bb[4 + j] = b1[j]; } }
            float xm3[8], xm2[8], xm1[8];
            const bf16* src = P + (size_t)(r0 + tt0) * PW + 2048 + j0;
            const bool has_prev = (c * 128 + tt0) > 0;
            if (has_prev) { unpack8(*(const u32x4*)(src - 3 * PW), xm3); unpack8(*(const u32x4*)(src - 2 * PW), xm2); unpack8(*(const u32x4*)(src - PW), xm1); }
            else {
#pragma unroll
                for (int j = 0; j < 8; ++j) { xm3[j] = 0.f; xm2[j] = 0.f; xm1[j] = 0.f; } }
            float o[8][8];
#pragma unroll
            for (int t = 0; t < 8; ++t) {
                float cur[8]; unpack8(*(const u32x4*)(src + (size_t)t * PW), cur);
#pragma unroll
                for (int j = 0; j < 8; ++j) o[t][j] = silu_f(bb[j] + w[0][j] * xm3[j] + w[1][j] * xm2[j] + w[2][j] * xm1[j] + w[3][j] * cur[j]);
                *(u32x4*)(XC + (size_t)(r0 + tt0 + t) * XBCW + j0) = pack8(o[t]);
#pragma unroll
                for (int j = 0; j < 8; ++j) { xm3[j] = xm2[j]; xm2[j] = xm1[j]; xm1[j] = cur[j]; }
            }
            if (ch8 < 48) { const int hh = ch8 >> 3, p0 = 8 * (ch8 & 7);
                const f32x4 s0 = *(const LAS f32x4*)(scL + hh * 128 + tt0), s1 = *(const LAS f32x4*)(scL + hh * 128 + tt0 + 4);
                bf16* xt = XT + ((size_t)(b * NCH + c) * NH + HPG * g + hh) * (HD * DS) + (size_t)p0 * 128 + tt0;
#pragma unroll
                for (int j = 0; j < 8; ++j) { const int R = hh * 64 + p0 + j;
                    u32x4 wu; wu.x = pk2(o[0][j], o[1][j]); wu.y = pk2(o[2][j], o[3][j]); wu.z = pk2(o[4][j], o[5][j]); wu.w = pk2(o[6][j], o[7][j]);
                    *(u32x4*)(xt + j * 128) = wu;
                    u32x4 ws; ws.x = pk2(o[0][j] * s0[0], o[1][j] * s0[1]); ws.y = pk2(o[2][j] * s0[2], o[3][j] * s0[3]); ws.z = pk2(o[4][j] * s1[0], o[5][j] * s1[1]); ws.w = pk2(o[6][j] * s1[2], o[7][j] * s1[3]);
                    *(LAS u32x4*)(xdT + R * LSTR + 8 * (rr ^ ((R >> 3) & 15))) = ws; }
            } else if (ch8 < 64) { const int n0 = 8 * (ch8 - 48);
#pragma unroll
                for (int j = 0; j < 8; ++j) { const int R = n0 + j;
                    u32x4 wu; wu.x = pk2(o[0][j], o[1][j]); wu.y = pk2(o[2][j], o[3][j]); wu.z = pk2(o[4][j], o[5][j]); wu.w = pk2(o[6][j], o[7][j]);
                    *(LAS u32x4*)(BT + R * LSTR + 8 * (rr ^ ((R >> 3) & 15))) = wu; }
            }
        }
        if (c == NCH - 1) {
            float* o = a.out + O_CP + ((size_t)l * NBP + b) * 3 * XBCW;
            for (int it = tid; it < 3 * 640; it += NTHR) { const int i = it / 640, cc = it % 640, j = k1_chan(g, cc >> 3) + (cc & 7);
                o[i * XBCW + j] = bf1(P[(size_t)(r0 + 125 + i) * PW + 2048 + j]); }
        }
        __syncthreads();
        for (int sr_ = 0; sr_ < SUBN(8); ++sr_)
#pragma unroll 1
        for (int hh = 0; hh < HPG; ++hh) {
            f32x4 acc[4];
#pragma unroll
            for (int pt = 0; pt < 4; ++pt) acc[pt] = (f32x4){0.f, 0.f, 0.f, 0.f};
#pragma unroll
            for (int ks = 0; ks < 4; ++ks) {
                const int Rb = 16 * wave + fr; const bf16x8 bfr = *(const LAS bf16x8*)(BT + Rb * LSTR + 8 * ((4 * ks + q) ^ ((Rb >> 3) & 15)));
#pragma unroll
                for (int pt = 0; pt < 4; ++pt) { const int Ra = hh * 64 + 16 * pt + fr; const bf16x8 afr = *(const LAS bf16x8*)(xdT + Ra * LSTR + 8 * ((4 * ks + q) ^ ((Ra >> 3) & 15)));
                    acc[pt] = MFMA16(bfr, afr, acc[pt]); }
            }
            float* so = S + ((size_t)(b * NCH + c) * NH + HPG * g + hh) * (HD * DS) + 16 * wave + 4 * q;
#pragma unroll
            for (int pt = 0; pt < 4; ++pt) *(f32x4*)(so + (size_t)(16 * pt + fr) * DS) = acc[pt];
        }
        __syncthreads();
    }
    for (int sr_ = 0; sr_ < SUBN(5); ++sr_)
    {
        const float* st = a.in[5] + (size_t)l * NBS * 3 * XBCW;
        float* oc = a.out + O_CS + (size_t)l * NBS * 3 * XBCW;
        for (int it = blockIdx.x * NTHR + tid; it < NBS * (XBCW / 8); it += G * NTHR) {
            const int bs = it / (XBCW / 8), j0 = (it % (XBCW / 8)) * 8, rs0 = NPR + 4 * bs;
            float full[7][8];
#pragma unroll
            for (int i = 0; i < 3; ++i) { const f32x4 p0 = *(const f32x4*)(st + ((size_t)bs * 3 + i) * XBCW + j0), p1 = *(const f32x4*)(st + ((size_t)bs * 3 + i) * XBCW + j0 + 4);
#pragma unroll
                for (int j = 0; j < 4; ++j) { full[i][j] = p0[j]; full[i][4 + j] = p1[j]; } }
#pragma unroll
            for (int t = 0; t < 4; ++t) unpack8(*(const u32x4*)(P + (size_t)(rs0 + t) * PW + 2048 + j0), full[3 + t]);
            float w[4][8], bb[8];
#pragma unroll
            for (int i = 0; i < 4; ++i) { const f32x4 w0 = *(const f32x4*)(cw + i * XBCW + j0), w1 = *(const f32x4*)(cw + i * XBCW + j0 + 4);
#pragma unroll
                for (int j = 0; j < 4; ++j) { w[i][j] = w0[j]; w[i][4 + j] = w1[j]; } }
            { const f32x4 b0 = *(const f32x4*)(cb + j0), b1 = *(const f32x4*)(cb + j0 + 4);
#pragma unroll
              for (int j = 0; j < 4; ++j) { bb[j] = b0[j]; bb[4 + j] = b1[j]; } }
#pragma unroll
            for (int t = 0; t < 4; ++t) { float o[8];
#pragma unroll
                for (int j = 0; j < 8; ++j) o[j] = silu_f(bb[j] + w[0][j] * full[t][j] + w[1][j] * full[t + 1][j] + w[2][j] * full[t + 2][j] + w[3][j] * full[t + 3][j]);
                *(u32x4*)(XC + (size_t)(rs0 + t) * XBCW + j0) = pack8(o); }
#pragma unroll
            for (int i = 0; i < 3; ++i) { float* o = oc + ((size_t)bs * 3 + i) * XBCW + j0;
                *(f32x4*)o = (f32x4){full[4 + i][0], full[4 + i][1], full[4 + i][2], full[4 + i][3]}; *(f32x4*)(o + 4) = (f32x4){full[4 + i][4], full[4 + i][5], full[4 + i][6], full[4 + i][7]}; }
        }
        for (int it = blockIdx.x * NTHR + tid; it < NSR * NH; it += G * NTHR) { const int r = NPR + it / NH, h = it % NH;
            DTB[(size_t)r * NH + h] = softplus_f(DT[(size_t)r * 32 + h] + dtb[h]); }
    }
}

__device__ __forceinline__ void k2_phase(const Args& a, int l, int G) {
    unsigned char* ws_ = a.ws; asm volatile("" : "+s"(ws_));
    int tid_ = threadIdx.x; asm volatile("" : "+v"(tid_)); const int tid = tid_, lane = tid & 63, wave = tid >> 6, q = lane >> 4, fr = lane & 15;
    const float* S = (const float*)(ws_ + WS_S); const float* DEC = (const float*)(ws_ + WS_DEC); bf16* HS = (bf16*)(ws_ + WS_HS);
    for (int sr_ = 0; sr_ < SUBN(0); ++sr_)
    for (int it = blockIdx.x * NTHR + tid; it < NBP * NH * (HD * DS / 4); it += G * NTHR) {
        const int bh = it / (HD * DS / 4), e = (it % (HD * DS / 4)) * 4, b = bh / NH, h = bh % NH;
        const size_t o0 = ((size_t)(b * NCH) * NH + h) * (HD * DS) + e; constexpr size_t cstr = (size_t)NH * HD * DS;
        f32x4 sv[NCH]; float dv[NCH];
#pragma unroll
        for (int c = 0; c < NCH; ++c) { sv[c] = *(const f32x4*)(S + o0 + c * cstr); dv[c] = DEC[(b * NCH + c) * NH + h]; }
        f32x4 H = (f32x4){0.f, 0.f, 0.f, 0.f};
#pragma unroll
        for (int c = 0; c < NCH; ++c) { u32x2 w; w.x = pk2(H[0], H[1]); w.y = pk2(H[2], H[3]); *(u32x2*)(HS + o0 + c * cstr) = w; H = H * dv[c] + sv[c]; }
        *(f32x4*)(a.out + O_SP + (((size_t)l * NBP + b) * NH + h) * (HD * DS) + e) = H;
    }
    const bf16* XC = (const bf16*)(ws_ + WS_XC); const bf16* P = (const bf16*)(ws_ + WS_P); const float* DTB = (const float*)(ws_ + WS_DTB);
    bf16* MIX = (bf16*)(ws_ + WS_MIX); float* SSQ2 = (float*)(ws_ + WS_SSQ2);
    const float* alog = a.in[18] + l * NH; const float* dsk = a.in[19] + l * NH;
    const int ustep = G * NWAVES;
    f32x4 hv0[4], hv1[4];
    { const int u = blockIdx.x * NWAVES + wave;
      if (u < NBS * NH * 4) { const float* h0 = a.in[6] + ((size_t)l * NBS * NH + (u >> 2)) * (HD * DS) + (size_t)(16 * (u & 3) + fr) * DS + 8 * q;
#pragma unroll
        for (int ks = 0; ks < 4; ++ks) { hv0[ks] = __builtin_nontemporal_load((const f32x4*)(h0 + 32 * ks)); hv1[ks] = __builtin_nontemporal_load((const f32x4*)(h0 + 32 * ks + 4)); } } }
    for (int u = blockIdx.x * NWAVES + wave; u < NBS * NH * 4; u += ustep) {
        const int pt = u & 3, bh = u >> 2, bs = bh / NH, h = bh % NH, g = h / HPG, rs0 = NPR + 4 * bs;
        const int p = 16 * pt + fr;
        f32x4 nx0[4], nx1[4];
        { const int un = (u + ustep < NBS * NH * 4) ? u + ustep : u;
          const float* h0 = a.in[6] + ((size_t)l * NBS * NH + (un >> 2)) * (HD * DS) + (size_t)(16 * (un & 3) + fr) * DS + 8 * q;
#pragma unroll
          for (int ks = 0; ks < 4; ++ks) { nx0[ks] = __builtin_nontemporal_load((const f32x4*)(h0 + 32 * ks)); nx1[ks] = __builtin_nontemporal_load((const f32x4*)(h0 + 32 * ks + 4)); } }
        const float A = -__expf(alog[h]), Dh = dsk[h];
        float dt[4], cs[4]; { float s = 0.f;
#pragma unroll
            for (int t = 0; t < 4; ++t) { dt[t] = DTB[(size_t)(rs0 + t) * NH + h]; s += dt[t] * A; cs[t] = s; } }
        bf16x8 cfr[4]; u32x4 brow[4];
#pragma unroll
        for (int ks = 0; ks < 4; ++ks) { u32x4 z = (u32x4){0u, 0u, 0u, 0u}, zb = z;
            if (fr < 4) { z = *(const u32x4*)(XC + (size_t)(rs0 + fr) * XBCW + SSDW + 512 + 128 * g + 32 * ks + 8 * q); zb = *(const u32x4*)(XC + (size_t)(rs0 + fr) * XBCW + SSDW + 128 * g + 32 * ks + 8 * q); }
            cfr[ks] = as_frag(z); brow[ks] = zb; }
        float xs[4];
#pragma unroll
        for (int s = 0; s < 4; ++s) xs[s] = bf1(XC[(size_t)(rs0 + s) * XBCW + h * HD + p]);
        f32x4 cb4 = (f32x4){0.f, 0.f, 0.f, 0.f};
#pragma unroll
        for (int ks = 0; ks < 4; ++ks) cb4 = MFMA16(cfr[ks], as_frag(brow[ks]), cb4);
        float Wm[4][4];
#pragma unroll
        for (int t = 0; t < 4; ++t)
#pragma unroll
            for (int s = 0; s < 4; ++s) Wm[t][s] = (s <= t) ? __int_as_float(__builtin_amdgcn_readlane(__float_as_int(cb4[t]), s)) * __expf(cs[t] - cs[s]) * dt[s] : 0.f;
        float cx[4];
#pragma unroll
        for (int s = 0; s < 4; ++s) cx[s] = dt[s] * __expf(cs[3] - cs[s]) * xs[s];
        const float e3 = __expf(cs[3]);
        float* hn = a.out + O_SS + (((size_t)l * NBS + bs) * NH + h) * (HD * DS) + (size_t)p * DS + 8 * q;
        f32x4 yo = (f32x4){0.f, 0.f, 0.f, 0.f};
#pragma unroll
        for (int ks = 0; ks < 4; ++ks) {
            float hv[8] = {hv0[ks][0], hv0[ks][1], hv0[ks][2], hv0[ks][3], hv1[ks][0], hv1[ks][1], hv1[ks][2], hv1[ks][3]}, nv[8];
#pragma unroll
            for (int j = 0; j < 8; ++j) nv[j] = e3 * hv[j];
#pragma unroll
            for (int s = 0; s < 4; ++s) { u32x4 bw; bw.x = __shfl(brow[ks].x, 16 * q + s); bw.y = __shfl(brow[ks].y, 16 * q + s); bw.z = __shfl(brow[ks].z, 16 * q + s); bw.w = __shfl(brow[ks].w, 16 * q + s);
                float bvv[8]; unpack8(bw, bvv);
#pragma unroll
                for (int j = 0; j < 8; ++j) nv[j] += cx[s] * bvv[j]; }
            __builtin_nontemporal_store((f32x4){nv[0], nv[1], nv[2], nv[3]}, (f32x4*)(hn + 32 * ks)); __builtin_nontemporal_store((f32x4){nv[4], nv[5], nv[6], nv[7]}, (f32x4*)(hn + 32 * ks + 4));
            yo = MFMA16(cfr[ks], as_frag(pack8(hv)), yo);
        }
        float ysq[4];
#pragma unroll
        for (int t = 0; t < 4; ++t) {
            float y = __expf(cs[t]) * yo[t] + Dh * xs[t];
#pragma unroll
            for (int s = 0; s < 4; ++s) if (s <= t) y += Wm[t][s] * xs[s];
            const float z = bf1(P[(size_t)(rs0 + t) * PW + POOLW + h * HD + p]);
            const float yg = y * silu_f(z);
            if (lane < 16) MIX[(size_t)(rs0 + t) * DM + POOLW + h * HD + p] = f2bf(yg);
            ysq[t] = lane < 16 ? yg * yg : 0.f;
        }
#pragma unroll
        for (int t = 0; t < 4; ++t) { float s = ysq[t]; s += __shfl_xor(s, 1); s += __shfl_xor(s, 2); s += __shfl_xor(s, 4); s += __shfl_xor(s, 8);
            if (lane == 0) SSQ2[(size_t)(rs0 - NPR + t) * (NH * 4) + h * 4 + pt] = s; }
#pragma unroll
        for (int ks = 0; ks < 4; ++ks) { hv0[ks] = nx0[ks]; hv1[ks] = nx1[ks]; }
    }
}

__device__ __forceinline__ void k3_phase(const Args& a, int l, LAS unsigned char* lds, int G) {
    unsigned char* ws_ = a.ws; asm volatile("" : "+s"(ws_));
    int tid_ = threadIdx.x; asm volatile("" : "+v"(tid_)); const int tid = tid_, lane = tid & 63, wave = __builtin_amdgcn_readfirstlane(tid >> 6), q = lane >> 4, fr = lane & 15;
    const bf16* XC = (const bf16*)(ws_ + WS_XC); const bf16* P = (const bf16*)(ws_ + WS_P); const bf16* XT = (const bf16*)(ws_ + WS_XT);
    const float* DTB = (const float*)(ws_ + WS_DTB); const float* CSB = (const float*)(ws_ + WS_CSB); const bf16* HS = (const bf16*)(ws_ + WS_HS);
    bf16* MIX = (bf16*)(ws_ + WS_MIX); float* SSQ = (float*)(ws_ + WS_SSQ);
    const float* dsk = a.in[19] + l * NH;
    LAS bf16* Cs = (LAS bf16*)lds;
    LAS bf16* Bs = Cs + 128 * LSTR;
    LAS bf16* Ms = Bs + 128 * LSTR;
    LAS float* csL = (LAS float*)(Ms + 8 * 16 * LSTR);
    LAS float* dtL = csL + 6 * 128;
    for (int u = blockIdx.x; u < NBP * NCH * NG; u += G) {
        const int b = u >> 6, c = (u >> 2) & 15, g = u & 3, r0 = b * SEQ + c * 128;
        for (int it = tid; it < 2 * 128 * 16; it += NTHR) { const int m = it >> 11, row = (it >> 4) & 127, k8 = (it & 15) * 8;
            const u32x4 v = *(const u32x4*)(XC + (size_t)(r0 + row) * XBCW + SSDW + (m ? 0 : 512) + 128 * g + k8);
            *(LAS u32x4*)((m ? Bs : Cs) + row * LSTR + k8) = v; }
        for (int it = tid; it < 6 * 128; it += NTHR) { const int hh = it >> 7, t = it & 127;
            csL[it] = CSB[(size_t)(r0 + t) * NH + HPG * g + hh]; dtL[it] = DTB[(size_t)(r0 + t) * NH + HPG * g + hh]; }
        __syncthreads();
        bf16x8 cf[4];
#pragma unroll
        for (int ks = 0; ks < 4; ++ks) cf[ks] = *(const LAS bf16x8*)(Cs + (16 * wave + fr) * LSTR + 32 * ks + 8 * q);
        f32x4 gacc[8];
#pragma unroll
        for (int st = 0; st < 8; ++st) { gacc[st] = (f32x4){0.f, 0.f, 0.f, 0.f};
            if (st <= wave) {
#pragma unroll
                for (int ks = 0; ks < 4; ++ks) { const bf16x8 bfr = *(const LAS bf16x8*)(Bs + (16 * st + fr) * LSTR + 32 * ks + 8 * q); gacc[st] = MFMA16(bfr, cf[ks], gacc[st]); } } }
        const int lrow = 16 * wave + fr, row = r0 + lrow;
        for (int sr_ = 0; sr_ < SUBN(10); ++sr_)
#pragma unroll 1
        for (int hh = 0; hh < HPG; ++hh) {
            const int h = HPG * g + hh;
            const bf16* hs = HS + ((size_t)(b * NCH + c) * NH + h) * (HD * DS) + (size_t)fr * DS + 8 * q;
            const bf16* xt = XT + ((size_t)(b * NCH + c) * NH + h) * (HD * DS) + (size_t)fr * 128 + 8 * q;
            u32x4 hf[4][4];
#pragma unroll
            for (int ks = 0; ks < 4; ++ks)
#pragma unroll
                for (int pt = 0; pt < 4; ++pt) hf[ks][pt] = *(const u32x4*)(hs + (size_t)(16 * pt) * DS + 32 * ks);
            u32x2 xw[4], zw[4];
#pragma unroll
            for (int pt = 0; pt < 4; ++pt) { xw[pt] = *(const u32x2*)(XC + (size_t)row * XBCW + h * HD + 16 * pt + 4 * q); zw[pt] = *(const u32x2*)(P + (size_t)row * PW + POOLW + h * HD + 16 * pt + 4 * q); }
            const float csl = csL[hh * 128 + lrow];
#pragma unroll
            for (int st = 0; st < 8; ++st) {
                if (st <= (wave | 1)) { float mv[4];
#pragma unroll
                    for (int r = 0; r < 4; ++r) { const int s = 16 * st + 4 * q + r;
                        mv[r] = (st <= wave && s <= lrow) ? gacc[st][r] * __expf(csl - csL[hh * 128 + s]) * dtL[hh * 128 + s] : 0.f; }
                    u32x2 w; w.x = pk2(mv[0], mv[1]); w.y = pk2(mv[2], mv[3]);
                    *(LAS u32x2*)(Ms + (wave * 16 + fr) * LSTR + 16 * st + 4 * q) = w; } }
            f32x4 y1[4], y2[4];
#pragma unroll
            for (int pt = 0; pt < 4; ++pt) { y1[pt] = (f32x4){0.f, 0.f, 0.f, 0.f}; y2[pt] = (f32x4){0.f, 0.f, 0.f, 0.f}; }
#pragma unroll
            for (int ks = 0; ks < 4; ++ks)
#pragma unroll
                for (int pt = 0; pt < 4; ++pt) y2[pt] = MFMA16(as_frag(hf[ks][pt]), cf[ks], y2[pt]);
#pragma unroll
            for (int ks = 0; ks < 4; ++ks) {
                if (2 * ks <= wave) {
                    u32x4 xf[4];
#pragma unroll
                    for (int pt = 0; pt < 4; ++pt) xf[pt] = *(const u32x4*)(xt + (size_t)(16 * pt) * 128 + 32 * ks);
                    const bf16x8 mfr = *(const LAS bf16x8*)(Ms + (wave * 16 + fr) * LSTR + 32 * ks + 8 * q);
#pragma unroll
                    for (int pt = 0; pt < 4; ++pt) y1[pt] = MFMA16(as_frag(xf[pt]), mfr, y1[pt]); } }
            const float ecs = __expf(csl), Dh = dsk[h]; float ss = 0.f;
#pragma unroll
            for (int pt = 0; pt < 4; ++pt) { const int p0 = 16 * pt + 4 * q;
                const float xv[4] = {bflo(xw[pt].x), bfhi(xw[pt].x), bflo(xw[pt].y), bfhi(xw[pt].y)}, zv[4] = {bflo(zw[pt].x), bfhi(zw[pt].x), bflo(zw[pt].y), bfhi(zw[pt].y)}; float yg[4];
#pragma unroll
                for (int r = 0; r < 4; ++r) { const float y = y1[pt][r] + ecs * y2[pt][r] + Dh * xv[r]; yg[r] = y * silu_f(zv[r]); ss += yg[r] * yg[r]; }
                u32x2 w; w.x = pk2(yg[0], yg[1]); w.y = pk2(yg[2], yg[3]);
                *(u32x2*)(MIX + (size_t)row * DM + POOLW + h * HD + p0) = w; }
            ss += __shfl_xor(ss, 16); ss += __shfl_xor(ss, 32);
            if (q == 0) SSQ[(size_t)row * NH + h] = ss;
        }
        __syncthreads();
    }
}

template <int W> __device__ __forceinline__ float pool_window(const bf16* P, const float* stp, bool prompt, int row, int ch, float (&sum)[8]) {
    if (prompt) { const int pos = row & (SEQ - 1);
#pragma unroll
        for (int i = 1; i < W; ++i) { const bool ok = i <= pos; float v[8]; unpack8(*(const u32x4*)(P + (size_t)(ok ? row - i : row) * PW + ch), v);
#pragma unroll
            for (int j = 0; j < 8; ++j) sum[j] += ok ? v[j] : 0.f; }
        return (float)((pos + 1 < W) ? pos + 1 : W);
    } else { const int seq = (row - NPR) >> 2, t4 = (row - NPR) & 3;
#pragma unroll
        for (int i = 1; i < W; ++i) { float v[8];
            if (t4 - i >= 0) unpack8(*(const u32x4*)(P + (size_t)(row - i) * PW + ch), v);
            else { const float* sp = stp + ((size_t)seq * 15 + (15 + t4 - i)) * POOLW + ch; const f32x4 v0 = *(const f32x4*)sp, v1 = *(const f32x4*)(sp + 4);
                v[0] = v0[0]; v[1] = v0[1]; v[2] = v0[2]; v[3] = v0[3]; v[4] = v1[0]; v[5] = v1[1]; v[6] = v1[2]; v[7] = v1[3]; }
#pragma unroll
            for (int j = 0; j < 8; ++j) sum[j] += v[j]; }
        return (float)W;
    }
}
template <int K> __device__ __forceinline__ float dpp_ror(float v) { return __int_as_float(__builtin_amdgcn_update_dpp(0, __float_as_int(v), 0x120 + K, 0xf, 0xf, false)); }
template <int K> __device__ __forceinline__ void pool_step(float (&C)[8], float (&H)[8], int fr) {
#pragma unroll
    for (int j = 0; j < 8; ++j) { const float rc = dpp_ror<K>(C[j]), rh = dpp_ror<K>(H[j]); const bool in = fr >= K; C[j] += in ? rc : rh; H[j] += in ? rh : 0.f; }
}
template <bool PROMPT> __device__ __forceinline__ void pool_unit(int u, int fr, int q, const bf16* P, const bf16* PWT, bf16* MIX, const float* SSQ, const float* SSQ2, float* R, const float* stp) {
        const int rb = u >> 2, g = u & 3, row = 16 * rb + fr; constexpr bool prompt = PROMPT;
        u32x4 cw[4], hw[4]; const bool has_hist = (rb & 127) != 0;
        if constexpr (prompt) {
#pragma unroll
            for (int ks = 0; ks < 4; ++ks) { const bf16* pp = P + (size_t)row * PW + 128 * g + 32 * ks + 8 * q; cw[ks] = *(const u32x4*)pp;
                hw[ks] = has_hist ? *(const u32x4*)(pp - (size_t)16 * PW) : (u32x4){0u, 0u, 0u, 0u}; }
        }
        float ssum = 0.f;
        if constexpr (prompt) {
#pragma unroll
            for (int i = 0; i < 6; ++i) { const f32x4 v = *(const f32x4*)(SSQ + (size_t)row * NH + 4 * i); ssum += (v[0] + v[1]) + (v[2] + v[3]); }
        } else {
#pragma unroll
            for (int i = 0; i < 24; ++i) { const f32x4 v = *(const f32x4*)(SSQ2 + (size_t)(row - NPR) * (NH * 4) + 4 * i); ssum += (v[0] + v[1]) + (v[2] + v[3]); }
        }
        const float rr = sqrtf(ssum * (1.f / SSDW) + EPS);
        if (g == 0 && q == 0) R[row] = 1.f / rr;
        f32x4 acc[8];
#pragma unroll
        for (int nt = 0; nt < 8; ++nt) acc[nt] = (f32x4){0.f, 0.f, 0.f, 0.f};
        const int W = 2 << g, pos = row & (SEQ - 1);
        if constexpr (prompt) {
#pragma unroll
            for (int ks = 0; ks < 4; ++ks) {
                float C[8], H[8], cur[8], d[8]; unpack8(cw[ks], cur); unpack8(hw[ks], H);
#pragma unroll
                for (int j = 0; j < 8; ++j) C[j] = cur[j];
                pool_step<1>(C, H, fr);
                if (g >= 1) pool_step<2>(C, H, fr);
                if (g >= 2) pool_step<4>(C, H, fr);
                if (g >= 3) pool_step<8>(C, H, fr);
                const float ic = 1.f / (float)((pos + 1 < W) ? pos + 1 : W);
#pragma unroll
                for (int j = 0; j < 8; ++j) d[j] = C[j] * ic - cur[j];
                const bf16x8 dfr = as_frag(pack8(d));
#pragma unroll
                for (int nt = 0; nt < 8; ++nt) { const bf16x8 wfr = as_frag(*(const u32x4*)(PWT + ((size_t)g * 128 + 16 * nt + fr) * 128 + 32 * ks + 8 * q)); acc[nt] = MFMA16(wfr, dfr, acc[nt]); }
                asm volatile("" ::: "memory");
            }
        } else {
#pragma unroll 1
            for (int ks = 0; ks < 4; ++ks) {
                const int ch = 128 * g + 32 * ks + 8 * q; float sum[8], cur[8], d[8]; unpack8(*(const u32x4*)(P + (size_t)row * PW + ch), cur);
#pragma unroll
                for (int j = 0; j < 8; ++j) sum[j] = cur[j];
                float cnt;
                if (g == 0) cnt = pool_window<2>(P, stp, false, row, ch, sum); else if (g == 1) cnt = pool_window<4>(P, stp, false, row, ch, sum);
                else if (g == 2) cnt = pool_window<8>(P, stp, false, row, ch, sum); else cnt = pool_window<16>(P, stp, false, row, ch, sum);
                const float ic = 1.f / cnt;
#pragma unroll
                for (int j = 0; j < 8; ++j) d[j] = sum[j] * ic - cur[j];
                const bf16x8 dfr = as_frag(pack8(d));
#pragma unroll
                for (int nt = 0; nt < 8; ++nt) { const bf16x8 wfr = as_frag(*(const u32x4*)(PWT + ((size_t)g * 128 + 16 * nt + fr) * 128 + 32 * ks + 8 * q)); acc[nt] = MFMA16(wfr, dfr, acc[nt]); }
            }
        }
#pragma unroll
        for (int nt = 0; nt < 8; ++nt) { u32x2 o; o.x = pk2(acc[nt][0] * rr, acc[nt][1] * rr); o.y = pk2(acc[nt][2] * rr, acc[nt][3] * rr);
            *(u32x2*)(MIX + (size_t)row * DM + 128 * g + 16 * nt + 4 * q) = o; }
}
__device__ __forceinline__ void pool_phase(const Args& a, int l, int G) {
    unsigned char* ws_ = a.ws; asm volatile("" : "+s"(ws_));
    int tid_ = threadIdx.x; asm volatile("" : "+v"(tid_)); const int tid = tid_, lane = tid & 63, wave = __builtin_amdgcn_readfirstlane(tid >> 6), q = lane >> 4, fr = lane & 15;
    const bf16* P = (const bf16*)(ws_ + WS_P); const bf16* PWT = (const bf16*)(ws_ + WS_PWT + l * SZ_PWT);
    bf16* MIX = (bf16*)(ws_ + WS_MIX); const float* SSQ = (const float*)(ws_ + WS_SSQ); const float* SSQ2 = (const float*)(ws_ + WS_SSQ2); float* R = (float*)(ws_ + WS_R);
    const float* stp = a.in[4] + (size_t)l * NBS * 15 * POOLW;
    for (int sr_ = 0; sr_ < SUBN(2); ++sr_) {
    for (int u = blockIdx.x * NWAVES + wave; u < (NPR / 16) * 4; u += G * NWAVES) pool_unit<true>(u, fr, q, P, PWT, MIX, SSQ, SSQ2, R, stp);
    if (wave == 0) for (int u = (NPR / 16) * 4 + blockIdx.x; u < (MROWS / 16) * 4; u += G) pool_unit<false>(u, fr, q, P, PWT, MIX, SSQ, SSQ2, R, stp);
    }
    for (int sr_ = 0; sr_ < SUBN(3); ++sr_)
    { float* o = a.out + O_PP + (size_t)l * NBP * 15 * POOLW;
      for (int it = blockIdx.x * NTHR + tid; it < NBP * 15 * (POOLW / 4); it += G * NTHR) { const int b = it / (15 * (POOLW / 4)), i = (it / (POOLW / 4)) % 15, cc = (it % (POOLW / 4)) * 4;
          const u32x2 w = *(const u32x2*)(P + (size_t)(b * SEQ + SEQ - 15 + i) * PW + cc);
          *(f32x4*)(o + (size_t)it * 4) = (f32x4){bflo(w.x), bfhi(w.x), bflo(w.y), bfhi(w.y)}; }
      float* os = a.out + O_PS + (size_t)l * NBS * 15 * POOLW;
      for (int it = blockIdx.x * NTHR + tid; it < NBS * 15 * (POOLW / 4); it += G * NTHR) { const int bs = it / (15 * (POOLW / 4)), i = (it / (POOLW / 4)) % 15, cc = (it % (POOLW / 4)) * 4;
          f32x4 v;
          if (i < 11) v = *(const f32x4*)(stp + ((size_t)bs * 15 + i + 4) * POOLW + cc);
          else { const u32x2 w = *(const u32x2*)(P + (size_t)(NPR + 4 * bs + i - 11) * PW + cc); v = (f32x4){bflo(w.x), bfhi(w.x), bflo(w.y), bfhi(w.y)}; }
          *(f32x4*)(os + (size_t)it * 4) = v; } }
}

__device__ __forceinline__ void ld8(const float* p, float (&d)[8]) { const f32x4 x = *(const f32x4*)p, y = *(const f32x4*)(p + 4); d[0] = x[0]; d[1] = x[1]; d[2] = x[2]; d[3] = x[3]; d[4] = y[0]; d[5] = y[1]; d[6] = y[2]; d[7] = y[3]; }
__device__ __forceinline__ void fx_phase(const Args& a, int l, int G) {
    unsigned char* ws_ = a.ws; asm volatile("" : "+s"(ws_));
    int tid_ = threadIdx.x; asm volatile("" : "+v"(tid_)); const int tid = tid_;
    bf16* ACT = (bf16*)(ws_ + WS_ACT); const float* GH = (const float*)(ws_ + WS_GH); const float* VH = (const float*)(ws_ + WS_VH);
    const float* fw = a.in[23] + (size_t)l * 3 * DFF; const float* fb = a.in[24] + (size_t)l * DFF;
    for (int it = blockIdx.x * NTHR + tid; it < 28 * (DFF / 8); it += G * NTHR) {
        const int ti = it / (DFF / 8), j0 = (it % (DFF / 8)) * 8, pm = (ti / 7) * 8 + 1 + ti % 7;
        float w[3][8], bb[8], gm2[8], gm1[8], g0[8], g1[8], v0[8], v1[8];
        ld8(fw + j0, w[0]); ld8(fw + DFF + j0, w[1]); ld8(fw + 2 * DFF + j0, w[2]); ld8(fb + j0, bb);
        ld8(GH + ((size_t)(pm - 1) * 4 + 2) * DFF + j0, gm2); ld8(GH + ((size_t)(pm - 1) * 4 + 3) * DFF + j0, gm1);
        ld8(GH + ((size_t)pm * 4 + 0) * DFF + j0, g0); ld8(GH + ((size_t)pm * 4 + 1) * DFF + j0, g1);
        ld8(VH + ((size_t)pm * 2 + 0) * DFF + j0, v0); ld8(VH + ((size_t)pm * 2 + 1) * DFF + j0, v1);
        float o0[8], o1[8];
#pragma unroll
        for (int j = 0; j < 8; ++j) { o0[j] = silu_f(bb[j] + w[0][j] * gm2[j] + w[1][j] * gm1[j] + w[2][j] * g0[j]) * v0[j];
                                      o1[j] = silu_f(bb[j] + w[0][j] * gm1[j] + w[1][j] * g0[j] + w[2][j] * g1[j]) * v1[j]; }
        *(u32x4*)(ACT + (size_t)(pm * 256) * DFF + j0) = pack8(o0); *(u32x4*)(ACT + (size_t)(pm * 256 + 1) * DFF + j0) = pack8(o1);
    }
}

constexpr int PH_P0A = 0, PH_P0B = 1, PH_L0 = 2, PH_PER_LAYER = 11, PH_FINAL = PH_L0 + DEPTH * PH_PER_LAYER, N_PHASES = PH_FINAL + 1;
#ifndef N_LAUNCH_MODE
#define N_LAUNCH_MODE 1
#endif

__device__ __forceinline__ int grid_size() { int g = gridDim.x; asm volatile("" : "+s"(g)); return g; }
__global__ void __launch_bounds__(NTHR, 2) fwd_kernel(Args a) {
    extern __shared__ __attribute__((aligned(16))) unsigned char lds_raw[];
    LAS unsigned char* lds = (LAS unsigned char*)lds_raw;
    const int tid = threadIdx.x;
#define G grid_size()
    volatile LAS unsigned* misc = (volatile LAS unsigned*)(lds + LDS_MISC);
    if (tid < 64) misc[tid] = 0u;
    __syncthreads();
    XcdBarrier bar; bar.bar = (unsigned*)(a.ws + WS_CTL) + CW_BAR; bar.x = 0; bar.st = misc + 8;
    const int lo = a.ph_lo, hi = a.ph_hi;
    if (hi - lo > 1) bar = xcd_barrier_post((unsigned*)(a.ws + WS_CTL) + CW_BAR, misc + 8);
#ifndef PH_MASK
#define PH_MASK 0xFFFFFFFFu
#endif
#define EN(b) (((PH_MASK) >> (b)) & 1u)
#ifndef REP_MASK
#define REP_MASK 0u
#endif
#define NREP(b) ((((REP_MASK) >> (b)) & 1u) ? 2 : 1)
#define IN(k) (lo <= (k) && (k) < hi)
#define SEAM(k) do { if ((k) + 1 < hi) xcd_barrier(bar); } while (0)
#define WSBASE ({ unsigned char* w_ = a.ws; asm volatile("" : "+s"(w_)); w_; })
#define WSP(T, off) ((T*)(WSBASE + (off)))
#define LDSL ({ LAS unsigned char* l_ = lds; asm volatile("" : "+s"(l_)); l_; })

    for (int rep_ = 0; rep_ < NREP(0); ++rep_) if (EN(0) && IN(PH_P0A)) { p0a_phase(a, LDSL, G); SEAM(PH_P0A); }
    for (int rep_ = 0; rep_ < NREP(1); ++rep_) if (EN(1) && IN(PH_P0B)) { p0b_phase(a, LDSL, G); SEAM(PH_P0B); }

    { constexpr int l = 0;
        const int pb = PH_L0 + l * PH_PER_LAYER;
#define MODL (WSP(const float, WS_MOD) + (size_t)l * NB * ADA)
#define XIN_P (l == 0 ? a.in[0] : WSP(const float, WS_XA))
#define XIN_S (l == 0 ? a.in[1] : WSP(const float, WS_XA) + (size_t)NPR * DM)
        for (int rep_ = 0; rep_ < NREP(2); ++rep_) if (EN(2) && IN(pb + 0)) { norm_phase(XIN_P, XIN_S, a.in[8] + l * DM, MODL, 0, WSP(bf16, WS_H), G); SEAM(pb + 0); }
        for (int rep_ = 0; rep_ < NREP(3); ++rep_) if (EN(3) && IN(pb + 1)) {
            pg8::Gemm g{WSP(const bf16, WS_H), (const bf16*)(WSBASE + WS_WIN + l * SZ_WIN), MROWS, NINP, DM}; pg8::StaticOrder S; S.init(MROWS, NINP, G, (int)blockIdx.x);
            EpiProj E{WSP(bf16, WS_P), WSP(float, WS_DT)};
            pg8::gemm_phase<EpiProj, pg8::StaticOrder, true, true>(LDSL, g, S, E);
            SEAM(pb + 1);
        }
        for (int rep_ = 0; rep_ < NREP(4); ++rep_) if (EN(4) && IN(pb + 2)) { k1_phase(a, l, LDSL, G); SEAM(pb + 2); }
        for (int rep_ = 0; rep_ < NREP(5); ++rep_) if (EN(5) && IN(pb + 3)) { k2_phase(a, l, G); SEAM(pb + 3); }
        for (int rep_ = 0; rep_ < NREP(6); ++rep_) if (EN(6) && IN(pb + 4)) { k3_phase(a, l, LDSL, G); SEAM(pb + 4); }
        for (int rep_ = 0; rep_ < NREP(7); ++rep_) if (EN(7) && IN(pb + 5)) { pool_phase(a, l, G); SEAM(pb + 5); }
        for (int rep_ = 0; rep_ < NREP(8); ++rep_) if (EN(8) && IN(pb + 6)) {
            pg8::Gemm g{WSP(const bf16, WS_MIX), (const bf16*)(WSBASE + WS_WOUT + l * SZ_WOUT), NPR, DM, DM}; pg8::StaticOrder S; S.init(NPR, DM, G, (int)blockIdx.x);
            EpiRes E{XIN_P, XIN_S, WSP(float, WS_XB), MODL + 2 * DM, WSP(const float, WS_R)};
            pg8::gemm_phase_x<EpiRes, pg8::StaticOrder>(LDSL, g, WSP(const bf16, WS_MIX) + (size_t)NPR * DM, S, E);
            SEAM(pb + 6);
        }
        for (int rep_ = 0; rep_ < NREP(9); ++rep_) if (EN(9) && IN(pb + 7)) { norm_phase(WSP(const float, WS_XB), WSP(const float, WS_XB) + (size_t)NPR * DM, a.in[9] + l * DM, MODL, 3, WSP(bf16, WS_H), G); SEAM(pb + 7); }
        for (int rep_ = 0; rep_ < NREP(10); ++rep_) if (EN(10) && IN(pb + 8)) {
            pg8::Gemm g{WSP(const bf16, WS_H), (const bf16*)(WSBASE + WS_WUP + l * SZ_WUP), MROWS, NUP, DM}; pg8::StaticOrder S; S.init(MROWS, NUP, G, (int)blockIdx.x);
            EpiAct E{WSP(bf16, WS_ACT), WSP(float, WS_GH), WSP(float, WS_VH), a.in[23] + (size_t)l * 3 * DFF, a.in[24] + (size_t)l * DFF, a.in[7] + (size_t)l * NBS * 2 * DFF,
                     a.out + O_FP + (size_t)l * NBP * 2 * DFF, a.out + O_FS + (size_t)l * NBS * 2 * DFF, (LAS float*)(LDSL + LDS_HALO), l};
            pg8::gemm_phase<EpiAct, pg8::StaticOrder, true, true>(LDSL, g, S, E);
            SEAM(pb + 8);
        }
        for (int rep_ = 0; rep_ < NREP(11); ++rep_) if (EN(11) && IN(pb + 9)) { fx_phase(a, l, G); SEAM(pb + 9); }
        for (int rep_ = 0; rep_ < NREP(12); ++rep_) if (EN(12) && IN(pb + 10)) {
            pg8::Gemm g{WSP(const bf16, WS_ACT), (const bf16*)(WSBASE + WS_WDN + l * SZ_WDN), NPR, DM, DFF}; pg8::StaticOrder S; S.init(NPR, DM, G, (int)blockIdx.x);
            EpiRes E{WSP(const float, WS_XB), WSP(const float, WS_XB) + (size_t)NPR * DM, WSP(float, WS_XA), MODL + 5 * DM, nullptr};
            pg8::gemm_phase_x<EpiRes, pg8::StaticOrder>(LDSL, g, WSP(const bf16, WS_ACT) + (size_t)NPR * DFF, S, E);
            SEAM(pb + 10);
        }
    }
    { constexpr int l = 1;
        const int pb = PH_L0 + l * PH_PER_LAYER;
#define MODL (WSP(const float, WS_MOD) + (size_t)l * NB * ADA)
#define XIN_P (l == 0 ? a.in[0] : WSP(const float, WS_XA))
#define XIN_S (l == 0 ? a.in[1] : WSP(const float, WS_XA) + (size_t)NPR * DM)
        for (int rep_ = 0; rep_ < NREP(2); ++rep_) if (EN(2) && IN(pb + 0)) { norm_phase(XIN_P, XIN_S, a.in[8] + l * DM, MODL, 0, WSP(bf16, WS_H), G); SEAM(pb + 0); }
        for (int rep_ = 0; rep_ < NREP(3); ++rep_) if (EN(3) && IN(pb + 1)) {
            pg8::Gemm g{WSP(const bf16, WS_H), (const bf16*)(WSBASE + WS_WIN + l * SZ_WIN), MROWS, NINP, DM}; pg8::StaticOrder S; S.init(MROWS, NINP, G, (int)blockIdx.x);
            EpiProj E{WSP(bf16, WS_P), WSP(float, WS_DT)};
            pg8::gemm_phase<EpiProj, pg8::StaticOrder, true, true>(LDSL, g, S, E);
            SEAM(pb + 1);
        }
        for (int rep_ = 0; rep_ < NREP(4); ++rep_) if (EN(4) && IN(pb + 2)) { k1_phase(a, l, LDSL, G); SEAM(pb + 2); }
        for (int rep_ = 0; rep_ < NREP(5); ++rep_) if (EN(5) && IN(pb + 3)) { k2_phase(a, l, G); SEAM(pb + 3); }
        for (int rep_ = 0; rep_ < NREP(6); ++rep_) if (EN(6) && IN(pb + 4)) { k3_phase(a, l, LDSL, G); SEAM(pb + 4); }
        for (int rep_ = 0; rep_ < NREP(7); ++rep_) if (EN(7) && IN(pb + 5)) { pool_phase(a, l, G); SEAM(pb + 5); }
        for (int rep_ = 0; rep_ < NREP(8); ++rep_) if (EN(8) && IN(pb + 6)) {
            pg8::Gemm g{WSP(const bf16, WS_MIX), (const bf16*)(WSBASE + WS_WOUT + l * SZ_WOUT), NPR, DM, DM}; pg8::StaticOrder S; S.init(NPR, DM, G, (int)blockIdx.x);
            EpiRes E{XIN_P, XIN_S, WSP(float, WS_XB), MODL + 2 * DM, WSP(const float, WS_R)};
            pg8::gemm_phase_x<EpiRes, pg8::StaticOrder>(LDSL, g, WSP(const bf16, WS_MIX) + (size_t)NPR * DM, S, E);
            SEAM(pb + 6);
        }
        for (int rep_ = 0; rep_ < NREP(9); ++rep_) if (EN(9) && IN(pb + 7)) { norm_phase(WSP(const float, WS_XB), WSP(const float, WS_XB) + (size_t)NPR * DM, a.in[9] + l * DM, MODL, 3, WSP(bf16, WS_H), G); SEAM(pb + 7); }
        for (int rep_ = 0; rep_ < NREP(10); ++rep_) if (EN(10) && IN(pb + 8)) {
            pg8::Gemm g{WSP(const bf16, WS_H), (const bf16*)(WSBASE + WS_WUP + l * SZ_WUP), MROWS, NUP, DM}; pg8::StaticOrder S; S.init(MROWS, NUP, G, (int)blockIdx.x);
            EpiAct E{WSP(bf16, WS_ACT), WSP(float, WS_GH), WSP(float, WS_VH), a.in[23] + (size_t)l * 3 * DFF, a.in[24] + (size_t)l * DFF, a.in[7] + (size_t)l * NBS * 2 * DFF,
                     a.out + O_FP + (size_t)l * NBP * 2 * DFF, a.out + O_FS + (size_t)l * NBS * 2 * DFF, (LAS float*)(LDSL + LDS_HALO), l};
            pg8::gemm_phase<EpiAct, pg8::StaticOrder, true, true>(LDSL, g, S, E);
            SEAM(pb + 8);
        }
        for (int rep_ = 0; rep_ < NREP(11); ++rep_) if (EN(11) && IN(pb + 9)) { fx_phase(a, l, G); SEAM(pb + 9); }
        for (int rep_ = 0; rep_ < NREP(12); ++rep_) if (EN(12) && IN(pb + 10)) {
            pg8::Gemm g{WSP(const bf16, WS_ACT), (const bf16*)(WSBASE + WS_WDN + l * SZ_WDN), NPR, DM, DFF}; pg8::StaticOrder S; S.init(NPR, DM, G, (int)blockIdx.x);
            EpiRes E{WSP(const float, WS_XB), WSP(const float, WS_XB) + (size_t)NPR * DM, WSP(float, WS_XA), MODL + 5 * DM, nullptr};
            pg8::gemm_phase_x<EpiRes, pg8::StaticOrder>(LDSL, g, WSP(const bf16, WS_ACT) + (size_t)NPR * DFF, S, E);
            SEAM(pb + 10);
        }
    }
    { constexpr int l = 2;
        const int pb = PH_L0 + l * PH_PER_LAYER;
#define MODL (WSP(const float, WS_MOD) + (size_t)l * NB * ADA)
#define XIN_P (l == 0 ? a.in[0] : WSP(const float, WS_XA))
#define XIN_S (l == 0 ? a.in[1] : WSP(const float, WS_XA) + (size_t)NPR * DM)
        for (int rep_ = 0; rep_ < NREP(2); ++rep_) if (EN(2) && IN(pb + 0)) { norm_phase(XIN_P, XIN_S, a.in[8] + l * DM, MODL, 0, WSP(bf16, WS_H), G); SEAM(pb + 0); }
        for (int rep_ = 0; rep_ < NREP(3); ++rep_) if (EN(3) && IN(pb + 1)) {
            pg8::Gemm g{WSP(const bf16, WS_H), (const bf16*)(WSBASE + WS_WIN + l * SZ_WIN), MROWS, NINP, DM}; pg8::StaticOrder S; S.init(MROWS, NINP, G, (int)blockIdx.x);
            EpiProj E{WSP(bf16, WS_P), WSP(float, WS_DT)};
            pg8::gemm_phase<EpiProj, pg8::StaticOrder, true, true>(LDSL, g, S, E);
            SEAM(pb + 1);
        }
        for (int rep_ = 0; rep_ < NREP(4); ++rep_) if (EN(4) && IN(pb + 2)) { k1_phase(a, l, LDSL, G); SEAM(pb + 2); }
        for (int rep_ = 0; rep_ < NREP(5); ++rep_) if (EN(5) && IN(pb + 3)) { k2_phase(a, l, G); SEAM(pb + 3); }
        for (int rep_ = 0; rep_ < NREP(6); ++rep_) if (EN(6) && IN(pb + 4)) { k3_phase(a, l, LDSL, G); SEAM(pb + 4); }
        for (int rep_ = 0; rep_ < NREP(7); ++rep_) if (EN(7) && IN(pb + 5)) { pool_phase(a, l, G); SEAM(pb + 5); }
        for (int rep_ = 0; rep_ < NREP(8); ++rep_) if (EN(8) && IN(pb + 6)) {
            pg8::Gemm g{WSP(const bf16, WS_MIX), (const bf16*)(WSBASE + WS_WOUT + l * SZ_WOUT), NPR, DM, DM}; pg8::StaticOrder S; S.init(NPR, DM, G, (int)blockIdx.x);
            EpiRes E{XIN_P, XIN_S, WSP(float, WS_XB), MODL + 2 * DM, WSP(const float, WS_R)};
            pg8::gemm_phase_x<EpiRes, pg8::StaticOrder>(LDSL, g, WSP(const bf16, WS_MIX) + (size_t)NPR * DM, S, E);
            SEAM(pb + 6);
        }
        for (int rep_ = 0; rep_ < NREP(9); ++rep_) if (EN(9) && IN(pb + 7)) { norm_phase(WSP(const float, WS_XB), WSP(const float, WS_XB) + (size_t)NPR * DM, a.in[9] + l * DM, MODL, 3, WSP(bf16, WS_H), G); SEAM(pb + 7); }
        for (int rep_ = 0; rep_ < NREP(10); ++rep_) if (EN(10) && IN(pb + 8)) {
            pg8::Gemm g{WSP(const bf16, WS_H), (const bf16*)(WSBASE + WS_WUP + l * SZ_WUP), MROWS, NUP, DM}; pg8::StaticOrder S; S.init(MROWS, NUP, G, (int)blockIdx.x);
            EpiAct E{WSP(bf16, WS_ACT), WSP(float, WS_GH), WSP(float, WS_VH), a.in[23] + (size_t)l * 3 * DFF, a.in[24] + (size_t)l * DFF, a.in[7] + (size_t)l * NBS * 2 * DFF,
                     a.out + O_FP + (size_t)l * NBP * 2 * DFF, a.out + O_FS + (size_t)l * NBS * 2 * DFF, (LAS float*)(LDSL + LDS_HALO), l};
            pg8::gemm_phase<EpiAct, pg8::StaticOrder, true, true>(LDSL, g, S, E);
            SEAM(pb + 8);
        }
        for (int rep_ = 0; rep_ < NREP(11); ++rep_) if (EN(11) && IN(pb + 9)) { fx_phase(a, l, G); SEAM(pb + 9); }
        for (int rep_ = 0; rep_ < NREP(12); ++rep_) if (EN(12) && IN(pb + 10)) {
            pg8::Gemm g{WSP(const bf16, WS_ACT), (const bf16*)(WSBASE + WS_WDN + l * SZ_WDN), NPR, DM, DFF}; pg8::StaticOrder S; S.init(NPR, DM, G, (int)blockIdx.x);
            EpiRes E{WSP(const float, WS_XB), WSP(const float, WS_XB) + (size_t)NPR * DM, WSP(float, WS_XA), MODL + 5 * DM, nullptr};
            pg8::gemm_phase_x<EpiRes, pg8::StaticOrder>(LDSL, g, WSP(const bf16, WS_ACT) + (size_t)NPR * DFF, S, E);
            SEAM(pb + 10);
        }
    }
    { constexpr int l = 3;
        const int pb = PH_L0 + l * PH_PER_LAYER;
#define MODL (WSP(const float, WS_MOD) + (size_t)l * NB * ADA)
#define XIN_P (l == 0 ? a.in[0] : WSP(const float, WS_XA))
#define XIN_S (l == 0 ? a.in[1] : WSP(const float, WS_XA) + (size_t)NPR * DM)
        for (int rep_ = 0; rep_ < NREP(2); ++rep_) if (EN(2) && IN(pb + 0)) { norm_phase(XIN_P, XIN_S, a.in[8] + l * DM, MODL, 0, WSP(bf16, WS_H), G); SEAM(pb + 0); }
        for (int rep_ = 0; rep_ < NREP(3); ++rep_) if (EN(3) && IN(pb + 1)) {
            pg8::Gemm g{WSP(const bf16, WS_H), (const bf16*)(WSBASE + WS_WIN + l * SZ_WIN), MROWS, NINP, DM}; pg8::StaticOrder S; S.init(MROWS, NINP, G, (int)blockIdx.x);
            EpiProj E{WSP(bf16, WS_P), WSP(float, WS_DT)};
            pg8::gemm_phase<EpiProj, pg8::StaticOrder, true, true>(LDSL, g, S, E);
            SEAM(pb + 1);
        }
        for (int rep_ = 0; rep_ < NREP(4); ++rep_) if (EN(4) && IN(pb + 2)) { k1_phase(a, l, LDSL, G); SEAM(pb + 2); }
        for (int rep_ = 0; rep_ < NREP(5); ++rep_) if (EN(5) && IN(pb + 3)) { k2_phase(a, l, G); SEAM(pb + 3); }
        for (int rep_ = 0; rep_ < NREP(6); ++rep_) if (EN(6) && IN(pb + 4)) { k3_phase(a, l, LDSL, G); SEAM(pb + 4); }
        for (int rep_ = 0; rep_ < NREP(7); ++rep_) if (EN(7) && IN(pb + 5)) { pool_phase(a, l, G); SEAM(pb + 5); }
        for (int rep_ = 0; rep_ < NREP(8); ++rep_) if (EN(8) && IN(pb + 6)) {
            pg8::Gemm g{WSP(const bf16, WS_MIX), (const bf16*)(WSBASE + WS_WOUT + l * SZ_WOUT), NPR, DM, DM}; pg8::StaticOrder S; S.init(NPR, DM, G, (int)blockIdx.x);
            EpiRes E{XIN_P, XIN_S, WSP(float, WS_XB), MODL + 2 * DM, WSP(const float, WS_R)};
            pg8::gemm_phase_x<EpiRes, pg8::StaticOrder>(LDSL, g, WSP(const bf16, WS_MIX) + (size_t)NPR * DM, S, E);
            SEAM(pb + 6);
        }
        for (int rep_ = 0; rep_ < NREP(9); ++rep_) if (EN(9) && IN(pb + 7)) { norm_phase(WSP(const float, WS_XB), WSP(const float, WS_XB) + (size_t)NPR * DM, a.in[9] + l * DM, MODL, 3, WSP(bf16, WS_H), G); SEAM(pb + 7); }
        for (int rep_ = 0; rep_ < NREP(10); ++rep_) if (EN(10) && IN(pb + 8)) {
            pg8::Gemm g{WSP(const bf16, WS_H), (const bf16*)(WSBASE + WS_WUP + l * SZ_WUP), MROWS, NUP, DM}; pg8::StaticOrder S; S.init(MROWS, NUP, G, (int)blockIdx.x);
            EpiAct E{WSP(bf16, WS_ACT), WSP(float, WS_GH), WSP(float, WS_VH), a.in[23] + (size_t)l * 3 * DFF, a.in[24] + (size_t)l * DFF, a.in[7] + (size_t)l * NBS * 2 * DFF,
                     a.out + O_FP + (size_t)l * NBP * 2 * DFF, a.out + O_FS + (size_t)l * NBS * 2 * DFF, (LAS float*)(LDSL + LDS_HALO), l};
            pg8::gemm_phase<EpiAct, pg8::StaticOrder, true, true>(LDSL, g, S, E);
            SEAM(pb + 8);
        }
        for (int rep_ = 0; rep_ < NREP(11); ++rep_) if (EN(11) && IN(pb + 9)) { fx_phase(a, l, G); SEAM(pb + 9); }
        for (int rep_ = 0; rep_ < NREP(12); ++rep_) if (EN(12) && IN(pb + 10)) {
            pg8::Gemm g{WSP(const bf16, WS_ACT), (const bf16*)(WSBASE + WS_WDN + l * SZ_WDN), NPR, DM, DFF}; pg8::StaticOrder S; S.init(NPR, DM, G, (int)blockIdx.x);
            EpiRes E{WSP(const float, WS_XB), WSP(const float, WS_XB) + (size_t)NPR * DM, WSP(float, WS_XA), MODL + 5 * DM, nullptr};
            pg8::gemm_phase_x<EpiRes, pg8::StaticOrder>(LDSL, g, WSP(const bf16, WS_ACT) + (size_t)NPR * DFF, S, E);
            SEAM(pb + 10);
        }
    }
    for (int rep_ = 0; rep_ < NREP(13); ++rep_) if (EN(13) && IN(PH_FINAL)) final_phase(WSP(const float, WS_XA), a.in[26], a.out + O_YP, G);
#undef IN
#undef SEAM
#undef G
}

extern "C" void kernel_launch(void* const* d_in, const int* in_sizes, int n_in, void* d_out, int out_size, void* d_ws, size_t ws_size, hipStream_t stream) {
    static int grid = 0;
    if (grid == 0) {
        if (n_in != 27 || (size_t)out_size != O_END || ws_size < WS_END) { fprintf(stderr, "kernel_launch: unexpected problem shape (n_in %d, out %d, ws %zu; need ws >= %zu)\n", n_in, out_size, ws_size, (size_t)WS_END); grid = -1; return; }
        int dev = 0, cus = 0, per_cu = 0;
        if (hipGetDevice(&dev) != hipSuccess || hipDeviceGetAttribute(&cus, hipDeviceAttributeMultiprocessorCount, dev) != hipSuccess) { grid = -1; return; }
        if (hipFuncSetAttribute((const void*)fwd_kernel, hipFuncAttributeMaxDynamicSharedMemorySize, LDS_BYTES) != hipSuccess) { fprintf(stderr, "kernel_launch: hipFuncSetAttribute failed\n"); grid = -1; return; }
        if (hipOccupancyMaxActiveBlocksPerMultiprocessor(&per_cu, (const void*)fwd_kernel, NTHR, LDS_BYTES) != hipSuccess || per_cu < 1) { fprintf(stderr, "kernel_launch: occupancy query says %d blocks per CU\n", per_cu); (void)hipGetLastError(); grid = -1; return; }
        grid = cus;
    }
    if (grid < 0) return;
    (void)hipMemsetAsync((char*)d_ws + WS_CTL, 0, CTL_BYTES, stream);
    Args a{};
    for (int i = 0; i < 27; ++i) a.in[i] = (const float*)d_in[i];
    a.out = (float*)d_out; a.ws = (unsigned char*)d_ws;
#if N_LAUNCH_MODE == 1
    a.ph_lo = 0; a.ph_hi = N_PHASES;
    hipLaunchKernelGGL(fwd_kernel, dim3(grid), dim3(NTHR), LDS_BYTES, stream, a);
#else
    for (int p = 0; p < N_PHASES; ++p) { a.ph_lo = p; a.ph_hi = p + 1; hipLaunchKernelGGL(fwd_kernel, dim3(grid), dim3(NTHR), LDS_BYTES, stream, a); }
#endif
}
```
